# Optimizing an MI355X kernel written in HIP

```python
import math
import jax, jax.numpy as jnp
from jax import lax
import numpy as np

D_MODEL = 1024
BATCH = 8
SEQ = 8192
DEPTH = 4

HEAD_DIM = 64
N_HEADS = D_MODEL // HEAD_DIM
HEADS_A = 3 * N_HEADS // 8
HEADS_B = N_HEADS // 4
KV_HEADS_B = HEADS_B // 2
HEADS_C = N_HEADS - HEADS_A - HEADS_B
DILATED_PAIRS = ((128, 1), (512, 4), (2048, 16))
WINDOW_B = 128
MLSTM_CHUNK = 64
CONV_WIDTH = 5
FORGET_BIAS_LO = 3.0
FORGET_BIAS_HI = 6.0
N_BUCKETS = 32
REL_MAX_DIST = 1024
D_FF = -(-8 * D_MODEL // (3 * 256)) * 256
PLE_DIM = 256
EPS = 1e-6
NEG = -1e30
COL_SIZES = (HEADS_A * HEAD_DIM,) * 3 + (HEADS_B * HEAD_DIM, KV_HEADS_B * HEAD_DIM, KV_HEADS_B * HEAD_DIM) + (HEADS_C * HEAD_DIM,) * 4 + (4 * HEADS_C,)
D_IN = sum(COL_SIZES)

kernel_name = "hybrid_dilated_swa_mlstm_encoder"


def rmsnorm(x, g):
    xf = x.astype(jnp.float32)
    y = xf * lax.rsqrt(jnp.mean(xf * xf, axis=-1, keepdims=True) + EPS)
    return (y * g.astype(jnp.float32)).astype(x.dtype)


def t5_bucket(rel):
    half_b = N_BUCKETS // 2
    max_exact = half_b // 2
    n = jnp.abs(rel)
    nf = jnp.maximum(n, 1).astype(jnp.float32)
    large = max_exact + (jnp.log(nf / max_exact) / math.log(REL_MAX_DIST / max_exact) * (half_b - max_exact)).astype(jnp.int32)
    large = jnp.minimum(large, half_b - 1)
    return jnp.where(rel > 0, half_b, 0) + jnp.where(n < max_exact, n, large)


def banded_attention(q, k, v, bias_table, half, blk, dil, sink=None):
    N, L, H, dh = q.shape
    G = k.shape[2]
    R = H // G
    nb = -(-L // blk)
    Lp = nb * blk
    pad = Lp - L
    qp = jnp.pad(q, ((0, 0), (0, pad), (0, 0), (0, 0))).reshape(N, nb, blk, G, R, dh)

    def kblocks(t):
        tp = jnp.pad(t, ((0, 0), (blk, pad + blk), (0, 0), (0, 0))).reshape(N, nb + 2, blk, G, dh)
        return jnp.concatenate([tp[:, :-2], tp[:, 1:-1], tp[:, 2:]], axis=2)

    kb, vb = kblocks(k), kblocks(v)
    logits = jnp.einsum('nbqgrd,nbkgd->nbgrqk', qp, kb).astype(jnp.float32) * (dh ** -0.5)
    iq = jnp.arange(blk, dtype=jnp.int32)
    ik = jnp.arange(3 * blk, dtype=jnp.int32)
    rel = ik[None, :] - blk - iq[:, None]
    kpos = jnp.arange(nb, dtype=jnp.int32)[:, None] * blk - blk + ik[None, :]
    mask = (jnp.abs(rel) <= half)[None] & ((kpos >= 0) & (kpos < L))[:, None, :]
    bias = jnp.transpose(bias_table[t5_bucket(rel * dil)], (2, 0, 1)).reshape(G, R, blk, 3 * blk)
    logits = jnp.where(mask[None, :, None, None], logits + bias.astype(jnp.float32), NEG)
    m = jnp.max(logits, axis=-1)
    if sink is not None:
        s = sink.astype(jnp.float32).reshape(G, R)[None, None, :, :, None]
        m = jnp.maximum(m, s)
    pexp = jnp.exp(logits - m[..., None])
    denom = jnp.sum(pexp, axis=-1)
    if sink is not None:
        denom = denom + jnp.exp(s - m)
    out = jnp.einsum('nbgrqk,nbkgd->nbqgrd', pexp, vb.astype(jnp.float32))
    out = out / jnp.moveaxis(denom, -1, 2)[..., None]
    lse = jnp.moveaxis(m + jnp.log(denom), -1, 2)
    return out.reshape(N, Lp, H, dh)[:, :L], lse.reshape(N, Lp, H)[:, :L]


def dilated_attention(q, k, v, bias_table):
    B, S, H, dh = q.shape
    outs, lses = [], []
    for (w, d) in DILATED_PAIRS:
        half = w // (2 * d)

        def to_sub(t):
            return t.reshape(B, S // d, d, H, dh).transpose(0, 2, 1, 3, 4).reshape(B * d, S // d, H, dh)

        o, l = banded_attention(to_sub(q), to_sub(k), to_sub(v), bias_table, half, half, d)
        outs.append(o.reshape(B, d, S // d, H, dh).transpose(0, 2, 1, 3, 4).reshape(B, S, H, dh))
        lses.append(l.reshape(B, d, S // d, H).transpose(0, 2, 1, 3).reshape(B, S, H))
    wts = jax.nn.softmax(jnp.stack(lses, 0), axis=0)
    return jnp.einsum('gbsh,gbshd->bshd', wts, jnp.stack(outs, 0))


def mlstm_direction(q, k, v, ig, fg):
    N, H, S, dh = q.shape
    L = MLSTM_CHUNK
    nc = S // L
    q = q.reshape(N, H, nc, L, dh)
    k = k.reshape(N, H, nc, L, dh)
    v = v.reshape(N, H, nc, L, dh)
    ig = ig.reshape(N, H, nc, L)
    b = jnp.cumsum(jax.nn.log_sigmoid(fg).reshape(N, H, nc, L), axis=-1)
    b_last = b[..., -1]
    w = b_last[..., None] - b + ig
    m_loc = jnp.max(w, axis=-1)
    e = jnp.exp(w - m_loc[..., None])
    C_loc = jnp.einsum('nhcs,nhcsd,nhcse->nhcde', e, k, v)
    n_loc = jnp.einsum('nhcs,nhcsd->nhcd', e, k)

    def step(carry, xs):
        C, n, m = carry
        bl, Cl, nl, ml = xs
        m_new = jnp.maximum(bl + m, ml)
        a = jnp.exp(bl + m - m_new)
        c = jnp.exp(ml - m_new)
        C_new = a[..., None, None] * C + c[..., None, None] * Cl
        n_new = a[..., None] * n + c[..., None] * nl
        return (C_new, n_new, m_new), (C, n, m)

    init = (jnp.zeros((N, H, dh, dh), jnp.float32), jnp.zeros((N, H, dh), jnp.float32), jnp.zeros((N, H), jnp.float32))
    xs = tuple(jnp.moveaxis(t, 2, 0) for t in (b_last, C_loc, n_loc, m_loc))
    _, (C_prev, n_prev, m_prev) = lax.scan(step, init, xs)
    C_prev = jnp.moveaxis(C_prev, 0, 2)
    n_prev = jnp.moveaxis(n_prev, 0, 2)
    m_prev = jnp.moveaxis(m_prev, 0, 2)
    lower = jnp.tril(jnp.ones((L, L), dtype=bool))
    D = jnp.where(lower, b[..., :, None] - b[..., None, :] + ig[..., None, :], NEG)
    m_inter = b + m_prev[..., None]
    m_t = jnp.maximum(jnp.max(D, axis=-1), m_inter)
    P = jnp.exp(D - m_t[..., None]) * jnp.einsum('nhctd,nhcsd->nhcts', q, k)
    a = jnp.exp(m_inter - m_t)
    num = jnp.einsum('nhcts,nhcse->nhcte', P, v) + a[..., None] * jnp.einsum('nhctd,nhcde->nhcte', q, C_prev)
    den = jnp.sum(P, axis=-1) + a * jnp.einsum('nhctd,nhcd->nhct', q, n_prev)
    h = num / jnp.maximum(jnp.abs(den), jnp.exp(-m_t))[..., None]
    return h.reshape(N, H, S, dh)


def centred_dwconv(t, w):
    K, C = w.shape
    return lax.conv_general_dilated(t, w[:, None, :], window_strides=(1,), padding=[(K // 2, K // 2)], dimension_numbers=('NWC', 'WIO', 'NWC'), feature_group_count=C)


def mlstm_mixer(qc, kc, vc, oc, gc, conv_w, gate_b, norm_g):
    B, S, _ = qc.shape
    dt = qc.dtype
    qk = jax.nn.silu(centred_dwconv(jnp.concatenate([qc, kc], axis=-1), conv_w))
    q, k = jnp.split(qk, 2, axis=-1)

    def to_bhsd(t):
        return t.reshape(B, S, HEADS_C, HEAD_DIM).transpose(0, 2, 1, 3).astype(jnp.float32)

    q, k, v = to_bhsd(q), to_bhsd(k) * (HEAD_DIM ** -0.5), to_bhsd(vc)
    g = (gc + gate_b).astype(jnp.float32).reshape(B, S, 4, HEADS_C).transpose(2, 0, 3, 1)
    ig_f, fg_f, ig_b, fg_b = g[0], g[1], g[2], g[3]

    def rev(t):
        return jnp.flip(t, axis=2)

    h = mlstm_direction(jnp.concatenate([q, rev(q)], 0), jnp.concatenate([k, rev(k)], 0), jnp.concatenate([v, rev(v)], 0), jnp.concatenate([ig_f, rev(ig_b)], 0), jnp.concatenate([fg_f, rev(fg_b)], 0))
    h = (h[:B] + rev(h[B:])).transpose(0, 2, 1, 3)
    h = h * lax.rsqrt(jnp.mean(h * h, axis=-1, keepdims=True) + EPS) * norm_g.astype(jnp.float32).reshape(HEADS_C, HEAD_DIM)
    return (jax.nn.sigmoid(oc.astype(jnp.float32)) * h.reshape(B, S, HEADS_C * HEAD_DIM)).astype(dt)


def setup_inputs(seed: int = 0) -> dict:
    key = jax.random.key(seed)
    ks = jax.random.split(key, 16)
    f32 = jnp.float32

    def nrm(k, shape, s):
        return jax.random.normal(k, shape, f32) * s

    fb = jnp.linspace(FORGET_BIAS_LO, FORGET_BIAS_HI, HEADS_C, dtype=f32)
    zb = jnp.zeros((HEADS_C,), f32)
    return {
        'x': nrm(ks[0], (BATCH, SEQ, D_MODEL), 1.0),
        'p': nrm(ks[1], (DEPTH, BATCH, SEQ, PLE_DIM), 1.0),
        'rel_bias': nrm(ks[2], (N_BUCKETS, HEADS_A + HEADS_B), 0.2),
        'attn_norm': 1.0 + nrm(ks[3], (DEPTH, D_MODEL), 0.05),
        'w_in': nrm(ks[4], (DEPTH, D_MODEL, D_IN), D_MODEL ** -0.5),
        'qk_conv': nrm(ks[5], (DEPTH, CONV_WIDTH, 2 * HEADS_C * HEAD_DIM), CONV_WIDTH ** -0.5),
        'gate_bias': jnp.concatenate([zb, fb, zb, fb])[None] + nrm(ks[6], (DEPTH, 4 * HEADS_C), 0.1),
        'sink_logits': nrm(ks[7], (DEPTH, HEADS_B), 0.5),
        'mlstm_norm': 1.0 + nrm(ks[8], (DEPTH, HEADS_C * HEAD_DIM), 0.05),
        'w_out': nrm(ks[9], (DEPTH, D_MODEL, D_MODEL), D_MODEL ** -0.5),
        'ffn_norm': 1.0 + nrm(ks[10], (DEPTH, D_MODEL), 0.05),
        'w_up': nrm(ks[11], (DEPTH, D_MODEL, 2 * D_FF), D_MODEL ** -0.5),
        'w_down': nrm(ks[12], (DEPTH, D_FF, D_MODEL), D_FF ** -0.5),
        'ple_proj': nrm(ks[13], (DEPTH, PLE_DIM, D_MODEL), PLE_DIM ** -0.5),
        'ple_gate': nrm(ks[14], (DEPTH, D_MODEL, D_MODEL), D_MODEL ** -0.5),
        'final_norm': 1.0 + nrm(ks[15], (D_MODEL,), 0.05),
    }


def reference(x, p, rel_bias, attn_norm, w_in, qk_conv, gate_bias, sink_logits, mlstm_norm, w_out, ffn_norm, w_up, w_down, ple_proj, ple_gate, final_norm):
    B, S, _ = x.shape
    bias_a = rel_bias[:, :HEADS_A]
    bias_b = rel_bias[:, HEADS_A:]
    for i in range(DEPTH):
        h = rmsnorm(x, attn_norm[i])
        z = h @ w_in[i]
        parts = []
        off = 0
        for sz in COL_SIZES:
            parts.append(z[..., off:off + sz])
            off += sz
        qa, ka, va, qb, kb, vb, qc, kc, vc, oc, gc = parts
        ya = dilated_attention(qa.reshape(B, S, HEADS_A, HEAD_DIM), ka.reshape(B, S, HEADS_A, HEAD_DIM), va.reshape(B, S, HEADS_A, HEAD_DIM), bias_a)
        yb, _ = banded_attention(qb.reshape(B, S, HEADS_B, HEAD_DIM), kb.reshape(B, S, KV_HEADS_B, HEAD_DIM), vb.reshape(B, S, KV_HEADS_B, HEAD_DIM), bias_b, WINDOW_B, WINDOW_B, 1, sink=sink_logits[i])
        yc = mlstm_mixer(qc, kc, vc, oc, gc, qk_conv[i], gate_bias[i], mlstm_norm[i])
        y = jnp.concatenate([ya.reshape(B, S, HEADS_A * HEAD_DIM).astype(x.dtype), yb.reshape(B, S, HEADS_B * HEAD_DIM).astype(x.dtype), yc], axis=-1)
        x = x + y @ w_out[i]
        h = rmsnorm(x, ffn_norm[i])
        gu = h @ w_up[i]
        x = x + (jax.nn.silu(gu[..., :D_FF]) * gu[..., D_FF:]) @ w_down[i]
        x = x + (p[i] @ ple_proj[i]) * jax.nn.sigmoid(x @ ple_gate[i])
    return rmsnorm(x, final_norm)
```

```cpp
#include <hip/hip_runtime.h>
#include <hip/hip_cooperative_groups.h>
#include <cstdio>
#include <cstdint>
namespace cg = cooperative_groups;

#define LAS __attribute__((address_space(3)))
#define DI __device__ __forceinline__
typedef unsigned short bf16_t;
typedef short bf16x8 __attribute__((ext_vector_type(8)));
typedef short s16x4 __attribute__((ext_vector_type(4)));
typedef float f32x4 __attribute__((ext_vector_type(4)));
typedef float f32x2 __attribute__((ext_vector_type(2)));
typedef unsigned u32x4 __attribute__((ext_vector_type(4)));
typedef unsigned u32x2 __attribute__((ext_vector_type(2)));
typedef __bf16 bf16v2 __attribute__((ext_vector_type(2)));

constexpr int NB = 8, SEQ = 8192, DM = 1024, DEPTH = 4, MTOK = NB * SEQ;
constexpr int ZLD = 3200, NIN_PAD = 3328, DFF = 2816, NUP = 2 * DFF, PLE = 256, DIN = 3224;
constexpr int QA = 0, QB = 384, QC = 640, KA = 1024, KB = 1408, KC = 1536, VA = 1920, VB = 2304, VC = 2432, OC = 2816;
constexpr int ACT_OFF = 384;
constexpr float LOG2E = 1.4426950408889634f;
constexpr float QSCALE = 0.125f * LOG2E;
constexpr float EPS = 1e-6f;
constexpr float NEGBIG = -1e30f;
constexpr int NSEQ = 2 * NB * 6, NCH = SEQ / 64;

constexpr size_t OFF_WIN = 0, OFF_WOUT = OFF_WIN + (size_t)NIN_PAD * DM, OFF_WUP = OFF_WOUT + (size_t)DM * DM, OFF_WDOWN = OFF_WUP + (size_t)NUP * DM,
                 OFF_WP = OFF_WDOWN + (size_t)DM * DFF, OFF_WG = OFF_WP + (size_t)DM * PLE, LAYER_W = OFF_WG + (size_t)DM * DM;
constexpr size_t MiB = 1u << 20;
constexpr size_t WS_W = 1 * MiB, WS_PB = 112 * MiB, WS_GATES = 144 * MiB, WS_RS = 150 * MiB, WS_NB = 151 * MiB, WS_ML = 153 * MiB, WS_BL = WS_ML + 256 * 1024,
                 WS_MP = WS_ML + 512 * 1024, WS_QCONV = 154 * MiB, WS_KCONV = 202 * MiB, WS_XBA = 250 * MiB, WS_XBB = 378 * MiB, WS_Z = 506 * MiB, WS_CT = 906 * MiB,
                 WS_END = 1002 * MiB;
static_assert(WS_W + 4 * LAYER_W * 2 <= WS_PB, "weights");
static_assert(WS_Z + (size_t)MTOK * ZLD * 2 <= WS_CT, "z");
static_assert(WS_CT + (size_t)NSEQ * NCH * 4096 * 2 <= WS_END, "ct");

constexpr int LDS_BYTES = 155648;
constexpr int RING_BYTES = 131072, SSQ_OFF = 131072;

DI unsigned pk2(float lo, float hi) { f32x2 v = {lo, hi}; bf16v2 b = __builtin_convertvector(v, bf16v2); return __builtin_bit_cast(unsigned, b); }
DI float bf2f(unsigned short u) { return __uint_as_float(((unsigned)u) << 16); }
DI float bflo(unsigned u) { return __uint_as_float(u << 16); }
DI float bfhi(unsigned u) { return __uint_as_float(u & 0xffff0000u); }
DI float ex2(float x) { return __builtin_amdgcn_exp2f(x); }
DI float fexp(float x) { return __builtin_amdgcn_exp2f(x * LOG2E); }
DI float frcp(float x) { return __builtin_amdgcn_rcpf(x); }
DI float sigmoidf_(float x) { return frcp(1.f + fexp(-x)); }
DI f32x4 mfma16(bf16x8 a, bf16x8 b, f32x4 c) { return __builtin_amdgcn_mfma_f32_16x16x32_bf16(a, b, c, 0, 0, 0); }
DI f32x4 zero4() { float z; asm volatile("v_mov_b32 %0, 0" : "=v"(z)); return (f32x4){z, z, z, z}; }
DI s16x4 trread(LAS unsigned char* p) { return __builtin_amdgcn_ds_read_tr16_b64_v4i16((LAS s16x4*)p); }
DI bf16x8 cat8(s16x4 a, s16x4 b) { return __builtin_shufflevector(a, b, 0, 1, 2, 3, 4, 5, 6, 7); }
#define WAVE_LDS_FENCE() asm volatile("s_waitcnt lgkmcnt(0)" ::: "memory")
#define LOCAL_SEAM() do { asm volatile("s_waitcnt vmcnt(0) lgkmcnt(0)" ::: "memory"); __syncthreads(); __builtin_amdgcn_fence(__ATOMIC_ACQUIRE, "agent"); } while (0)

namespace pg8 {
constexpr int BM = 256, BK = 64, HALF = 128, HTB = HALF * BK * 2, STAGE_BYTES = 8 * HTB;
DI int lds_byte(int r, int c) { const int st = (r >> 4) * 2 + (c >> 5), rr = r & 15, cc = c & 31, ob = rr * 64 + cc * 2; return st * 1024 + (ob ^ (((ob >> 9) & 1) << 5)); }
DI void stage_rc(int b, int& R, int& C) { const int st = b / 1024, sb = b % 1024, swz = sb ^ (((sb >> 9) & 1) << 5); R = (st >> 1) * 16 + swz / 64; C = (st & 1) * 32 + (swz % 64) / 2; }
DI int perm32(int rho) { const int n = rho >> 4, i = rho & 15; return 8 * (i >> 2) + 4 * n + (i & 3); }
struct Unit { int pm, pn; };
struct Gemm { const bf16_t* A; const bf16_t* Bt; int lda, K; };
struct RowOrder {
    int pm, nN;
    DI bool next(int i, Unit& u) const { if (i >= nN) return false; u.pm = pm; u.pn = i; return true; }
};

template <class Epi, class Sched>
DI void gemm_phase(LAS unsigned char* lds, const Gemm g, const Sched& S, const Epi& E) {
    int tid = threadIdx.x; asm volatile("" : "+v"(tid));
    const int wid = __builtin_amdgcn_readfirstlane(tid >> 6), lane = tid & 63, wr = wid >> 2, wc = wid & 3, fr = lane & 15, fq = lane >> 4;
    const int K = g.K, nt = K / BK, lda = g.lda;
    unsigned voffA[2], voffB[2];
#pragma unroll
    for (int i = 0; i < 2; ++i) { int R, C; stage_rc(tid * 16 + i * 8192, R, C); const int Rb = Epi::PERM ? ((R & ~31) + perm32(R & 31)) : R;
        voffA[i] = (unsigned)(R * lda + C) * 2u; voffB[i] = (unsigned)(Rb * K + C) * 2u; }
    const size_t kstep = (size_t)(BK * 2);
    const size_t hsA = (size_t)HALF * lda * 2, hsB = (size_t)HALF * K * 2;
    const size_t tsA = 2 * hsA, tsB = 2 * hsB;
    const unsigned ldsw = (unsigned)wid * 1024u;
    const int aoff = lds_byte(wr * 64 + fr, fq * 8), boff = lds_byte(wc * 32 + fr, fq * 8);
#define PG8_SA(b, h) (((b) * 2 + (h)) * HTB)
#define PG8_SB(b, h) ((4 + (b) * 2 + (h)) * HTB)
#define PG8_STAGE(bufoff, gbase, voff) do { _Pragma("unroll") for (int _i = 0; _i < 2; ++_i) \
        __builtin_amdgcn_global_load_lds((const unsigned*)((const char*)(gbase) + (voff)[_i]), (LAS unsigned*)(lds + (bufoff) + ldsw + _i * 8192), 16, 0, 0); } while (0)
#define PG8_LDA(dst, b, h) do { _Pragma("unroll") for (int m = 0; m < 4; ++m) _Pragma("unroll") for (int k = 0; k < 2; ++k) dst[m][k] = *(const LAS bf16x8*)(lds + PG8_SA(b, h) + aoff + m * 2048 + k * 1024); } while (0)
#define PG8_LDB(dst, b, h) do { _Pragma("unroll") for (int n = 0; n < 2; ++n) _Pragma("unroll") for (int k = 0; k < 2; ++k) dst[n][k] = *(const LAS bf16x8*)(lds + PG8_SB(b, h) + boff + n * 2048 + k * 1024); } while (0)
#define PG8_MMA(ai, bj, At, Bt) do { __builtin_amdgcn_s_setprio(1); _Pragma("unroll") for (int m = 0; m < 4; ++m) _Pragma("unroll") for (int n = 0; n < 2; ++n) _Pragma("unroll") for (int k = 0; k < 2; ++k) \
        acc[ai][bj][m][n] = __builtin_amdgcn_mfma_f32_16x16x32_bf16(Bt[n][k], At[m][k], acc[ai][bj][m][n], 0, 0, 0); __builtin_amdgcn_s_setprio(0); } while (0)
#define PG8_WAIT_V(n) asm volatile("s_waitcnt vmcnt(" #n ")" ::: "memory")
#define PG8_WAIT_L(n) asm volatile("s_waitcnt lgkmcnt(" #n ")" ::: "memory")
#define PG8_BAR __builtin_amdgcn_s_barrier()
#define PG8_SCHED __builtin_amdgcn_sched_barrier(0)
    Unit cur, nxt; int ui = 0;
    if (!S.next(0, cur)) return;
    f32x4 acc[2][2][4][2];
    { float z0; asm volatile("v_mov_b32 %0, 0" : "=v"(z0));
#pragma unroll
    for (int a = 0; a < 2; ++a)
#pragma unroll
        for (int b = 0; b < 2; ++b)
#pragma unroll
            for (int m = 0; m < 4; ++m)
#pragma unroll
                for (int n = 0; n < 2; ++n) acc[a][b][m][n] = (f32x4){z0, z0, z0, z0}; }
    bf16x8 At[4][2], B0[2][2], B1[2][2];
    const char* cA = (const char*)g.A + (size_t)cur.pm * tsA; const char* cB = (const char*)g.Bt + (size_t)cur.pn * tsB;
    PG8_STAGE(PG8_SB(0, 0), cB, voffB); PG8_STAGE(PG8_SB(0, 1), cB + hsB, voffB); PG8_STAGE(PG8_SA(0, 0), cA, voffA); PG8_STAGE(PG8_SA(0, 1), cA + hsA, voffA);
    if (wr == 1) PG8_BAR;
    PG8_WAIT_V(2); PG8_BAR;
    PG8_STAGE(PG8_SB(1, 0), cB + kstep, voffB); PG8_STAGE(PG8_SA(1, 0), cA + kstep, voffA); PG8_STAGE(PG8_SB(1, 1), cB + hsB + kstep, voffB);
    PG8_WAIT_V(6); PG8_BAR;
    for (;;) {
        const bool has_next = S.next(ui + 1, nxt);
        const char* nA = has_next ? (const char*)g.A + (size_t)nxt.pm * tsA : cA; const char* nB = has_next ? (const char*)g.Bt + (size_t)nxt.pn * tsB : cB;
        for (int t = 0; t < nt; t += 2) {
            const bool last = (t == nt - 2);
            const char* a1 = cA + (size_t)(t + 1) * kstep;
            const char* a2 = last ? nA : cA + (size_t)(t + 2) * kstep; const char* b2 = last ? nB : cB + (size_t)(t + 2) * kstep;
            const char* a3 = a2 + kstep; const char* b3 = b2 + kstep;
            PG8_LDB(B0, 0, 0); PG8_LDB(B1, 0, 1); PG8_SCHED; PG8_LDA(At, 0, 0); PG8_STAGE(PG8_SA(1, 1), a1 + hsA, voffA);
            PG8_WAIT_V(8); PG8_WAIT_L(0); PG8_BAR; PG8_MMA(0, 0, At, B0); PG8_MMA(0, 1, At, B1); PG8_BAR; PG8_SCHED;
            PG8_LDA(At, 0, 1); PG8_STAGE(PG8_SB(0, 0), b2, voffB); PG8_STAGE(PG8_SB(0, 1), b2 + hsB, voffB); PG8_STAGE(PG8_SA(0, 0), a2, voffA);
            PG8_WAIT_V(8); PG8_WAIT_L(0); PG8_BAR; PG8_MMA(1, 0, At, B0); PG8_MMA(1, 1, At, B1); PG8_BAR; PG8_SCHED;
            PG8_LDB(B0, 1, 0); PG8_LDB(B1, 1, 1); PG8_SCHED; PG8_LDA(At, 1, 0); PG8_STAGE(PG8_SA(0, 1), a2 + hsA, voffA);
            PG8_WAIT_V(8); PG8_WAIT_L(0); PG8_BAR; PG8_MMA(0, 0, At, B0); PG8_MMA(0, 1, At, B1); PG8_BAR; PG8_SCHED;
            PG8_LDA(At, 1, 1); PG8_STAGE(PG8_SB(1, 0), b3, voffB); PG8_STAGE(PG8_SB(1, 1), b3 + hsB, voffB); PG8_STAGE(PG8_SA(1, 0), a3, voffA);
            PG8_WAIT_V(8); PG8_WAIT_L(0); PG8_BAR; PG8_MMA(1, 0, At, B0); PG8_MMA(1, 1, At, B1); PG8_BAR; PG8_SCHED;
        }
        if (wr == 0) PG8_BAR;
        E(acc, cur, wr, wc, fr, fq);
        if (!has_next) break;
        { float z0; asm volatile("v_mov_b32 %0, 0" : "=v"(z0));
#pragma unroll
        for (int a = 0; a < 2; ++a)
#pragma unroll
            for (int b = 0; b < 2; ++b)
#pragma unroll
                for (int m = 0; m < 4; ++m)
#pragma unroll
                    for (int n = 0; n < 2; ++n) acc[a][b][m][n] = (f32x4){z0, z0, z0, z0}; }
        cur = nxt; cA = nA; cB = nB; ++ui;
        if (wr == 1) PG8_BAR;
    }
    PG8_WAIT_V(0);
    PG8_BAR;
#undef PG8_SA
#undef PG8_SB
#undef PG8_STAGE
#undef PG8_LDA
#undef PG8_LDB
#undef PG8_MMA
#undef PG8_WAIT_V
#undef PG8_WAIT_L
#undef PG8_BAR
#undef PG8_SCHED
}

struct EpiZ {
    static constexpr bool PERM = true;
    bf16_t* Z; float* gates; const float* rs;
    DI void operator()(const f32x4 (&acc)[2][2][4][2], const Unit& u, int wr, int wc, int fr, int fq) const {
        asm volatile("" : "+v"(fr), "+v"(fq));
        const int row0 = u.pm * BM + wr * 64 + fr, col0 = u.pn * BM + wc * 32 + 8 * fq;
#pragma unroll
        for (int ai = 0; ai < 2; ++ai)
#pragma unroll
            for (int m = 0; m < 4; ++m) { const int row = row0 + ai * HALF + m * 16; const float sc = rs[row];
#pragma unroll
                for (int bj = 0; bj < 2; ++bj) { const int col = col0 + bj * HALF; const f32x4 v0 = acc[ai][bj][m][0] * sc, v1 = acc[ai][bj][m][1] * sc;
                    if (col < ZLD) { u32x4 w; w.x = pk2(v0[0], v0[1]); w.y = pk2(v0[2], v0[3]); w.z = pk2(v1[0], v1[1]); w.w = pk2(v1[2], v1[3]); *(u32x4*)(Z + (size_t)row * ZLD + col) = w; }
                    else if (col < DIN) { float* gp = gates + (size_t)row * 24 + (col - ZLD); *(f32x4*)gp = v0; *(f32x4*)(gp + 4) = v1; } }
                asm volatile("" ::: "memory"); }
    }
};
struct EpiSwiGLU {
    static constexpr bool PERM = true;
    bf16_t* Z; const float* rs;
    DI void operator()(const f32x4 (&acc)[2][2][4][2], const Unit& u, int wr, int wc, int fr, int fq) const {
        asm volatile("" : "+v"(fr), "+v"(fq));
        const int row0 = u.pm * BM + wr * 64 + fr, col0 = ACT_OFF + u.pn * HALF + wc * 32 + 8 * fq;
#pragma unroll
        for (int ai = 0; ai < 2; ++ai)
#pragma unroll
            for (int m = 0; m < 4; ++m) { const int row = row0 + ai * HALF + m * 16; const float sc = rs[row]; float o[8];
#pragma unroll
                for (int n = 0; n < 2; ++n)
#pragma unroll
                    for (int i = 0; i < 4; ++i) { const float gg = acc[ai][0][m][n][i] * sc, uu = acc[ai][1][m][n][i] * sc; o[4 * n + i] = gg * sigmoidf_(gg) * uu; }
                u32x4 w; w.x = pk2(o[0], o[1]); w.y = pk2(o[2], o[3]); w.z = pk2(o[4], o[5]); w.w = pk2(o[6], o[7]);
                *(u32x4*)(Z + (size_t)row * ZLD + col0) = w;
                asm volatile("" ::: "memory"); }
    }
};
struct EpiSigmoid {
    static constexpr bool PERM = true;
    bf16_t* Z;
    DI void operator()(const f32x4 (&acc)[2][2][4][2], const Unit& u, int wr, int wc, int fr, int fq) const {
        asm volatile("" : "+v"(fr), "+v"(fq));
        const int row0 = u.pm * BM + wr * 64 + fr, col0 = u.pn * BM + wc * 32 + 8 * fq;
#pragma unroll
        for (int ai = 0; ai < 2; ++ai)
#pragma unroll
            for (int m = 0; m < 4; ++m) { const int row = row0 + ai * HALF + m * 16;
#pragma unroll
                for (int bj = 0; bj < 2; ++bj) { const f32x4 v0 = acc[ai][bj][m][0], v1 = acc[ai][bj][m][1]; u32x4 w;
                    w.x = pk2(sigmoidf_(v0[0]), sigmoidf_(v0[1])); w.y = pk2(sigmoidf_(v0[2]), sigmoidf_(v0[3])); w.z = pk2(sigmoidf_(v1[0]), sigmoidf_(v1[1])); w.w = pk2(sigmoidf_(v1[2]), sigmoidf_(v1[3]));
                    *(u32x4*)(Z + (size_t)row * ZLD + col0 + bj * HALF) = w; }
                asm volatile("" ::: "memory"); }
    }
};
template <bool MUL> struct EpiResid {
    static constexpr bool PERM = false;
    const float* resid; float* out; bf16_t* xb; const bf16_t* mul; LAS float* ssq;
    DI void operator()(const f32x4 (&acc)[2][2][4][2], const Unit& u, int wr, int wc, int fr, int fq) const {
        asm volatile("" : "+v"(fr), "+v"(fq));
        const int col0 = u.pn * BM + wc * 32 + 4 * fq;
#pragma unroll
        for (int ai = 0; ai < 2; ++ai)
#pragma unroll
            for (int m = 0; m < 4; ++m) { const int rl = ai * HALF + wr * 64 + m * 16 + fr; const size_t row = (size_t)(u.pm * BM + rl); float s = 0.f;
#pragma unroll
                for (int bj = 0; bj < 2; ++bj)
#pragma unroll
                    for (int n = 0; n < 2; ++n) { const int col = col0 + bj * HALF + n * 16; f32x4 a = acc[ai][bj][m][n];
                        if (MUL) { const u32x2 mv = *(const u32x2*)(mul + row * ZLD + col); a[0] *= bflo(mv.x); a[1] *= bfhi(mv.x); a[2] *= bflo(mv.y); a[3] *= bfhi(mv.y); }
                        const f32x4 r = *(const f32x4*)(resid + row * DM + col); const f32x4 x = r + a;
                        *(f32x4*)(out + row * DM + col) = x; u32x2 w; w.x = pk2(x[0], x[1]); w.y = pk2(x[2], x[3]); *(u32x2*)(xb + row * DM + col) = w;
                        s += (x[0] * x[0] + x[1] * x[1]) + (x[2] * x[2] + x[3] * x[3]); }
                { const int lid = fr + 16 * fq;
                  s += __builtin_bit_cast(float, __builtin_amdgcn_ds_bpermute((lid ^ 16) << 2, __builtin_bit_cast(int, s)));
                  s += __builtin_bit_cast(float, __builtin_amdgcn_ds_bpermute((lid ^ 32) << 2, __builtin_bit_cast(int, s))); }
                if (fq == 0) ssq[rl * 4 + wc] += s;
                asm volatile("" ::: "memory"); }
    }
};
}

struct KParams {
    const float* x; const float* p; const float* rel_bias; const float* attn_norm; const float* w_in; const float* qk_conv; const float* gate_bias; const float* sink;
    const float* mlstm_norm; const float* w_out; const float* ffn_norm; const float* w_up; const float* w_down; const float* ple_proj; const float* ple_gate; const float* final_norm;
    float* out; unsigned char* ws;
};

DI void transpose_item(const float* __restrict__ W, int K, int Nsrc, int n0, int nvalid, const float* __restrict__ gk, float cs,
                       bf16_t* __restrict__ WT, int dst_row0, int k0, LAS float* scr, int lane) {
    const int c = lane & 31, kh = lane >> 5;
#pragma unroll 8
    for (int i = 0; i < 32; ++i) { const int kk = 2 * i + kh; float v = 0.f;
        if (c < nvalid) { v = W[(size_t)(k0 + kk) * Nsrc + n0 + c] * cs; if (gk) v *= gk[k0 + kk]; }
        scr[kk * 33 + c] = v; }
    WAVE_LDS_FENCE();
    const int c8 = lane & 7;
#pragma unroll
    for (int j = 0; j < 4; ++j) { const int n = (lane >> 3) + 8 * j; const LAS float* s = scr + (8 * c8) * 33 + n;
        u32x4 o; o.x = pk2(s[0 * 33], s[1 * 33]); o.y = pk2(s[2 * 33], s[3 * 33]); o.z = pk2(s[4 * 33], s[5 * 33]); o.w = pk2(s[6 * 33], s[7 * 33]);
        *(u32x4*)(WT + (size_t)(dst_row0 + n) * K + k0 + 8 * c8) = o; }
    WAVE_LDS_FENCE();
}
constexpr int IT_WIN = 16 * 104, IT_WOUT = 16 * 32, IT_WUP = 16 * 176, IT_WDOWN = 44 * 32, IT_WP = 4 * 32, IT_WG = 16 * 32;
constexpr int IT_LAYER = IT_WIN + IT_WOUT + IT_WUP + IT_WDOWN + IT_WP + IT_WG;

DI void prep_weights(const KParams& P, LAS unsigned char* lds, int gw, int NGW, int wave, int lane) {
    LAS float* scr = (LAS float*)(lds + wave * 16384);
    bf16_t* Wall = (bf16_t*)(P.ws + WS_W);
    for (int it = gw; it < DEPTH * IT_LAYER; it += NGW) {
        const int l = it / IT_LAYER; int r = it % IT_LAYER;
        bf16_t* Wl = Wall + (size_t)l * LAYER_W;
        if (r < IT_WIN) { const int kb = r / 104, jb = r % 104, d0 = 32 * jb; int src = d0, nv = 32; float cs = 1.f;
            if (d0 < 384) { src = d0; cs = QSCALE; } else if (d0 < 640) { src = 1152 + d0 - 384; cs = QSCALE; } else if (d0 < 1024) src = 1664 + d0 - 640;
            else if (d0 < 1408) src = 384 + d0 - 1024; else if (d0 < 1536) src = d0; else if (d0 < 1920) src = 2048 + d0 - 1536;
            else if (d0 < 2304) src = 768 + d0 - 1920; else if (d0 < 2432) src = 1536 + d0 - 2304; else if (d0 < 3200) src = d0;
            else if (d0 == 3200) { src = 3200; nv = 24; } else { src = 0; nv = 0; }
            transpose_item(P.w_in + (size_t)l * DM * DIN, DM, DIN, src, nv, P.attn_norm + l * DM, cs, Wl + OFF_WIN, d0, 64 * kb, scr, lane); continue; }
        r -= IT_WIN;
        if (r < IT_WOUT) { const int kb = r / 32, jb = r % 32; transpose_item(P.w_out + (size_t)l * DM * DM, DM, DM, 32 * jb, 32, nullptr, 1.f, Wl + OFF_WOUT, 32 * jb, 64 * kb, scr, lane); continue; }
        r -= IT_WOUT;
        if (r < IT_WUP) { const int kb = r / 176, jb = r % 176, d0 = 32 * jb, pn = d0 >> 8, c0 = d0 & 255; const int src = c0 < 128 ? 128 * pn + c0 : DFF + 128 * pn + (c0 - 128);
            transpose_item(P.w_up + (size_t)l * DM * NUP, DM, NUP, src, 32, P.ffn_norm + l * DM, 1.f, Wl + OFF_WUP, d0, 64 * kb, scr, lane); continue; }
        r -= IT_WUP;
        if (r < IT_WDOWN) { const int kb = r / 32, jb = r % 32; transpose_item(P.w_down + (size_t)l * DFF * DM, DFF, DM, 32 * jb, 32, nullptr, 1.f, Wl + OFF_WDOWN, 32 * jb, 64 * kb, scr, lane); continue; }
        r -= IT_WDOWN;
        if (r < IT_WP) { const int kb = r / 32, jb = r % 32; transpose_item(P.ple_proj + (size_t)l * PLE * DM, PLE, DM, 32 * jb, 32, nullptr, 1.f, Wl + OFF_WP, 32 * jb, 64 * kb, scr, lane); continue; }
        r -= IT_WP;
        { const int kb = r / 32, jb = r % 32; transpose_item(P.ple_gate + (size_t)l * DM * DM, DM, DM, 32 * jb, 32, nullptr, 1.f, Wl + OFF_WG, 32 * jb, 64 * kb, scr, lane); }
    }
}
DI float wave_sum(float v) {
#pragma unroll
    for (int o = 1; o < 64; o <<= 1) v += __shfl_xor(v, o);
    return v;
}
DI float wave_max(float v) {
#pragma unroll
    for (int o = 1; o < 64; o <<= 1) v = fmaxf(v, __shfl_xor(v, o));
    return v;
}

constexpr int VROW = 144;
constexpr int VBUF = 32 * VROW;
constexpr int LUTN = 640, LUTC = 320;

DI void load_kv(const bf16_t* __restrict__ zb, int kcol, int vcol, int dstr, int rd, int u0, int lane, bf16x8 (&kn)[2][2], u32x4 (&vn)[4]) {
    const int r16 = lane & 15, g = lane >> 4;
#pragma unroll
    for (int T = 0; T < 2; ++T) { int pos = dstr * (u0 + 16 * T + r16) + rd; pos = pos < 0 ? 0 : (pos > SEQ - 1 ? SEQ - 1 : pos);
        const bf16_t* p = zb + (size_t)pos * ZLD + kcol + 8 * g; kn[T][0] = *(const bf16x8*)p; kn[T][1] = *(const bf16x8*)(p + 32); }
#pragma unroll
    for (int k = 0; k < 4; ++k) { const int id = lane + 64 * k, row = id >> 3, c16 = id & 7; int pos = dstr * (u0 + row) + rd; pos = pos < 0 ? 0 : (pos > SEQ - 1 ? SEQ - 1 : pos);
        vn[k] = *(const u32x4*)(zb + (size_t)pos * ZLD + vcol + 8 * c16); }
}

template <int NH>
DI void attn_cfg(const bf16_t* __restrict__ zb, int kcol, int vcol, int dstr, int rd, int ubase, int nch, int uq,
                 const LAS float* lut0, const LAS float* lut1, const bf16x8 (&qf)[NH][2], float (&m)[NH], float (&l)[NH], f32x4 (&o)[NH][4],
                 LAS unsigned char* vbase, int lane) {
    const int r16 = lane & 15, g = lane >> 4, q4 = r16 >> 2, p4 = r16 & 3;
    bf16x8 kn[2][2]; u32x4 vn[4];
    load_kv(zb, kcol, vcol, dstr, rd, ubase, lane, kn, vn);
    for (int c = 0; c < nch; ++c) {
        const int u0 = ubase + 32 * c;
        LAS unsigned char* vb = vbase + (c & 1) * VBUF;
#pragma unroll
        for (int k = 0; k < 4; ++k) { const int id = lane + 64 * k, row = id >> 3, c16 = id & 7; *(LAS u32x4*)(vb + row * VROW + c16 * 16) = vn[k]; }
        bf16x8 kf[2][2];
#pragma unroll
        for (int T = 0; T < 2; ++T) { kf[T][0] = kn[T][0]; kf[T][1] = kn[T][1]; }
        if (c + 1 < nch) load_kv(zb, kcol, vcol, dstr, rd, u0 + 32, lane, kn, vn);
        float rm[2][4];
#pragma unroll
        for (int T = 0; T < 2; ++T)
#pragma unroll
            for (int i = 0; i < 4; ++i) { const int pos = dstr * (u0 + 16 * T + 4 * g + i) + rd; rm[T][i] = ((unsigned)pos < (unsigned)SEQ) ? 0.f : NEGBIG; }
        const int li = u0 - uq + 4 * g + LUTC;
        WAVE_LDS_FENCE();
        bf16x8 vf[4];
#pragma unroll
        for (int c4 = 0; c4 < 4; ++c4) { const s16x4 a0 = trread(vb + (4 * g + q4) * VROW + 32 * c4 + 8 * p4), a1 = trread(vb + (16 + 4 * g + q4) * VROW + 32 * c4 + 8 * p4); vf[c4] = cat8(a0, a1); }
#pragma unroll
        for (int hh = 0; hh < NH; ++hh) {
            const LAS float* lut = hh == 0 ? lut0 : lut1;
            float s[8];
#pragma unroll
            for (int T = 0; T < 2; ++T) { f32x4 st = {0.f, 0.f, 0.f, 0.f}; st = mfma16(kf[T][0], qf[hh][0], st); st = mfma16(kf[T][1], qf[hh][1], st);
#pragma unroll
                for (int i = 0; i < 4; ++i) s[4 * T + i] = st[i] + lut[li + 16 * T + i] + rm[T][i]; }
            float cm = fmaxf(fmaxf(fmaxf(s[0], s[1]), fmaxf(s[2], s[3])), fmaxf(fmaxf(s[4], s[5]), fmaxf(s[6], s[7])));
            cm = fmaxf(cm, __shfl_xor(cm, 16)); cm = fmaxf(cm, __shfl_xor(cm, 32));
            const float mn = fmaxf(m[hh], cm), alpha = ex2(m[hh] - mn); m[hh] = mn;
            float pv[8], ps = 0.f;
#pragma unroll
            for (int k = 0; k < 8; ++k) { pv[k] = ex2(s[k] - mn); ps += pv[k]; }
            l[hh] = l[hh] * alpha + ps;
            u32x4 pw; pw.x = pk2(pv[0], pv[1]); pw.y = pk2(pv[2], pv[3]); pw.z = pk2(pv[4], pv[5]); pw.w = pk2(pv[6], pv[7]);
            const bf16x8 pf = __builtin_bit_cast(bf16x8, pw);
#pragma unroll
            for (int c4 = 0; c4 < 4; ++c4) { o[hh][c4] = o[hh][c4] * alpha; o[hh][c4] = mfma16(vf[c4], pf, o[hh][c4]); }
        }
    }
}

DI void build_lut(const KParams& P, LAS unsigned char* lds, int tid) {
    LAS float* lut = (LAS float*)lds;
    for (int idx = tid; idx < 22 * LUTN; idx += 512) {
        const int t = idx / LUTN, rel = idx % LUTN - LUTC; int dil, half, hc;
        if (t < 18) { const int cfg = t / 6; dil = cfg == 0 ? 16 : (cfg == 1 ? 4 : 1); half = 64; hc = t % 6; } else { dil = 1; half = 128; hc = 6 + (t - 18); }
        float v = NEGBIG; const int ar = rel < 0 ? -rel : rel;
        if (ar <= half) { const int n = ar * dil; int bk;
            if (n < 8) bk = n; else { const float nf = (float)n; bk = 8 + (int)(logf(nf / 8.0f) / 4.852030263919617f * 8.0f); bk = bk > 15 ? 15 : bk; }
            if (rel > 0) bk += 16;
            v = P.rel_bias[bk * 10 + hc] * LOG2E; }
        lut[idx] = v;
    }
}

DI void attention_phase(const KParams& P, LAS unsigned char* lds, int l, int pm, int wave, int lane) {
    bf16_t* Z = (bf16_t*)(P.ws + WS_Z);
    const int r16 = lane & 15, g = lane >> 4;
    const int row0 = pm * 256, b = row0 / SEQ, s0 = row0 % SEQ;
    bf16_t* zb = Z + (size_t)b * SEQ * ZLD;
    const LAS float* lut = (const LAS float*)lds;
    LAS unsigned char* vbase = lds + 22 * LUTN * 4 + wave * (2 * VBUF);
    for (int ua = wave; ua < 96; ua += 8) {
        const int h = ua >> 4, rho = ua & 15;
        const int posq = s0 + rho + 16 * r16;
        bf16x8 qf[1][2];
        { const bf16_t* qp = zb + (size_t)posq * ZLD + QA + 64 * h + 8 * g; qf[0][0] = *(const bf16x8*)qp; qf[0][1] = *(const bf16x8*)(qp + 32); }
        float m[1] = {-1e20f}, lsum[1] = {0.f}; f32x4 o[1][4];
#pragma unroll
        for (int c4 = 0; c4 < 4; ++c4) o[0][c4] = zero4();
        { const int U0 = s0 >> 4;
          attn_cfg<1>(zb, KA + 64 * h, VA + 64 * h, 16, rho, U0 - 64, 5, U0 + r16, lut + (0 * 6 + h) * LUTN, nullptr, qf, m, lsum, o, vbase, lane); }
        { const int U0 = (s0 >> 2) + (rho >> 2);
          attn_cfg<1>(zb, KA + 64 * h, VA + 64 * h, 4, rho & 3, U0 - 64, 6, U0 + 4 * r16, lut + (1 * 6 + h) * LUTN, nullptr, qf, m, lsum, o, vbase, lane); }
        { const int U0 = s0 + rho;
          attn_cfg<1>(zb, KA + 64 * h, VA + 64 * h, 1, 0, U0 - 64, 12, U0 + 16 * r16, lut + (2 * 6 + h) * LUTN, nullptr, qf, m, lsum, o, vbase, lane); }
        float lt = lsum[0]; lt += __shfl_xor(lt, 16); lt += __shfl_xor(lt, 32);
        const float inv = 1.f / lt;
        bf16_t* yp = zb + (size_t)posq * ZLD + QA + 64 * h + 4 * g;
#pragma unroll
        for (int c4 = 0; c4 < 4; ++c4) { const f32x4 v = o[0][c4] * inv; u32x2 w; w.x = pk2(v[0], v[1]); w.y = pk2(v[2], v[3]); *(u32x2*)(yp + 16 * c4) = w; }
    }
    for (int ub = wave; ub < 32; ub += 8) {
        const int kvh = ub >> 4, qg = ub & 15;
        const int posq = s0 + 16 * qg + r16;
        bf16x8 qf[2][2];
#pragma unroll
        for (int hh = 0; hh < 2; ++hh) { const bf16_t* qp = zb + (size_t)posq * ZLD + QB + 64 * (2 * kvh + hh) + 8 * g; qf[hh][0] = *(const bf16x8*)qp; qf[hh][1] = *(const bf16x8*)(qp + 32); }
        float m[2] = {-1e20f, -1e20f}, lsum[2] = {0.f, 0.f}; f32x4 o[2][4];
#pragma unroll
        for (int hh = 0; hh < 2; ++hh)
#pragma unroll
            for (int c4 = 0; c4 < 4; ++c4) o[hh][c4] = zero4();
        const int U0 = s0 + 16 * qg;
        attn_cfg<2>(zb, KB + 64 * kvh, VB + 64 * kvh, 1, 0, U0 - 128, 9, U0 + r16, lut + (18 + 2 * kvh) * LUTN, lut + (18 + 2 * kvh + 1) * LUTN, qf, m, lsum, o, vbase, lane);
#pragma unroll
        for (int hh = 0; hh < 2; ++hh) { const int hq = 2 * kvh + hh;
            float lt = lsum[hh]; lt += __shfl_xor(lt, 16); lt += __shfl_xor(lt, 32);
            const float sk = P.sink[l * 4 + hq] * LOG2E, mf = fmaxf(m[hh], sk), sc = ex2(m[hh] - mf);
            const float den = lt * sc + ex2(sk - mf), f = sc / den;
            bf16_t* yp = zb + (size_t)posq * ZLD + QB + 64 * hq + 4 * g;
#pragma unroll
            for (int c4 = 0; c4 < 4; ++c4) { const f32x4 v = o[hh][c4] * f; u32x2 w; w.x = pk2(v[0], v[1]); w.y = pk2(v[2], v[3]); *(u32x2*)(yp + 16 * c4) = w; } }
    }
}

DI float logsig(float x) { return fminf(x, 0.f) - log1pf(fexp(-fabsf(x))); }
DI float scan_add_up(float v, int lane) {
#pragma unroll
    for (int o = 1; o < 64; o <<= 1) { const float t = __shfl_up(v, o); if (lane >= o) v += t; }
    return v;
}
DI float scan_add_down(float v, int lane) {
#pragma unroll
    for (int o = 1; o < 64; o <<= 1) { const float t = __shfl_down(v, o); if (lane + o < 64) v += t; }
    return v;
}
DI float scan_max_up(float v, int lane) {
#pragma unroll
    for (int o = 1; o < 64; o <<= 1) { const float t = __shfl_up(v, o); if (lane >= o) v = fmaxf(v, t); }
    return v;
}
DI float scan_max_down(float v, int lane) {
#pragma unroll
    for (int o = 1; o < 64; o <<= 1) { const float t = __shfl_down(v, o); if (lane + o < 64) v = fmaxf(v, t); }
    return v;
}

DI void conv8(const bf16_t* __restrict__ zb, int s, int col, const float* __restrict__ cw  , int lane, float (&acc)[8][8]) {
    const int r8 = lane >> 3;
    float w[5][8];
#pragma unroll
    for (int j = 0; j < 5; ++j) { const f32x4 a = *(const f32x4*)(cw + j * 768), b = *(const f32x4*)(cw + j * 768 + 4);
        w[j][0] = a[0]; w[j][1] = a[1]; w[j][2] = a[2]; w[j][3] = a[3]; w[j][4] = b[0]; w[j][5] = b[1]; w[j][6] = b[2]; w[j][7] = b[3]; }
#pragma unroll
    for (int k = 0; k < 8; ++k)
#pragma unroll
        for (int e = 0; e < 8; ++e) acc[k][e] = 0.f;
#pragma unroll
    for (int rr = -2; rr < 10; ++rr) {
        const int pos = s + 8 * r8 + rr;
        u32x4 raw = {0u, 0u, 0u, 0u};
        if ((unsigned)pos < (unsigned)SEQ) raw = *(const u32x4*)(zb + (size_t)pos * ZLD + col);
        float x[8] = {bflo(raw.x), bfhi(raw.x), bflo(raw.y), bfhi(raw.y), bflo(raw.z), bfhi(raw.z), bflo(raw.w), bfhi(raw.w)};
#pragma unroll
        for (int k = 0; k < 8; ++k) { const int j = rr - k + 2;
            if (j >= 0 && j <= 4) {
#pragma unroll
                for (int e = 0; e < 8; ++e) acc[k][e] += w[j][e] * x[e]; } }
    }
#pragma unroll
    for (int k = 0; k < 8; ++k)
#pragma unroll
        for (int e = 0; e < 8; ++e) { const float a = acc[k][e]; acc[k][e] = a * sigmoidf_(a); }
}

DI void mlstm_state_phase(const KParams& P, LAS unsigned char* lds, int l, int pm, int wave, int lane) {
    bf16_t* Z = (bf16_t*)(P.ws + WS_Z);
    const float* gates = (const float*)(P.ws + WS_GATES);
    bf16_t* qconv = (bf16_t*)(P.ws + WS_QCONV); bf16_t* kconv = (bf16_t*)(P.ws + WS_KCONV);
    bf16_t* CT = (bf16_t*)(P.ws + WS_CT); bf16_t* nbuf = (bf16_t*)(P.ws + WS_NB);
    float* mloc = (float*)(P.ws + WS_ML); float* blast = (float*)(P.ws + WS_BL);
    const float* gb = P.gate_bias + l * 24;
    const int r16 = lane & 15, g = lane >> 4, q4 = r16 >> 2, p4 = r16 & 3, r8 = lane >> 3, pc = lane & 7;
    LAS unsigned char* kbuf = lds + wave * (2 * 64 * VROW);
    LAS unsigned char* vbuf = kbuf + 64 * VROW;
    for (int um = wave; um < 24; um += 8) {
        asm volatile("" : "+v"(lane));
        const int cc = um / 6, h = um % 6;
        const int tc = pm * 256 + 64 * cc, b = tc / SEQ, s = tc % SEQ, ci = s >> 6;
        const bf16_t* zb = Z + (size_t)b * SEQ * ZLD;
        const float* G = gates + (size_t)(tc + lane) * 24;
        const float igf = G[h] + gb[h], fgf = G[6 + h] + gb[6 + h], igb = G[12 + h] + gb[12 + h], fgb = G[18 + h] + gb[18 + h];
        const float bfw = scan_add_up(logsig(fgf), lane), bbw = scan_add_down(logsig(fgb), lane);
        const float blf = __shfl(bfw, 63), blb = __shfl(bbw, 0);
        const float wf = blf - bfw + igf, wb = blb - bbw + igb;
        const float mlf = wave_max(wf), mlb = wave_max(wb);
        const float ef = fexp(wf - mlf), eb = fexp(wb - mlb);
        const int slot_f = ((0 * NB + b) * 6 + h) * NCH + ci, slot_b = ((1 * NB + b) * 6 + h) * NCH + ci;
        if (lane == 0) { mloc[slot_f] = mlf; blast[slot_f] = blf; mloc[slot_b] = mlb; blast[slot_b] = blb; }
        float acc[8][8];
        conv8(zb, s, QC + 64 * h + 8 * pc, P.qk_conv + (size_t)l * 5 * 768 + 64 * h + 8 * pc, lane, acc);
#pragma unroll
        for (int k = 0; k < 8; ++k) { u32x4 w; w.x = pk2(acc[k][0], acc[k][1]); w.y = pk2(acc[k][2], acc[k][3]); w.z = pk2(acc[k][4], acc[k][5]); w.w = pk2(acc[k][6], acc[k][7]);
            *(u32x4*)(qconv + (size_t)(tc + 8 * r8 + k) * 384 + 64 * h + 8 * pc) = w; }
        conv8(zb, s, KC + 64 * h + 8 * pc, P.qk_conv + (size_t)l * 5 * 768 + 384 + 64 * h + 8 * pc, lane, acc);
        u32x4 kpk[8];
#pragma unroll
        for (int k = 0; k < 8; ++k) {
#pragma unroll
            for (int e = 0; e < 8; ++e) acc[k][e] *= 0.125f;
            u32x4 w; w.x = pk2(acc[k][0], acc[k][1]); w.y = pk2(acc[k][2], acc[k][3]); w.z = pk2(acc[k][4], acc[k][5]); w.w = pk2(acc[k][6], acc[k][7]);
            kpk[k] = w;
            *(u32x4*)(kconv + (size_t)(tc + 8 * r8 + k) * 384 + 64 * h + 8 * pc) = w; }
#pragma unroll
        for (int k = 0; k < 8; ++k) { const int id = lane + 64 * k, row = id >> 3, c16 = id & 7;
            *(LAS u32x4*)(vbuf + row * VROW + 16 * c16) = *(const u32x4*)(zb + (size_t)(s + row) * ZLD + VC + 64 * h + 8 * c16); }
#pragma unroll
        for (int dir = 0; dir < 2; ++dir) {
            const float ed = dir ? eb : ef;
#pragma unroll
            for (int k = 0; k < 8; ++k) { const float e = __shfl(ed, 8 * r8 + k); const u32x4 kk = kpk[k];
                u32x4 w; w.x = pk2(bflo(kk.x) * e, bfhi(kk.x) * e); w.y = pk2(bflo(kk.y) * e, bfhi(kk.y) * e); w.z = pk2(bflo(kk.z) * e, bfhi(kk.z) * e); w.w = pk2(bflo(kk.w) * e, bfhi(kk.w) * e);
                *(LAS u32x4*)(kbuf + (8 * r8 + k) * VROW + 16 * pc) = w; }
            WAVE_LDS_FENCE();
            f32x4 c[4][5];
#pragma unroll
            for (int dt = 0; dt < 4; ++dt)
#pragma unroll
                for (int et = 0; et < 5; ++et) c[dt][et] = zero4();
#pragma unroll
            for (int ks = 0; ks < 2; ++ks) {
                bf16x8 af[4], bfr[5];
#pragma unroll
                for (int t4 = 0; t4 < 4; ++t4) {
                    af[t4] = cat8(trread(kbuf + (32 * ks + 8 * g + q4) * VROW + 32 * t4 + 8 * p4), trread(kbuf + (32 * ks + 8 * g + 4 + q4) * VROW + 32 * t4 + 8 * p4));
                    bfr[t4] = cat8(trread(vbuf + (32 * ks + 8 * g + q4) * VROW + 32 * t4 + 8 * p4), trread(vbuf + (32 * ks + 8 * g + 4 + q4) * VROW + 32 * t4 + 8 * p4)); }
                { const short one = r16 == 0 ? (short)0x3F80 : (short)0; bfr[4] = (bf16x8){one, one, one, one, one, one, one, one}; }
#pragma unroll
                for (int dt = 0; dt < 4; ++dt)
#pragma unroll
                    for (int et = 0; et < 5; ++et) c[dt][et] = mfma16(af[dt], bfr[et], c[dt][et]);
            }
            const int slot = dir ? slot_b : slot_f;
            bf16_t* ct = CT + (size_t)slot * 4096;
#pragma unroll
            for (int dt = 0; dt < 4; ++dt) {
#pragma unroll
                for (int et = 0; et < 4; ++et) { const f32x4 v = c[dt][et]; u32x2 w; w.x = pk2(v[0], v[1]); w.y = pk2(v[2], v[3]); *(u32x2*)(ct + (16 * et + r16) * 64 + 16 * dt + 4 * g) = w; }
                if (r16 == 0) { const f32x4 v = c[dt][4]; u32x2 w; w.x = pk2(v[0], v[1]); w.y = pk2(v[2], v[3]); *(u32x2*)(nbuf + (size_t)slot * 64 + 16 * dt + 4 * g) = w; } }
            WAVE_LDS_FENCE();
        }
    }
}

DI void mlstm_scan_phase(const KParams& P, int bid, int G, int tid) {
    bf16_t* CT = (bf16_t*)(P.ws + WS_CT); bf16_t* nbuf = (bf16_t*)(P.ws + WS_NB);
    const float* mloc = (const float*)(P.ws + WS_ML); const float* blast = (const float*)(P.ws + WS_BL); float* mprev = (float*)(P.ws + WS_MP);
    constexpr int NITEM = NSEQ * 8 + NSEQ;
    for (int it0 = bid; it0 < NITEM; it0 += 3 * G) {
        bf16_t* ptr[3]; int seqs[3]; int strd[3]; bool act[3], wm[3];
#pragma unroll
        for (int k = 0; k < 3; ++k) { const int it = it0 + k * G;
            if (it < NSEQ * 8) { seqs[k] = it >> 3; ptr[k] = CT + (size_t)seqs[k] * NCH * 4096 + (it & 7) * 512 + tid; strd[k] = 4096; act[k] = true; wm[k] = ((it & 7) == 0) && tid == 0; }
            else if (it < NITEM) { seqs[k] = it - NSEQ * 8; ptr[k] = nbuf + (size_t)seqs[k] * NCH * 64 + (tid & 63); strd[k] = 64; act[k] = tid < 64; wm[k] = false; }
            else { seqs[k] = 0; ptr[k] = CT; strd[k] = 0; act[k] = false; wm[k] = false; } }
        float C[3] = {0.f, 0.f, 0.f}, m[3] = {0.f, 0.f, 0.f};
        for (int st0 = 0; st0 < NCH; st0 += 4) {
            float cl[3][4], bl[3][4], ml[3][4];
#pragma unroll
            for (int k = 0; k < 3; ++k)
#pragma unroll
                for (int j = 0; j < 4; ++j) { const int dirb = seqs[k] >= NSEQ / 2; const int c = dirb ? (NCH - 1 - (st0 + j)) : (st0 + j);
                    cl[k][j] = act[k] ? bf2f(ptr[k][(size_t)c * strd[k]]) : 0.f; bl[k][j] = blast[seqs[k] * NCH + c]; ml[k][j] = mloc[seqs[k] * NCH + c]; }
#pragma unroll
            for (int k = 0; k < 3; ++k)
#pragma unroll
                for (int j = 0; j < 4; ++j) { const int dirb = seqs[k] >= NSEQ / 2; const int c = dirb ? (NCH - 1 - (st0 + j)) : (st0 + j);
                    if (act[k]) ptr[k][(size_t)c * strd[k]] = (bf16_t)(pk2(C[k], 0.f) & 0xffffu);
                    if (wm[k]) mprev[seqs[k] * NCH + c] = m[k];
                    const float mn = fmaxf(bl[k][j] + m[k], ml[k][j]); const float a = fexp(bl[k][j] + m[k] - mn), cc = fexp(ml[k][j] - mn);
                    C[k] = a * C[k] + cc * cl[k][j]; m[k] = mn; }
        }
    }
}

DI void mlstm_out_phase(const KParams& P, LAS unsigned char* lds, int l, int pm, int wave, int lane) {
    bf16_t* Z = (bf16_t*)(P.ws + WS_Z);
    const float* gates = (const float*)(P.ws + WS_GATES);
    const bf16_t* qconv = (const bf16_t*)(P.ws + WS_QCONV); const bf16_t* kconv = (const bf16_t*)(P.ws + WS_KCONV);
    const bf16_t* CT = (const bf16_t*)(P.ws + WS_CT); const bf16_t* nbuf = (const bf16_t*)(P.ws + WS_NB);
    const float* mprev = (const float*)(P.ws + WS_MP);
    const float* gb = P.gate_bias + l * 24;
    const int r16 = lane & 15, g = lane >> 4, q4 = r16 >> 2, p4 = r16 & 3;
    LAS unsigned char* vbuf = lds + wave * (64 * VROW + 2048);
    LAS float* tab = (LAS float*)(vbuf + 64 * VROW);
    for (int um = wave; um < 24; um += 8) {
        asm volatile("" : "+v"(lane));
        const int cc = um / 6, h = um % 6;
        const int tc = pm * 256 + 64 * cc, b = tc / SEQ, s = tc % SEQ, ci = s >> 6;
        bf16_t* zb = Z + (size_t)b * SEQ * ZLD;
        const int slot_f = ((0 * NB + b) * 6 + h) * NCH + ci, slot_b = ((1 * NB + b) * 6 + h) * NCH + ci;
        {
            const float* G = gates + (size_t)(tc + lane) * 24;
            const float igf = G[h] + gb[h], fgf = G[6 + h] + gb[6 + h], igb = G[12 + h] + gb[12 + h], fgb = G[18 + h] + gb[18 + h];
            const float bfw = scan_add_up(logsig(fgf), lane), bbw = scan_add_down(logsig(fgb), lane);
            const float gf = igf - bfw, gbk = igb - bbw;
            const float pmf = scan_max_up(gf, lane), pmb = scan_max_down(gbk, lane);
            const float mpf = mprev[slot_f], mpb = mprev[slot_b];
            const float Mf = fmaxf(pmf, mpf), Mb = fmaxf(pmb, mpb);
            tab[0 * 64 + lane] = gf; tab[1 * 64 + lane] = gbk; tab[2 * 64 + lane] = Mf; tab[3 * 64 + lane] = Mb;
            tab[4 * 64 + lane] = fexp(mpf - Mf); tab[5 * 64 + lane] = fexp(mpb - Mb); tab[6 * 64 + lane] = fexp(-(bfw + Mf)); tab[7 * 64 + lane] = fexp(-(bbw + Mb));
        }
#pragma unroll
        for (int k = 0; k < 8; ++k) { const int id = lane + 64 * k, row = id >> 3, c16 = id & 7;
            *(LAS u32x4*)(vbuf + row * VROW + 16 * c16) = *(const u32x4*)(zb + (size_t)(s + row) * ZLD + VC + 64 * h + 8 * c16); }
        bf16x8 kfr[4][2];
#pragma unroll
        for (int st = 0; st < 4; ++st) { const bf16_t* kp = kconv + (size_t)(tc + 16 * st + r16) * 384 + 64 * h + 8 * g; kfr[st][0] = *(const bf16x8*)kp; kfr[st][1] = *(const bf16x8*)(kp + 32); }
        WAVE_LDS_FENCE();
        for (int tt = 0; tt < 4; ++tt) {
            const int tau = 16 * tt + r16;
            bf16x8 qfr[2];
            { const bf16_t* qp = qconv + (size_t)(tc + tau) * 384 + 64 * h + 8 * g; qfr[0] = *(const bf16x8*)qp; qfr[1] = *(const bf16x8*)(qp + 32); }
            f32x4 S[4];
#pragma unroll
            for (int st = 0; st < 4; ++st) { S[st] = (f32x4){0.f, 0.f, 0.f, 0.f}; S[st] = mfma16(kfr[st][0], qfr[0], S[st]); S[st] = mfma16(kfr[st][1], qfr[1], S[st]); }
            f32x4 hs[4];
#pragma unroll
            for (int et = 0; et < 4; ++et) hs[et] = zero4();
#pragma unroll
            for (int dir = 0; dir < 2; ++dir) {
                const float Mt = tab[(2 + dir) * 64 + tau], at = tab[(4 + dir) * 64 + tau], flt = tab[(6 + dir) * 64 + tau];
                bf16x8 pfr[2];
#pragma unroll
                for (int kp = 0; kp < 2; ++kp) { float pv[8];
#pragma unroll
                    for (int hf = 0; hf < 2; ++hf) { const int st = 2 * kp + hf; const f32x4 gs = *(const LAS f32x4*)(tab + dir * 64 + 16 * st + 4 * g);
#pragma unroll
                        for (int i = 0; i < 4; ++i) { const int sg = 16 * st + 4 * g + i; const bool ok = dir ? (sg >= tau) : (sg <= tau);
                            const float e = fexp(gs[i] - Mt) * S[st][i]; pv[4 * hf + i] = ok ? e : 0.f; } }
                    u32x4 pw; pw.x = pk2(pv[0], pv[1]); pw.y = pk2(pv[2], pv[3]); pw.z = pk2(pv[4], pv[5]); pw.w = pk2(pv[6], pv[7]); pfr[kp] = __builtin_bit_cast(bf16x8, pw); }
                f32x4 intra[5], inter[5];
#pragma unroll
                for (int et = 0; et < 5; ++et) { intra[et] = zero4(); inter[et] = zero4(); }
                const int slot = dir ? slot_b : slot_f;
                const bf16_t* ct = CT + (size_t)slot * 4096;
#pragma unroll
                for (int kp = 0; kp < 2; ++kp) {
#pragma unroll
                    for (int et = 0; et < 4; ++et) { const bf16x8 vf = cat8(trread(vbuf + (32 * kp + 4 * g + q4) * VROW + 32 * et + 8 * p4), trread(vbuf + (32 * kp + 16 + 4 * g + q4) * VROW + 32 * et + 8 * p4));
                        intra[et] = mfma16(vf, pfr[kp], intra[et]); }
                    { const short one = r16 == 0 ? (short)0x3F80 : (short)0; const bf16x8 of = {one, one, one, one, one, one, one, one}; intra[4] = mfma16(of, pfr[kp], intra[4]); }
#pragma unroll
                    for (int et = 0; et < 4; ++et) { const bf16x8 cf = *(const bf16x8*)(ct + (16 * et + r16) * 64 + 32 * kp + 8 * g); inter[et] = mfma16(cf, qfr[kp], inter[et]); }
                    { bf16x8 nf = {0, 0, 0, 0, 0, 0, 0, 0}; if (r16 == 0) nf = *(const bf16x8*)(nbuf + (size_t)slot * 64 + 32 * kp + 8 * g); inter[4] = mfma16(nf, qfr[kp], inter[4]); }
                }
                const float dintra = __shfl(intra[4][0], r16), dinter = __shfl(inter[4][0], r16);
                const float den = dintra + at * dinter;
                const float inv = 1.f / fmaxf(fabsf(den), flt);
#pragma unroll
                for (int et = 0; et < 4; ++et) hs[et] += (intra[et] + inter[et] * at) * inv;
            }
            float ss = 0.f;
#pragma unroll
            for (int et = 0; et < 4; ++et) ss += (hs[et][0] * hs[et][0] + hs[et][1] * hs[et][1]) + (hs[et][2] * hs[et][2] + hs[et][3] * hs[et][3]);
            ss += __shfl_xor(ss, 16); ss += __shfl_xor(ss, 32);
            const float rn = 1.f / sqrtf(ss * (1.f / 64.f) + EPS);
            bf16_t* zr = zb + (size_t)(s + tau) * ZLD;
#pragma unroll
            for (int et = 0; et < 4; ++et) { const int e0 = 64 * h + 16 * et + 4 * g;
                const u32x2 ov = *(const u32x2*)(zr + OC + e0); const f32x4 ng = *(const f32x4*)(P.mlstm_norm + l * 384 + e0);
                const float y0 = hs[et][0] * rn * ng[0] * sigmoidf_(bflo(ov.x)), y1 = hs[et][1] * rn * ng[1] * sigmoidf_(bfhi(ov.x));
                const float y2 = hs[et][2] * rn * ng[2] * sigmoidf_(bflo(ov.y)), y3 = hs[et][3] * rn * ng[3] * sigmoidf_(bfhi(ov.y));
                u32x2 w; w.x = pk2(y0, y1); w.y = pk2(y2, y3); *(u32x2*)(zr + QC + e0) = w; }
        }
        WAVE_LDS_FENCE();
    }
}

#ifndef SKIP_ATTN
#define SKIP_ATTN 0
#endif
#ifndef SKIP_MLSTM
#define SKIP_MLSTM 0
#endif

__global__ void __launch_bounds__(512, 2) fwd_kernel(KParams P) {
    extern __shared__ __attribute__((aligned(16))) unsigned char lds_raw[];
    LAS unsigned char* lds = (LAS unsigned char*)lds_raw;
    cg::grid_group grid = cg::this_grid();
    const int G = gridDim.x, bx = blockIdx.x;
    if (G != 256) return;
    const int pm0 = (bx & 7) * 32 + (bx >> 3);
#define FRESH_IDS int tid = threadIdx.x; asm volatile("" : "+v"(tid)); const int lane = tid & 63, wave = __builtin_amdgcn_readfirstlane(tid >> 6); int pm = pm0; asm volatile("" : "+s"(pm)); (void)lane; (void)wave; (void)pm;
    bf16_t* Wall = (bf16_t*)(P.ws + WS_W);
    bf16_t* PB = (bf16_t*)(P.ws + WS_PB);
    float* gates = (float*)(P.ws + WS_GATES);
    float* rs = (float*)(P.ws + WS_RS);
    bf16_t* XBA = (bf16_t*)(P.ws + WS_XBA); bf16_t* XBB = (bf16_t*)(P.ws + WS_XBB);
    bf16_t* Z = (bf16_t*)(P.ws + WS_Z);
    LAS float* ssq = (LAS float*)(lds + SSQ_OFF);
#define ZERO_SSQ() do { FRESH_IDS; if (tid < 256) { *(LAS f32x4*)(ssq + tid * 4) = zero4(); } } while (0)
#define WRITE_RS() do { FRESH_IDS; if (tid < 256) { const float s_ = (ssq[tid * 4] + ssq[tid * 4 + 1]) + (ssq[tid * 4 + 2] + ssq[tid * 4 + 3]); rs[pm * 256 + tid] = 1.f / sqrtf(s_ * (1.f / DM) + EPS); } } while (0)

    { FRESH_IDS;
      prep_weights(P, lds, bx * 8 + wave, G * 8, wave, lane);
      for (int rr = wave; rr < 256; rr += 8) { const size_t row = (size_t)pm * 256 + rr;
        const f32x4* xr = (const f32x4*)(P.x + row * DM) + lane; f32x4 v[4]; float s = 0.f;
#pragma unroll
        for (int j = 0; j < 4; ++j) { v[j] = xr[64 * j]; s += (v[j][0] * v[j][0] + v[j][1] * v[j][1]) + (v[j][2] * v[j][2] + v[j][3] * v[j][3]); }
        s = wave_sum(s);
        u32x2* o = (u32x2*)(XBA + row * DM) + lane;
#pragma unroll
        for (int j = 0; j < 4; ++j) { u32x2 w; w.x = pk2(v[j][0], v[j][1]); w.y = pk2(v[j][2], v[j][3]); o[64 * j] = w; }
        if (lane == 0) rs[row] = 1.f / sqrtf(s * (1.f / DM) + EPS); } }
    grid.sync();

    for (int l = 0; l < DEPTH; ++l) {
        bf16_t* Wl = Wall + (size_t)l * LAYER_W;
        { pg8::Gemm g{XBA, Wl + OFF_WIN, DM, DM}; pg8::RowOrder S{pm0, NIN_PAD / 256}; pg8::EpiZ E{Z, gates, rs};
          pg8::gemm_phase<pg8::EpiZ, pg8::RowOrder>(lds, g, S, E); }
        grid.sync();
        if (!SKIP_ATTN) { FRESH_IDS;
            build_lut(P, lds, tid);
            __syncthreads();
            attention_phase(P, lds, l, pm, wave, lane);
        }
        __syncthreads();
        if (!SKIP_MLSTM) { FRESH_IDS; mlstm_state_phase(P, lds, l, pm, wave, lane); }
        grid.sync();
        if (!SKIP_MLSTM) { FRESH_IDS; mlstm_scan_phase(P, bx, G, tid); }
        grid.sync();
        if (!SKIP_MLSTM) { FRESH_IDS; mlstm_out_phase(P, lds, l, pm, wave, lane); }
        ZERO_SSQ();
        LOCAL_SEAM();
        { pg8::Gemm g{Z, Wl + OFF_WOUT, ZLD, DM}; pg8::RowOrder S{pm0, 4}; pg8::EpiResid<false> E{l == 0 ? P.x : P.out, P.out, XBA, nullptr, ssq};
          pg8::gemm_phase<pg8::EpiResid<false>, pg8::RowOrder>(lds, g, S, E); }
        __syncthreads();
        WRITE_RS();
        LOCAL_SEAM();
        { pg8::Gemm g{XBA, Wl + OFF_WUP, DM, DM}; pg8::RowOrder S{pm0, NUP / 256}; pg8::EpiSwiGLU E{Z, rs};
          pg8::gemm_phase<pg8::EpiSwiGLU, pg8::RowOrder>(lds, g, S, E); }
        ZERO_SSQ();
        LOCAL_SEAM();
        { pg8::Gemm g{Z + ACT_OFF, Wl + OFF_WDOWN, ZLD, DFF}; pg8::RowOrder S{pm0, 4}; pg8::EpiResid<false> E{P.out, P.out, XBB, nullptr, ssq};
          pg8::gemm_phase<pg8::EpiResid<false>, pg8::RowOrder>(lds, g, S, E); }
        { FRESH_IDS;
          for (int rr = wave; rr < 256; rr += 8) { const size_t row = (size_t)pm * 256 + rr;
            const f32x4 v = *((const f32x4*)(P.p + ((size_t)l * MTOK + row) * PLE) + lane); u32x2 w; w.x = pk2(v[0], v[1]); w.y = pk2(v[2], v[3]); *((u32x2*)(PB + row * PLE) + lane) = w; } }
        LOCAL_SEAM();
        { pg8::Gemm g{XBB, Wl + OFF_WG, DM, DM}; pg8::RowOrder S{pm0, 4}; pg8::EpiSigmoid E{Z};
          pg8::gemm_phase<pg8::EpiSigmoid, pg8::RowOrder>(lds, g, S, E); }
        ZERO_SSQ();
        LOCAL_SEAM();
        { pg8::Gemm g{PB, Wl + OFF_WP, PLE, PLE}; pg8::RowOrder S{pm0, 4}; pg8::EpiResid<true> E{P.out, P.out, XBA, Z, ssq};
          pg8::gemm_phase<pg8::EpiResid<true>, pg8::RowOrder>(lds, g, S, E); }
        __syncthreads();
        WRITE_RS();
        LOCAL_SEAM();
    }
    { FRESH_IDS;
      for (int rr = wave; rr < 256; rr += 8) { const size_t row = (size_t)pm * 256 + rr; const float sc = rs[row];
        f32x4* xr = (f32x4*)(P.out + row * DM) + lane; const f32x4* gr = (const f32x4*)P.final_norm + lane;
#pragma unroll
        for (int j = 0; j < 4; ++j) xr[64 * j] = xr[64 * j] * sc * gr[64 * j]; } }
}

extern "C" void kernel_launch(void* const* d_in, const int* in_sizes, int n_in, void* d_out, int out_size, void* d_ws, size_t ws_size, hipStream_t stream) {
    static int ready = 0;
    if (ready == 0) {
        if (n_in != 16 || out_size != MTOK * DM || ws_size < WS_END) { fprintf(stderr, "kernel_launch: unexpected sizes (n_in %d, out %d, ws %zu)\n", n_in, out_size, ws_size); ready = -1; return; }
        if (hipFuncSetAttribute((const void*)fwd_kernel, hipFuncAttributeMaxDynamicSharedMemorySize, LDS_BYTES) != hipSuccess) { fprintf(stderr, "kernel_launch: hipFuncSetAttribute failed\n"); ready = -1; return; }
        int dev = 0, cus = 0, per_cu = 0;
        (void)hipGetDevice(&dev); (void)hipDeviceGetAttribute(&cus, hipDeviceAttributeMultiprocessorCount, dev);
        (void)hipOccupancyMaxActiveBlocksPerMultiprocessor(&per_cu, (const void*)fwd_kernel, 512, LDS_BYTES);
        if (cus != 256 || per_cu < 1) fprintf(stderr, "kernel_launch: note: %d CUs, %d blocks/CU (kernel expects 256 x 1)\n", cus, per_cu);
        (void)hipGetLastError();
        ready = 1;
    }
    if (ready < 0) return;
    KParams P{};
    P.x = (const float*)d_in[0]; P.p = (const float*)d_in[1]; P.rel_bias = (const float*)d_in[2]; P.attn_norm = (const float*)d_in[3]; P.w_in = (const float*)d_in[4];
    P.qk_conv = (const float*)d_in[5]; P.gate_bias = (const float*)d_in[6]; P.sink = (const float*)d_in[7]; P.mlstm_norm = (const float*)d_in[8]; P.w_out = (const float*)d_in[9];
    P.ffn_norm = (const float*)d_in[10]; P.w_up = (const float*)d_in[11]; P.w_down = (const float*)d_in[12]; P.ple_proj = (const float*)d_in[13]; P.ple_gate = (const float*)d_in[14];
    P.final_norm = (const float*)d_in[15]; P.out = (float*)d_out; P.ws = (unsigned char*)d_ws;
    void* args[] = {&P};
    hipError_t e = hipLaunchCooperativeKernel((const void*)fwd_kernel, dim3(256), dim3(512), args, LDS_BYTES, stream);
    if (e != hipSuccess) fprintf(stderr, "kernel_launch: cooperative launch failed: %s\n", hipGetErrorString(e));
}
```

```cpp
#include <hip/hip_runtime.h>
#include <hip/hip_cooperative_groups.h>
#include <cstdio>
#include <cstdint>
namespace cg = cooperative_groups;

#define LAS __attribute__((address_space(3)))
#define DI __device__ __forceinline__
typedef unsigned short bf16_t;
typedef short bf16x8 __attribute__((ext_vector_type(8)));
typedef short s16x4 __attribute__((ext_vector_type(4)));
typedef float f32x4 __attribute__((ext_vector_type(4)));
typedef float f32x2 __attribute__((ext_vector_type(2)));
typedef unsigned u32x4 __attribute__((ext_vector_type(4)));
typedef unsigned u32x2 __attribute__((ext_vector_type(2)));
typedef __bf16 bf16v2 __attribute__((ext_vector_type(2)));

constexpr int NB = 8, SEQ = 8192, DM = 1024, DEPTH = 4, MTOK = NB * SEQ;
constexpr int ZLD = 3200, NIN_PAD = 3328, DFF = 2816, NUP = 2 * DFF, PLE = 256, DIN = 3224;
constexpr int QA = 0, QB = 384, QC = 640, KA = 1024, KB = 1408, KC = 1536, VA = 1920, VB = 2304, VC = 2432, OC = 2816;
constexpr int ACT_OFF = 384;
constexpr float LOG2E = 1.4426950408889634f;
constexpr float QSCALE = 0.125f * LOG2E;
constexpr float EPS = 1e-6f;
constexpr float NEGBIG = -1e30f;
constexpr int NSEQ = 2 * NB * 6, NCH = SEQ / 64;

constexpr size_t OFF_WIN = 0, OFF_WOUT = OFF_WIN + (size_t)NIN_PAD * DM, OFF_WUP = OFF_WOUT + (size_t)DM * DM, OFF_WDOWN = OFF_WUP + (size_t)NUP * DM,
                 OFF_WP = OFF_WDOWN + (size_t)DM * DFF, OFF_WG = OFF_WP + (size_t)DM * PLE, LAYER_W = OFF_WG + (size_t)DM * DM;
constexpr size_t MiB = 1u << 20;
constexpr size_t WS_W = 1 * MiB, WS_PB = 112 * MiB, WS_GATES = 144 * MiB, WS_RS = 150 * MiB, WS_NB = 151 * MiB, WS_ML = 153 * MiB, WS_BL = WS_ML + 256 * 1024,
                 WS_MP = WS_ML + 512 * 1024, WS_QCONV = 154 * MiB, WS_KCONV = 202 * MiB, WS_XBA = 250 * MiB, WS_XBB = 378 * MiB, WS_Z = 506 * MiB, WS_CT = 906 * MiB,
                 WS_END = 1002 * MiB;
static_assert(WS_W + 4 * LAYER_W * 2 <= WS_PB, "weights");
static_assert(WS_Z + (size_t)MTOK * ZLD * 2 <= WS_CT, "z");
static_assert(WS_CT + (size_t)NSEQ * NCH * 4096 * 2 <= WS_END, "ct");

constexpr int LDS_BYTES = 155648;
constexpr int RING_BYTES = 131072, SSQ_OFF = 131072;

DI unsigned pk2(float lo, float hi) { f32x2 v = {lo, hi}; bf16v2 b = __builtin_convertvector(v, bf16v2); return __builtin_bit_cast(unsigned, b); }
DI float bf2f(unsigned short u) { return __uint_as_float(((unsigned)u) << 16); }
DI float bflo(unsigned u) { return __uint_as_float(u << 16); }
DI float bfhi(unsigned u) { return __uint_as_float(u & 0xffff0000u); }
DI float ex2(float x) { return __builtin_amdgcn_exp2f(x); }
DI float fexp(float x) { return __builtin_amdgcn_exp2f(x * LOG2E); }
DI float frcp(float x) { return __builtin_amdgcn_rcpf(x); }
DI float sigmoidf_(float x) { return frcp(1.f + fexp(-x)); }
DI f32x4 mfma16(bf16x8 a, bf16x8 b, f32x4 c) { return __builtin_amdgcn_mfma_f32_16x16x32_bf16(a, b, c, 0, 0, 0); }
DI f32x4 zero4() { float z; asm volatile("v_mov_b32 %0, 0" : "=v"(z)); return (f32x4){z, z, z, z}; }
DI s16x4 trread(LAS unsigned char* p) { return __builtin_amdgcn_ds_read_tr16_b64_v4i16((LAS s16x4*)p); }
DI bf16x8 cat8(s16x4 a, s16x4 b) { return __builtin_shufflevector(a, b, 0, 1, 2, 3, 4, 5, 6, 7); }
DI float shx(float v, int mask, int lane) { return __builtin_bit_cast(float, __builtin_amdgcn_ds_bpermute((lane ^ mask) << 2, __builtin_bit_cast(int, v))); }
DI float shi(float v, int idx) { return __builtin_bit_cast(float, __builtin_amdgcn_ds_bpermute(idx << 2, __builtin_bit_cast(int, v))); }
#define WAVE_LDS_FENCE() asm volatile("s_waitcnt lgkmcnt(0)" ::: "memory")
#define LOCAL_SEAM() do { asm volatile("s_waitcnt vmcnt(0) lgkmcnt(0)" ::: "memory"); __syncthreads(); __builtin_amdgcn_fence(__ATOMIC_ACQUIRE, "agent"); } while (0)

namespace pg8 {
constexpr int BM = 256, BK = 64, HALF = 128, HTB = HALF * BK * 2, STAGE_BYTES = 8 * HTB;
DI int lds_byte(int r, int c) { const int st = (r >> 4) * 2 + (c >> 5), rr = r & 15, cc = c & 31, ob = rr * 64 + cc * 2; return st * 1024 + (ob ^ (((ob >> 9) & 1) << 5)); }
DI void stage_rc(int b, int& R, int& C) { const int st = b / 1024, sb = b % 1024, swz = sb ^ (((sb >> 9) & 1) << 5); R = (st >> 1) * 16 + swz / 64; C = (st & 1) * 32 + (swz % 64) / 2; }
DI int perm32(int rho) { const int n = rho >> 4, i = rho & 15; return 8 * (i >> 2) + 4 * n + (i & 3); }
struct Unit { int pm, pn; };
struct Gemm { const bf16_t* A; const bf16_t* Bt; int lda, K; };
struct RowOrder {
    int pm, nN;
    DI bool next(int i, Unit& u) const { if (i >= nN) return false; u.pm = pm; u.pn = i; return true; }
};

template <class Epi, class Sched>
DI void gemm_phase(LAS unsigned char* lds, const Gemm g, const Sched& S, const Epi& E) {
    int tid = threadIdx.x; asm volatile("" : "+v"(tid));
    const int wid = __builtin_amdgcn_readfirstlane(tid >> 6), lane = tid & 63, wr = wid >> 2, wc = wid & 3, fr = lane & 15, fq = lane >> 4;
    const int K = g.K, nt = K / BK, lda = g.lda;
    unsigned voffA[2], voffB[2];
#pragma unroll
    for (int i = 0; i < 2; ++i) { int R, C; stage_rc(tid * 16 + i * 8192, R, C); const int Rb = Epi::PERM ? ((R & ~31) + perm32(R & 31)) : R;
        voffA[i] = (unsigned)(R * lda + C) * 2u; voffB[i] = (unsigned)(Rb * K + C) * 2u; }
    const size_t kstep = (size_t)(BK * 2);
    const size_t hsA = (size_t)HALF * lda * 2, hsB = (size_t)HALF * K * 2;
    const size_t tsA = 2 * hsA, tsB = 2 * hsB;
    const unsigned ldsw = (unsigned)wid * 1024u;
    const int aoff = lds_byte(wr * 64 + fr, fq * 8), boff = lds_byte(wc * 32 + fr, fq * 8);
#define PG8_SA(b, h) (((b) * 2 + (h)) * HTB)
#define PG8_SB(b, h) ((4 + (b) * 2 + (h)) * HTB)
#define PG8_STAGE(bufoff, gbase, voff) do { _Pragma("unroll") for (int _i = 0; _i < 2; ++_i) \
        __builtin_amdgcn_global_load_lds((const unsigned*)((const char*)(gbase) + (voff)[_i]), (LAS unsigned*)(lds + (bufoff) + ldsw + _i * 8192), 16, 0, 0); } while (0)
#define PG8_LDA(dst, b, h) do { _Pragma("unroll") for (int m = 0; m < 4; ++m) _Pragma("unroll") for (int k = 0; k < 2; ++k) dst[m][k] = *(const LAS bf16x8*)(lds + PG8_SA(b, h) + aoff + m * 2048 + k * 1024); } while (0)
#define PG8_LDB(dst, b, h) do { _Pragma("unroll") for (int n = 0; n < 2; ++n) _Pragma("unroll") for (int k = 0; k < 2; ++k) dst[n][k] = *(const LAS bf16x8*)(lds + PG8_SB(b, h) + boff + n * 2048 + k * 1024); } while (0)
#define PG8_MMA(ai, bj, At, Bt) do { __builtin_amdgcn_s_setprio(1); _Pragma("unroll") for (int m = 0; m < 4; ++m) _Pragma("unroll") for (int n = 0; n < 2; ++n) _Pragma("unroll") for (int k = 0; k < 2; ++k) \
        acc[ai][bj][m][n] = __builtin_amdgcn_mfma_f32_16x16x32_bf16(Bt[n][k], At[m][k], acc[ai][bj][m][n], 0, 0, 0); __builtin_amdgcn_s_setprio(0); } while (0)
#define PG8_WAIT_V(n) asm volatile("s_waitcnt vmcnt(" #n ")" ::: "memory")
#define PG8_WAIT_L(n) asm volatile("s_waitcnt lgkmcnt(" #n ")" ::: "memory")
#define PG8_BAR __builtin_amdgcn_s_barrier()
#define PG8_SCHED __builtin_amdgcn_sched_barrier(0)
    Unit cur, nxt; int ui = 0;
    if (!S.next(0, cur)) return;
    f32x4 acc[2][2][4][2];
    { float z0; asm volatile("v_mov_b32 %0, 0" : "=v"(z0));
#pragma unroll
    for (int a = 0; a < 2; ++a)
#pragma unroll
        for (int b = 0; b < 2; ++b)
#pragma unroll
            for (int m = 0; m < 4; ++m)
#pragma unroll
                for (int n = 0; n < 2; ++n) acc[a][b][m][n] = (f32x4){z0, z0, z0, z0}; }
    bf16x8 At[4][2], B0[2][2], B1[2][2];
    const char* cA = (const char*)g.A + (size_t)cur.pm * tsA; const char* cB = (const char*)g.Bt + (size_t)cur.pn * tsB;
    PG8_STAGE(PG8_SB(0, 0), cB, voffB); PG8_STAGE(PG8_SB(0, 1), cB + hsB, voffB); PG8_STAGE(PG8_SA(0, 0), cA, voffA); PG8_STAGE(PG8_SA(0, 1), cA + hsA, voffA);
    if (wr == 1) PG8_BAR;
    PG8_WAIT_V(2); PG8_BAR;
    PG8_STAGE(PG8_SB(1, 0), cB + kstep, voffB); PG8_STAGE(PG8_SA(1, 0), cA + kstep, voffA); PG8_STAGE(PG8_SB(1, 1), cB + hsB + kstep, voffB);
    PG8_WAIT_V(6); PG8_BAR;
    for (;;) {
        const bool has_next = S.next(ui + 1, nxt);
        const char* nA = has_next ? (const char*)g.A + (size_t)nxt.pm * tsA : cA; const char* nB = has_next ? (const char*)g.Bt + (size_t)nxt.pn * tsB : cB;
        for (int t = 0; t < nt; t += 2) {
            const bool last = (t == nt - 2);
            const char* a1 = cA + (size_t)(t + 1) * kstep;
            const char* a2 = last ? nA : cA + (size_t)(t + 2) * kstep; const char* b2 = last ? nB : cB + (size_t)(t + 2) * kstep;
            const char* a3 = a2 + kstep; const char* b3 = b2 + kstep;
            PG8_LDB(B0, 0, 0); PG8_LDB(B1, 0, 1); PG8_SCHED; PG8_LDA(At, 0, 0); PG8_STAGE(PG8_SA(1, 1), a1 + hsA, voffA);
            PG8_WAIT_V(8); PG8_WAIT_L(0); PG8_BAR; PG8_MMA(0, 0, At, B0); PG8_MMA(0, 1, At, B1); PG8_BAR; PG8_SCHED;
            PG8_LDA(At, 0, 1); PG8_STAGE(PG8_SB(0, 0), b2, voffB); PG8_STAGE(PG8_SB(0, 1), b2 + hsB, voffB); PG8_STAGE(PG8_SA(0, 0), a2, voffA);
            PG8_WAIT_V(8); PG8_WAIT_L(0); PG8_BAR; PG8_MMA(1, 0, At, B0); PG8_MMA(1, 1, At, B1); PG8_BAR; PG8_SCHED;
            PG8_LDB(B0, 1, 0); PG8_LDB(B1, 1, 1); PG8_SCHED; PG8_LDA(At, 1, 0); PG8_STAGE(PG8_SA(0, 1), a2 + hsA, voffA);
            PG8_WAIT_V(8); PG8_WAIT_L(0); PG8_BAR; PG8_MMA(0, 0, At, B0); PG8_MMA(0, 1, At, B1); PG8_BAR; PG8_SCHED;
            PG8_LDA(At, 1, 1); PG8_STAGE(PG8_SB(1, 0), b3, voffB); PG8_STAGE(PG8_SB(1, 1), b3 + hsB, voffB); PG8_STAGE(PG8_SA(1, 0), a3, voffA);
            PG8_WAIT_V(8); PG8_WAIT_L(0); PG8_BAR; PG8_MMA(1, 0, At, B0); PG8_MMA(1, 1, At, B1); PG8_BAR; PG8_SCHED;
        }
        if (wr == 0) PG8_BAR;
        E(acc, cur, wr, wc, fr, fq);
        if (!has_next) break;
        { float z0; asm volatile("v_mov_b32 %0, 0" : "=v"(z0));
#pragma unroll
        for (int a = 0; a < 2; ++a)
#pragma unroll
            for (int b = 0; b < 2; ++b)
#pragma unroll
                for (int m = 0; m < 4; ++m)
#pragma unroll
                    for (int n = 0; n < 2; ++n) acc[a][b][m][n] = (f32x4){z0, z0, z0, z0}; }
        cur = nxt; cA = nA; cB = nB; ++ui;
        if (wr == 1) PG8_BAR;
    }
    PG8_WAIT_V(0);
    PG8_BAR;
#undef PG8_SA
#undef PG8_SB
#undef PG8_STAGE
#undef PG8_LDA
#undef PG8_LDB
#undef PG8_MMA
#undef PG8_WAIT_V
#undef PG8_WAIT_L
#undef PG8_BAR
#undef PG8_SCHED
}

struct EpiZ {
    static constexpr bool PERM = true;
    bf16_t* Z; float* gates; const float* rs;
    DI void operator()(const f32x4 (&acc)[2][2][4][2], const Unit& u, int wr, int wc, int fr, int fq) const {
        asm volatile("" : "+v"(fr), "+v"(fq));
        const int row0 = u.pm * BM + wr * 64 + fr, col0 = u.pn * BM + wc * 32 + 8 * fq;
#pragma unroll
        for (int ai = 0; ai < 2; ++ai)
#pragma unroll
            for (int m = 0; m < 4; ++m) { const int row = row0 + ai * HALF + m * 16; const float sc = rs[row];
#pragma unroll
                for (int bj = 0; bj < 2; ++bj) { const int col = col0 + bj * HALF; const f32x4 v0 = acc[ai][bj][m][0] * sc, v1 = acc[ai][bj][m][1] * sc;
                    if (col < ZLD) { u32x4 w; w.x = pk2(v0[0], v0[1]); w.y = pk2(v0[2], v0[3]); w.z = pk2(v1[0], v1[1]); w.w = pk2(v1[2], v1[3]); *(u32x4*)(Z + (size_t)row * ZLD + col) = w; }
                    else if (col < DIN) { float* gp = gates + (size_t)row * 24 + (col - ZLD); *(f32x4*)gp = v0; *(f32x4*)(gp + 4) = v1; } }
                asm volatile("" ::: "memory"); }
    }
};
struct EpiSwiGLU {
    static constexpr bool PERM = true;
    bf16_t* Z; const float* rs;
    DI void operator()(const f32x4 (&acc)[2][2][4][2], const Unit& u, int wr, int wc, int fr, int fq) const {
        asm volatile("" : "+v"(fr), "+v"(fq));
        const int row0 = u.pm * BM + wr * 64 + fr, col0 = ACT_OFF + u.pn * HALF + wc * 32 + 8 * fq;
#pragma unroll
        for (int ai = 0; ai < 2; ++ai)
#pragma unroll
            for (int m = 0; m < 4; ++m) { const int row = row0 + ai * HALF + m * 16; const float sc = rs[row]; float o[8];
#pragma unroll
                for (int n = 0; n < 2; ++n)
#pragma unroll
                    for (int i = 0; i < 4; ++i) { const float gg = acc[ai][0][m][n][i] * sc, uu = acc[ai][1][m][n][i] * sc; o[4 * n + i] = gg * sigmoidf_(gg) * uu; }
                u32x4 w; w.x = pk2(o[0], o[1]); w.y = pk2(o[2], o[3]); w.z = pk2(o[4], o[5]); w.w = pk2(o[6], o[7]);
                *(u32x4*)(Z + (size_t)row * ZLD + col0) = w;
                asm volatile("" ::: "memory"); }
    }
};
struct EpiSigmoid {
    static constexpr bool PERM = true;
    bf16_t* Z;
    DI void operator()(const f32x4 (&acc)[2][2][4][2], const Unit& u, int wr, int wc, int fr, int fq) const {
        asm volatile("" : "+v"(fr), "+v"(fq));
        const int row0 = u.pm * BM + wr * 64 + fr, col0 = u.pn * BM + wc * 32 + 8 * fq;
#pragma unroll
        for (int ai = 0; ai < 2; ++ai)
#pragma unroll
            for (int m = 0; m < 4; ++m) { const int row = row0 + ai * HALF + m * 16;
#pragma unroll
                for (int bj = 0; bj < 2; ++bj) { const f32x4 v0 = acc[ai][bj][m][0], v1 = acc[ai][bj][m][1]; u32x4 w;
                    w.x = pk2(sigmoidf_(v0[0]), sigmoidf_(v0[1])); w.y = pk2(sigmoidf_(v0[2]), sigmoidf_(v0[3])); w.z = pk2(sigmoidf_(v1[0]), sigmoidf_(v1[1])); w.w = pk2(sigmoidf_(v1[2]), sigmoidf_(v1[3]));
                    *(u32x4*)(Z + (size_t)row * ZLD + col0 + bj * HALF) = w; }
                asm volatile("" ::: "memory"); }
    }
};
template <bool MUL> struct EpiResid {
    static constexpr bool PERM = false;
    const float* resid; float* out; bf16_t* xb; const bf16_t* mul; LAS float* ssq; bool wr_en;
    DI void operator()(const f32x4 (&acc)[2][2][4][2], const Unit& u, int wr, int wc, int fr, int fq) const {
        asm volatile("" : "+v"(fr), "+v"(fq));
        const int col0 = u.pn * BM + wc * 32 + 4 * fq;
#pragma unroll
        for (int ai = 0; ai < 2; ++ai)
#pragma unroll
            for (int m = 0; m < 4; ++m) { const int rl = ai * HALF + wr * 64 + m * 16 + fr; const size_t row = (size_t)(u.pm * BM + rl); float s = 0.f;
#pragma unroll
                for (int bj = 0; bj < 2; ++bj)
#pragma unroll
                    for (int n = 0; n < 2; ++n) { const int col = col0 + bj * HALF + n * 16; f32x4 a = acc[ai][bj][m][n];
                        if (MUL) { const u32x2 mv = *(const u32x2*)(mul + row * ZLD + col); a[0] *= bflo(mv.x); a[1] *= bfhi(mv.x); a[2] *= bflo(mv.y); a[3] *= bfhi(mv.y); }
                        const f32x4 r = *(const f32x4*)(resid + row * DM + col); const f32x4 x = r + a;
                        if (wr_en) { *(f32x4*)(out + row * DM + col) = x; u32x2 w; w.x = pk2(x[0], x[1]); w.y = pk2(x[2], x[3]); *(u32x2*)(xb + row * DM + col) = w; }
                        s += (x[0] * x[0] + x[1] * x[1]) + (x[2] * x[2] + x[3] * x[3]); }
                { const int lid = fr + 16 * fq;
                  s += __builtin_bit_cast(float, __builtin_amdgcn_ds_bpermute((lid ^ 16) << 2, __builtin_bit_cast(int, s)));
                  s += __builtin_bit_cast(float, __builtin_amdgcn_ds_bpermute((lid ^ 32) << 2, __builtin_bit_cast(int, s))); }
                if (fq == 0 && wr_en) ssq[rl * 4 + wc] += s;
                asm volatile("" ::: "memory"); }
    }
};
}

struct KParams {
    const float* x; const float* p; const float* rel_bias; const float* attn_norm; const float* w_in; const float* qk_conv; const float* gate_bias; const float* sink;
    const float* mlstm_norm; const float* w_out; const float* ffn_norm; const float* w_up; const float* w_down; const float* ple_proj; const float* ple_gate; const float* final_norm;
    float* out; unsigned char* ws;
};

DI void transpose_item(const float* __restrict__ W, int K, int Nsrc, int n0, int nvalid, const float* __restrict__ gk, float cs,
                       bf16_t* __restrict__ WT, int dst_row0, int k0, LAS float* scr, int lane) {
    const int c = lane & 31, kh = lane >> 5;
#pragma unroll 8
    for (int i = 0; i < 32; ++i) { const int kk = 2 * i + kh; float v = 0.f;
        if (c < nvalid) { v = W[(size_t)(k0 + kk) * Nsrc + n0 + c] * cs; if (gk) v *= gk[k0 + kk]; }
        scr[kk * 33 + c] = v; }
    WAVE_LDS_FENCE();
    const int c8 = lane & 7;
#pragma unroll
    for (int j = 0; j < 4; ++j) { const int n = (lane >> 3) + 8 * j; const LAS float* s = scr + (8 * c8) * 33 + n;
        u32x4 o; o.x = pk2(s[0 * 33], s[1 * 33]); o.y = pk2(s[2 * 33], s[3 * 33]); o.z = pk2(s[4 * 33], s[5 * 33]); o.w = pk2(s[6 * 33], s[7 * 33]);
        *(u32x4*)(WT + (size_t)(dst_row0 + n) * K + k0 + 8 * c8) = o; }
    WAVE_LDS_FENCE();
}
constexpr int IT_WIN = 16 * 104, IT_WOUT = 16 * 32, IT_WUP = 16 * 176, IT_WDOWN = 44 * 32, IT_WP = 4 * 32, IT_WG = 16 * 32;
constexpr int IT_LAYER = IT_WIN + IT_WOUT + IT_WUP + IT_WDOWN + IT_WP + IT_WG;

DI void prep_weights(const KParams& P, LAS unsigned char* lds, int gw, int NGW, int wave, int lane) {
    LAS float* scr = (LAS float*)(lds + wave * 16384);
    bf16_t* Wall = (bf16_t*)(P.ws + WS_W);
    for (int it = gw; it < DEPTH * IT_LAYER; it += NGW) {
        const int l = it / IT_LAYER; int r = it % IT_LAYER;
        bf16_t* Wl = Wall + (size_t)l * LAYER_W;
        if (r < IT_WIN) { const int kb = r / 104, jb = r % 104, d0 = 32 * jb; int src = d0, nv = 32; float cs = 1.f;
            if (d0 < 384) { src = d0; cs = QSCALE; } else if (d0 < 640) { src = 1152 + d0 - 384; cs = QSCALE; } else if (d0 < 1024) src = 1664 + d0 - 640;
            else if (d0 < 1408) src = 384 + d0 - 1024; else if (d0 < 1536) src = d0; else if (d0 < 1920) src = 2048 + d0 - 1536;
            else if (d0 < 2304) src = 768 + d0 - 1920; else if (d0 < 2432) src = 1536 + d0 - 2304; else if (d0 < 3200) src = d0;
            else if (d0 == 3200) { src = 3200; nv = 24; } else { src = 0; nv = 0; }
            transpose_item(P.w_in + (size_t)l * DM * DIN, DM, DIN, src, nv, P.attn_norm + l * DM, cs, Wl + OFF_WIN, d0, 64 * kb, scr, lane); continue; }
        r -= IT_WIN;
        if (r < IT_WOUT) { const int kb = r / 32, jb = r % 32; transpose_item(P.w_out + (size_t)l * DM * DM, DM, DM, 32 * jb, 32, nullptr, 1.f, Wl + OFF_WOUT, 32 * jb, 64 * kb, scr, lane); continue; }
        r -= IT_WOUT;
        if (r < IT_WUP) { const int kb = r / 176, jb = r % 176, d0 = 32 * jb, pn = d0 >> 8, c0 = d0 & 255; const int src = c0 < 128 ? 128 * pn + c0 : DFF + 128 * pn + (c0 - 128);
            transpose_item(P.w_up + (size_t)l * DM * NUP, DM, NUP, src, 32, P.ffn_norm + l * DM, 1.f, Wl + OFF_WUP, d0, 64 * kb, scr, lane); continue; }
        r -= IT_WUP;
        if (r < IT_WDOWN) { const int kb = r / 32, jb = r % 32; transpose_item(P.w_down + (size_t)l * DFF * DM, DFF, DM, 32 * jb, 32, nullptr, 1.f, Wl + OFF_WDOWN, 32 * jb, 64 * kb, scr, lane); continue; }
        r -= IT_WDOWN;
        if (r < IT_WP) { const int kb = r / 32, jb = r % 32; transpose_item(P.ple_proj + (size_t)l * PLE * DM, PLE, DM, 32 * jb, 32, nullptr, 1.f, Wl + OFF_WP, 32 * jb, 64 * kb, scr, lane); continue; }
        r -= IT_WP;
        { const int kb = r / 32, jb = r % 32; transpose_item(P.ple_gate + (size_t)l * DM * DM, DM, DM, 32 * jb, 32, nullptr, 1.f, Wl + OFF_WG, 32 * jb, 64 * kb, scr, lane); }
    }
}
DI float wave_sum(float v, int lane) {
#pragma unroll
    for (int o = 1; o < 64; o <<= 1) v += shx(v, o, lane);
    return v;
}
DI float wave_max(float v, int lane) {
#pragma unroll
    for (int o = 1; o < 64; o <<= 1) v = fmaxf(v, shx(v, o, lane));
    return v;
}

constexpr int VROW = 144;
constexpr int VBUF = 32 * VROW;
constexpr int LUTN = 640, LUTC = 320;

DI void load_kv(const bf16_t* __restrict__ zb, int kcol, int vcol, int dstr, int rd, int u0, int lane, bf16x8 (&kn)[2][2], u32x4 (&vn)[4]) {
    const int r16 = lane & 15, g = lane >> 4;
#pragma unroll
    for (int T = 0; T < 2; ++T) { int pos = dstr * (u0 + 16 * T + r16) + rd; pos = pos < 0 ? 0 : (pos > SEQ - 1 ? SEQ - 1 : pos);
        const bf16_t* p = zb + (size_t)pos * ZLD + kcol + 8 * g; kn[T][0] = *(const bf16x8*)p; kn[T][1] = *(const bf16x8*)(p + 32); }
#pragma unroll
    for (int k = 0; k < 4; ++k) { const int id = lane + 64 * k, row = id >> 3, c16 = id & 7; int pos = dstr * (u0 + row) + rd; pos = pos < 0 ? 0 : (pos > SEQ - 1 ? SEQ - 1 : pos);
        vn[k] = *(const u32x4*)(zb + (size_t)pos * ZLD + vcol + 8 * c16); }
}

struct DescA {
    int rd0, rd1, ub0, ub1, ub2, uq0, uq1, uq2, tb;
    DI void get(int ci, int g, int& dstr, int& rd, int& u0, int& li) const {
        const int cf = ci < 5 ? 0 : (ci < 11 ? 1 : 2); const int lc = ci - (cf == 0 ? 0 : (cf == 1 ? 5 : 11));
        dstr = cf == 0 ? 16 : (cf == 1 ? 4 : 1); rd = cf == 0 ? rd0 : (cf == 1 ? rd1 : 0);
        u0 = (cf == 0 ? ub0 : (cf == 1 ? ub1 : ub2)) + 32 * lc;
        const int uq = cf == 0 ? uq0 : (cf == 1 ? uq1 : uq2);
        li = u0 - uq + 4 * g + LUTC + tb + cf * 6 * LUTN; }
};
struct DescB {
    int ub, uq, tb;
    DI void get(int ci, int g, int& dstr, int& rd, int& u0, int& li) const { dstr = 1; rd = 0; u0 = ub + 32 * ci; li = u0 - uq + 4 * g + LUTC + tb; }
};

template <int NH, int D, class Desc>
DI void attn_stream(const bf16_t* __restrict__ zb, int kcol, int vcol, int nch, const Desc& ds, const LAS float* lutbase,
                    const bf16x8 (&qf)[NH][2], float (&m)[NH], float (&l)[NH], f32x4 (&o)[NH][4], LAS unsigned char* vbase, int lane) {
    const int r16 = lane & 15, g = lane >> 4, q4 = r16 >> 2, p4 = r16 & 3;
    bf16x8 kn[D][2][2]; u32x4 vn[D][4];
#pragma unroll
    for (int j = 0; j < D; ++j) if (j < nch) { int dstr, rd, u0, li; ds.get(j, g, dstr, rd, u0, li); load_kv(zb, kcol, vcol, dstr, rd, u0, lane, kn[j], vn[j]); }
    for (int c0 = 0; c0 < nch; c0 += D) {
#pragma unroll
        for (int j = 0; j < D; ++j) {
            const int c = c0 + j;
            if (c < nch) {
                int dstr, rd, u0, li; ds.get(c, g, dstr, rd, u0, li);
                LAS unsigned char* vb = vbase + (c & 1) * VBUF;
#pragma unroll
                for (int k = 0; k < 4; ++k) { const int id = lane + 64 * k, row = id >> 3, c16 = id & 7; *(LAS u32x4*)(vb + row * VROW + c16 * 16) = vn[j][k]; }
                f32x4 stt[NH][2];
#pragma unroll
                for (int hh = 0; hh < NH; ++hh)
#pragma unroll
                    for (int T = 0; T < 2; ++T) { f32x4 st = {0.f, 0.f, 0.f, 0.f}; st = mfma16(kn[j][T][0], qf[hh][0], st); st = mfma16(kn[j][T][1], qf[hh][1], st); stt[hh][T] = st; }
                if (c + D < nch) { int d2, r2, u2, l2; ds.get(c + D, g, d2, r2, u2, l2); load_kv(zb, kcol, vcol, d2, r2, u2, lane, kn[j], vn[j]); }
                float rm[2][4];
#pragma unroll
                for (int T = 0; T < 2; ++T)
#pragma unroll
                    for (int i = 0; i < 4; ++i) { const int pos = dstr * (u0 + 16 * T + 4 * g + i) + rd; rm[T][i] = ((unsigned)pos < (unsigned)SEQ) ? 0.f : NEGBIG; }
                bf16x8 vf[4];
#pragma unroll
                for (int c4 = 0; c4 < 4; ++c4) { const s16x4 a0 = trread(vb + (4 * g + q4) * VROW + 32 * c4 + 8 * p4), a1 = trread(vb + (16 + 4 * g + q4) * VROW + 32 * c4 + 8 * p4); vf[c4] = cat8(a0, a1); }
#pragma unroll
                for (int hh = 0; hh < NH; ++hh) {
                    const LAS float* lut = lutbase + hh * LUTN + li;
                    float sv[8];
#pragma unroll
                    for (int T = 0; T < 2; ++T) {
#pragma unroll
                        for (int i = 0; i < 4; ++i) sv[4 * T + i] = stt[hh][T][i] + lut[16 * T + i] + rm[T][i]; }
                    float cm = fmaxf(fmaxf(fmaxf(sv[0], sv[1]), fmaxf(sv[2], sv[3])), fmaxf(fmaxf(sv[4], sv[5]), fmaxf(sv[6], sv[7])));
                    cm = fmaxf(cm, shx(cm, 16, lane)); cm = fmaxf(cm, shx(cm, 32, lane));
                    const float mn = fmaxf(m[hh], cm), alpha = ex2(m[hh] - mn); m[hh] = mn;
                    float pv[8], ps = 0.f;
#pragma unroll
                    for (int k = 0; k < 8; ++k) { pv[k] = ex2(sv[k] - mn); ps += pv[k]; }
                    l[hh] = l[hh] * alpha + ps;
                    u32x4 pw; pw.x = pk2(pv[0], pv[1]); pw.y = pk2(pv[2], pv[3]); pw.z = pk2(pv[4], pv[5]); pw.w = pk2(pv[6], pv[7]);
                    const bf16x8 pf = __builtin_bit_cast(bf16x8, pw);
#pragma unroll
                    for (int c4 = 0; c4 < 4; ++c4) { o[hh][c4] = o[hh][c4] * alpha; o[hh][c4] = mfma16(vf[c4], pf, o[hh][c4]); }
                }
            }
        }
    }
}

DI void build_lut(const KParams& P, LAS unsigned char* lds, int tid) {
    LAS float* lut = (LAS float*)lds;
    for (int idx = tid; idx < 22 * LUTN; idx += 512) {
        const int t = idx / LUTN, rel = idx % LUTN - LUTC; int dil, half, hc;
        if (t < 18) { const int cfg = t / 6; dil = cfg == 0 ? 16 : (cfg == 1 ? 4 : 1); half = 64; hc = t % 6; } else { dil = 1; half = 128; hc = 6 + (t - 18); }
        float v = NEGBIG; const int ar = rel < 0 ? -rel : rel;
        if (ar <= half) { const int n = ar * dil; int bk;
            if (n < 8) bk = n; else { const float nf = (float)n; bk = 8 + (int)(logf(nf / 8.0f) / 4.852030263919617f * 8.0f); bk = bk > 15 ? 15 : bk; }
            if (rel > 0) bk += 16;
            v = P.rel_bias[bk * 10 + hc] * LOG2E; }
        lut[idx] = v;
    }
}

DI void attention_phase(const KParams& P0_, LAS unsigned char* lds, int l, int pm, int wave, int lane, bool wr_en = true) {
    KParams P = P0_; { __attribute__((address_space(1))) unsigned char* w1_ = (__attribute__((address_space(1))) unsigned char*)P.ws; asm volatile("" : "+s"(w1_)); P.ws = (unsigned char*)w1_; }

    bf16_t* Z = (bf16_t*)(P.ws + WS_Z);
    const int r16 = lane & 15, g = lane >> 4;
    const int row0 = pm * 256, b = row0 / SEQ, s0 = row0 % SEQ;
    bf16_t* zb = Z + (size_t)b * SEQ * ZLD;
    const LAS float* lut = (const LAS float*)lds;
    LAS unsigned char* vbase = lds + 22 * LUTN * 4 + wave * (2 * VBUF);
    for (int ua = wave; ua < 96; ua += 8) {
        const int h = ua >> 4, rho = ua & 15;
        const int posq = s0 + rho + 16 * r16;
        bf16x8 qf[1][2];
        { const bf16_t* qp = zb + (size_t)posq * ZLD + QA + 64 * h + 8 * g; qf[0][0] = *(const bf16x8*)qp; qf[0][1] = *(const bf16x8*)(qp + 32); }
        float m[1] = {-1e20f}, lsum[1] = {0.f}; f32x4 o[1][4];
#pragma unroll
        for (int c4 = 0; c4 < 4; ++c4) o[0][c4] = zero4();
        { DescA ds; const int U16 = s0 >> 4, U4 = (s0 >> 2) + (rho >> 2), U1 = s0 + rho;
          ds.rd0 = rho; ds.rd1 = rho & 3; ds.ub0 = U16 - 64; ds.ub1 = U4 - 64; ds.ub2 = U1 - 64; ds.uq0 = U16 + r16; ds.uq1 = U4 + 4 * r16; ds.uq2 = U1 + 16 * r16; ds.tb = h * LUTN;
          attn_stream<1, 2, DescA>(zb, KA + 64 * h, VA + 64 * h, 23, ds, lut, qf, m, lsum, o, vbase, lane); }
        float lt = lsum[0]; lt += shx(lt, 16, lane); lt += shx(lt, 32, lane);
        const float inv = 1.f / lt;
        bf16_t* yp = zb + (size_t)posq * ZLD + QA + 64 * h + 4 * g;
        if (wr_en)
#pragma unroll
        for (int c4 = 0; c4 < 4; ++c4) { const f32x4 v = o[0][c4] * inv; u32x2 w; w.x = pk2(v[0], v[1]); w.y = pk2(v[2], v[3]); *(u32x2*)(yp + 16 * c4) = w; }
    }
    for (int ub = wave; ub < 32; ub += 8) {
        const int kvh = ub >> 4, qg = ub & 15;
        const int posq = s0 + 16 * qg + r16;
        bf16x8 qf[2][2];
#pragma unroll
        for (int hh = 0; hh < 2; ++hh) { const bf16_t* qp = zb + (size_t)posq * ZLD + QB + 64 * (2 * kvh + hh) + 8 * g; qf[hh][0] = *(const bf16x8*)qp; qf[hh][1] = *(const bf16x8*)(qp + 32); }
        float m[2] = {-1e20f, -1e20f}, lsum[2] = {0.f, 0.f}; f32x4 o[2][4];
#pragma unroll
        for (int hh = 0; hh < 2; ++hh)
#pragma unroll
            for (int c4 = 0; c4 < 4; ++c4) o[hh][c4] = zero4();
        const int U0 = s0 + 16 * qg;
        { DescB ds; ds.ub = U0 - 128; ds.uq = U0 + r16; ds.tb = (18 + 2 * kvh) * LUTN;
          attn_stream<2, 2, DescB>(zb, KB + 64 * kvh, VB + 64 * kvh, 9, ds, lut, qf, m, lsum, o, vbase, lane); }
#pragma unroll
        for (int hh = 0; hh < 2; ++hh) { const int hq = 2 * kvh + hh;
            float lt = lsum[hh]; lt += shx(lt, 16, lane); lt += shx(lt, 32, lane);
            const float sk = P.sink[l * 4 + hq] * LOG2E, mf = fmaxf(m[hh], sk), sc = ex2(m[hh] - mf);
            const float den = lt * sc + ex2(sk - mf), f = sc / den;
            bf16_t* yp = zb + (size_t)posq * ZLD + QB + 64 * hq + 4 * g;
            if (wr_en)
#pragma unroll
            for (int c4 = 0; c4 < 4; ++c4) { const f32x4 v = o[hh][c4] * f; u32x2 w; w.x = pk2(v[0], v[1]); w.y = pk2(v[2], v[3]); *(u32x2*)(yp + 16 * c4) = w; } }
    }
}

DI float logsig(float x) { return fminf(x, 0.f) - log1pf(fexp(-fabsf(x))); }
DI float scan_add_up(float v, int lane) {
#pragma unroll
    for (int o = 1; o < 64; o <<= 1) { const float t = shi(v, lane - o); if (lane >= o) v += t; }
    return v;
}
DI float scan_add_down(float v, int lane) {
#pragma unroll
    for (int o = 1; o < 64; o <<= 1) { const float t = shi(v, lane + o); if (lane + o < 64) v += t; }
    return v;
}
DI float scan_max_up(float v, int lane) {
#pragma unroll
    for (int o = 1; o < 64; o <<= 1) { const float t = shi(v, lane - o); if (lane >= o) v = fmaxf(v, t); }
    return v;
}
DI float scan_max_down(float v, int lane) {
#pragma unroll
    for (int o = 1; o < 64; o <<= 1) { const float t = shi(v, lane + o); if (lane + o < 64) v = fmaxf(v, t); }
    return v;
}

DI void conv8(const bf16_t* __restrict__ zb, int s, int col, const float* __restrict__ cw  , int lane, float (&acc)[8][8]) {
    const int r8 = lane >> 3;
    float w[5][8];
#pragma unroll
    for (int j = 0; j < 5; ++j) { const f32x4 a = *(const f32x4*)(cw + j * 768), b = *(const f32x4*)(cw + j * 768 + 4);
        w[j][0] = a[0]; w[j][1] = a[1]; w[j][2] = a[2]; w[j][3] = a[3]; w[j][4] = b[0]; w[j][5] = b[1]; w[j][6] = b[2]; w[j][7] = b[3]; }
#pragma unroll
    for (int k = 0; k < 8; ++k)
#pragma unroll
        for (int e = 0; e < 8; ++e) acc[k][e] = 0.f;
#pragma unroll
    for (int rr = -2; rr < 10; ++rr) {
        const int pos = s + 8 * r8 + rr;
        u32x4 raw = {0u, 0u, 0u, 0u};
        if ((unsigned)pos < (unsigned)SEQ) raw = *(const u32x4*)(zb + (size_t)pos * ZLD + col);
        float x[8] = {bflo(raw.x), bfhi(raw.x), bflo(raw.y), bfhi(raw.y), bflo(raw.z), bfhi(raw.z), bflo(raw.w), bfhi(raw.w)};
#pragma unroll
        for (int k = 0; k < 8; ++k) { const int j = rr - k + 2;
            if (j >= 0 && j <= 4) {
#pragma unroll
                for (int e = 0; e < 8; ++e) acc[k][e] += w[j][e] * x[e]; } }
    }
#pragma unroll
    for (int k = 0; k < 8; ++k)
#pragma unroll
        for (int e = 0; e < 8; ++e) { const float a = acc[k][e]; acc[k][e] = a * sigmoidf_(a); }
}

DI void mlstm_state_phase(const KParams& P0_, LAS unsigned char* lds, int l, int pm, int wave, int lane) {
    KParams P = P0_; { __attribute__((address_space(1))) unsigned char* w1_ = (__attribute__((address_space(1))) unsigned char*)P.ws; asm volatile("" : "+s"(w1_)); P.ws = (unsigned char*)w1_; }

    bf16_t* Z = (bf16_t*)(P.ws + WS_Z);
    const float* gates = (const float*)(P.ws + WS_GATES);
    bf16_t* qconv = (bf16_t*)(P.ws + WS_QCONV); bf16_t* kconv = (bf16_t*)(P.ws + WS_KCONV);
    bf16_t* CT = (bf16_t*)(P.ws + WS_CT); bf16_t* nbuf = (bf16_t*)(P.ws + WS_NB);
    float* mloc = (float*)(P.ws + WS_ML); float* blast = (float*)(P.ws + WS_BL);
    const float* gb = P.gate_bias + l * 24;
    const int r16 = lane & 15, g = lane >> 4, q4 = r16 >> 2, p4 = r16 & 3, r8 = lane >> 3, pc = lane & 7;
    LAS unsigned char* kbuf = lds + wave * (2 * 64 * VROW);
    LAS unsigned char* vbuf = kbuf + 64 * VROW;
    for (int um = wave; um < 24; um += 8) {
        asm volatile("" : "+v"(lane));
        const int cc = um / 6, h = um % 6;
        const int tc = pm * 256 + 64 * cc, b = tc / SEQ, s = tc % SEQ, ci = s >> 6;
        const bf16_t* zb = Z + (size_t)b * SEQ * ZLD;
        const float* G = gates + (size_t)(tc + lane) * 24;
        const float igf = G[h] + gb[h], fgf = G[6 + h] + gb[6 + h], igb = G[12 + h] + gb[12 + h], fgb = G[18 + h] + gb[18 + h];
        const float bfw = scan_add_up(logsig(fgf), lane), bbw = scan_add_down(logsig(fgb), lane);
        const float blf = shi(bfw, 63), blb = shi(bbw, 0);
        const float wf = blf - bfw + igf, wb = blb - bbw + igb;
        const float mlf = wave_max(wf, lane), mlb = wave_max(wb, lane);
        const float ef = fexp(wf - mlf), eb = fexp(wb - mlb);
        const int slot_f = ((0 * NB + b) * 6 + h) * NCH + ci, slot_b = ((1 * NB + b) * 6 + h) * NCH + ci;
        if (lane == 0) { mloc[slot_f] = mlf; blast[slot_f] = blf; mloc[slot_b] = mlb; blast[slot_b] = blb; }
        float acc[8][8];
        conv8(zb, s, QC + 64 * h + 8 * pc, P.qk_conv + (size_t)l * 5 * 768 + 64 * h + 8 * pc, lane, acc);
#pragma unroll
        for (int k = 0; k < 8; ++k) { u32x4 w; w.x = pk2(acc[k][0], acc[k][1]); w.y = pk2(acc[k][2], acc[k][3]); w.z = pk2(acc[k][4], acc[k][5]); w.w = pk2(acc[k][6], acc[k][7]);
            *(u32x4*)(qconv + (size_t)(tc + 8 * r8 + k) * 384 + 64 * h + 8 * pc) = w; }
        conv8(zb, s, KC + 64 * h + 8 * pc, P.qk_conv + (size_t)l * 5 * 768 + 384 + 64 * h + 8 * pc, lane, acc);
        u32x4 kpk[8];
#pragma unroll
        for (int k = 0; k < 8; ++k) {
#pragma unroll
            for (int e = 0; e < 8; ++e) acc[k][e] *= 0.125f;
            u32x4 w; w.x = pk2(acc[k][0], acc[k][1]); w.y = pk2(acc[k][2], acc[k][3]); w.z = pk2(acc[k][4], acc[k][5]); w.w = pk2(acc[k][6], acc[k][7]);
            kpk[k] = w;
            *(u32x4*)(kconv + (size_t)(tc + 8 * r8 + k) * 384 + 64 * h + 8 * pc) = w; }
#pragma unroll
        for (int k = 0; k < 8; ++k) { const int id = lane + 64 * k, row = id >> 3, c16 = id & 7;
            *(LAS u32x4*)(vbuf + row * VROW + 16 * c16) = *(const u32x4*)(zb + (size_t)(s + row) * ZLD + VC + 64 * h + 8 * c16); }
#pragma unroll
        for (int dir = 0; dir < 2; ++dir) {
            const float ed = dir ? eb : ef;
#pragma unroll
            for (int k = 0; k < 8; ++k) { const float e = shi(ed, 8 * r8 + k); const u32x4 kk = kpk[k];
                u32x4 w; w.x = pk2(bflo(kk.x) * e, bfhi(kk.x) * e); w.y = pk2(bflo(kk.y) * e, bfhi(kk.y) * e); w.z = pk2(bflo(kk.z) * e, bfhi(kk.z) * e); w.w = pk2(bflo(kk.w) * e, bfhi(kk.w) * e);
                *(LAS u32x4*)(kbuf + (8 * r8 + k) * VROW + 16 * pc) = w; }
            WAVE_LDS_FENCE();
            f32x4 c[4][5];
#pragma unroll
            for (int dt = 0; dt < 4; ++dt)
#pragma unroll
                for (int et = 0; et < 5; ++et) c[dt][et] = zero4();
#pragma unroll
            for (int ks = 0; ks < 2; ++ks) {
                bf16x8 af[4], bfr[5];
#pragma unroll
                for (int t4 = 0; t4 < 4; ++t4) {
                    af[t4] = cat8(trread(kbuf + (32 * ks + 8 * g + q4) * VROW + 32 * t4 + 8 * p4), trread(kbuf + (32 * ks + 8 * g + 4 + q4) * VROW + 32 * t4 + 8 * p4));
                    bfr[t4] = cat8(trread(vbuf + (32 * ks + 8 * g + q4) * VROW + 32 * t4 + 8 * p4), trread(vbuf + (32 * ks + 8 * g + 4 + q4) * VROW + 32 * t4 + 8 * p4)); }
                { const short one = r16 == 0 ? (short)0x3F80 : (short)0; bfr[4] = (bf16x8){one, one, one, one, one, one, one, one}; }
#pragma unroll
                for (int dt = 0; dt < 4; ++dt)
#pragma unroll
                    for (int et = 0; et < 5; ++et) c[dt][et] = mfma16(af[dt], bfr[et], c[dt][et]);
            }
            const int slot = dir ? slot_b : slot_f;
            bf16_t* ct = CT + ((size_t)(slot / NCH) * 64 * NCH + (slot % NCH)) * 64;
#pragma unroll
            for (int dt = 0; dt < 4; ++dt) {
#pragma unroll
                for (int et = 0; et < 4; ++et) { const f32x4 v = c[dt][et]; u32x2 w; w.x = pk2(v[0], v[1]); w.y = pk2(v[2], v[3]); *(u32x2*)(ct + (size_t)(16 * et + r16) * (NCH * 64) + 16 * dt + 4 * g) = w; }
                if (r16 == 0) { const f32x4 v = c[dt][4]; u32x2 w; w.x = pk2(v[0], v[1]); w.y = pk2(v[2], v[3]); *(u32x2*)(nbuf + (size_t)slot * 64 + 16 * dt + 4 * g) = w; } }
            WAVE_LDS_FENCE();
        }
    }
}

DI void mlstm_scan_phase(const KParams& P0_, LAS unsigned char* lds, int bid, int G, int tid, bool wr_en = true) {
    KParams P = P0_; { __attribute__((address_space(1))) unsigned char* w1_ = (__attribute__((address_space(1))) unsigned char*)P.ws; asm volatile("" : "+s"(w1_)); P.ws = (unsigned char*)w1_; }
    bf16_t* CT = (bf16_t*)(P.ws + WS_CT); bf16_t* nbuf = (bf16_t*)(P.ws + WS_NB);
    const float* mloc = (const float*)(P.ws + WS_ML); const float* blast = (const float*)(P.ws + WS_BL); float* mprev = (float*)(P.ws + WS_MP);
    LAS float* sbl = (LAS float*)lds; LAS float* sml = sbl + 512; LAS float* sa = sml + 512; LAS float* scc = sa + 512;
    const int wave = tid >> 6, lane = tid & 63;
    { const int k = tid >> 7, st = tid & 127; const int sq = k < 3 ? ((bid * 8 + 2048 * k) >> 6) : (bid < NSEQ ? bid : 0); const int c = sq >= NSEQ / 2 ? (NCH - 1 - st) : st;
      sbl[tid] = blast[sq * NCH + c]; sml[tid] = mloc[sq * NCH + c]; }
    __syncthreads();
    if (tid < 4) { const int k = tid; const int sq = k < 3 ? ((bid * 8 + 2048 * k) >> 6) : (bid < NSEQ ? bid : 0); const bool dirb = sq >= NSEQ / 2;
        const bool wm = wr_en && k < 3 && ((bid * 8) & 63) == 0;
        float m = 0.f;
        for (int st = 0; st < NCH; ++st) { const float bl = sbl[k * 128 + st], ml = sml[k * 128 + st]; const float mn = fmaxf(bl + m, ml);
            sa[k * 128 + st] = fexp(bl + m - mn); scc[k * 128 + st] = fexp(ml - mn);
            if (wm) mprev[sq * NCH + (dirb ? (NCH - 1 - st) : st)] = m;
            m = mn; } }
    __syncthreads();
    bf16_t* ptr[4]; bool act[4]; bool dirb[4];
#pragma unroll
    for (int k = 0; k < 3; ++k) { const int row = bid * 8 + wave + 2048 * k; ptr[k] = CT + (size_t)row * (NCH * 64) + lane; act[k] = true; dirb[k] = (row >> 6) >= NSEQ / 2; }
    { ptr[3] = nbuf + (size_t)(bid < NSEQ ? bid : 0) * NCH * 64 + lane; act[3] = bid < NSEQ && wave == 0; dirb[3] = bid >= NSEQ / 2; }
    float C[4] = {0.f, 0.f, 0.f, 0.f};
    for (int st0 = 0; st0 < NCH; st0 += 8) {
        float cl[4][8];
#pragma unroll
        for (int k = 0; k < 4; ++k)
#pragma unroll
            for (int j = 0; j < 8; ++j) { const int c = dirb[k] ? (NCH - 1 - (st0 + j)) : (st0 + j); cl[k][j] = act[k] ? bf2f(ptr[k][c * 64]) : 0.f; }
#pragma unroll
        for (int k = 0; k < 4; ++k)
#pragma unroll
            for (int j = 0; j < 8; ++j) { const int c = dirb[k] ? (NCH - 1 - (st0 + j)) : (st0 + j);
                if (act[k] && wr_en) ptr[k][c * 64] = (bf16_t)(pk2(C[k], 0.f) & 0xffffu);
                C[k] = sa[k * 128 + st0 + j] * C[k] + scc[k * 128 + st0 + j] * cl[k][j]; }
    }
    __syncthreads();
}

DI void mlstm_out_phase(const KParams& P0_, LAS unsigned char* lds, int l, int pm, int wave, int lane) {
    KParams P = P0_; { __attribute__((address_space(1))) unsigned char* w1_ = (__attribute__((address_space(1))) unsigned char*)P.ws; asm volatile("" : "+s"(w1_)); P.ws = (unsigned char*)w1_; }

    bf16_t* Z = (bf16_t*)(P.ws + WS_Z);
    const float* gates = (const float*)(P.ws + WS_GATES);
    const bf16_t* qconv = (const bf16_t*)(P.ws + WS_QCONV); const bf16_t* kconv = (const bf16_t*)(P.ws + WS_KCONV);
    const bf16_t* CT = (const bf16_t*)(P.ws + WS_CT); const bf16_t* nbuf = (const bf16_t*)(P.ws + WS_NB);
    const float* mprev = (const float*)(P.ws + WS_MP);
    const float* gb = P.gate_bias + l * 24;
    const int r16 = lane & 15, g = lane >> 4, q4 = r16 >> 2, p4 = r16 & 3;
    LAS unsigned char* vbuf = lds + wave * (64 * VROW + 2048 + 256);
    LAS float* tab = (LAS float*)(vbuf + 64 * VROW);
    LAS unsigned char* ntab = vbuf + 64 * VROW + 2048;
    for (int um = wave; um < 24; um += 8) {
        asm volatile("" : "+v"(lane));
        const int cc = um / 6, h = um % 6;
        const int tc = pm * 256 + 64 * cc, b = tc / SEQ, s = tc % SEQ, ci = s >> 6;
        bf16_t* zb = Z + (size_t)b * SEQ * ZLD;
        const int slot_f = ((0 * NB + b) * 6 + h) * NCH + ci, slot_b = ((1 * NB + b) * 6 + h) * NCH + ci;
        {
            const float* G = gates + (size_t)(tc + lane) * 24;
            const float igf = G[h] + gb[h], fgf = G[6 + h] + gb[6 + h], igb = G[12 + h] + gb[12 + h], fgb = G[18 + h] + gb[18 + h];
            const float bfw = scan_add_up(logsig(fgf), lane), bbw = scan_add_down(logsig(fgb), lane);
            const float gf = igf - bfw, gbk = igb - bbw;
            const float pmf = scan_max_up(gf, lane), pmb = scan_max_down(gbk, lane);
            const float mpf = mprev[slot_f], mpb = mprev[slot_b];
            const float Mf = fmaxf(pmf, mpf), Mb = fmaxf(pmb, mpb);
            tab[0 * 64 + lane] = gf; tab[1 * 64 + lane] = gbk; tab[2 * 64 + lane] = Mf; tab[3 * 64 + lane] = Mb;
            tab[4 * 64 + lane] = fexp(mpf - Mf); tab[5 * 64 + lane] = fexp(mpb - Mb); tab[6 * 64 + lane] = fexp(-(bfw + Mf)); tab[7 * 64 + lane] = fexp(-(bbw + Mb));
        }
#pragma unroll
        for (int k = 0; k < 8; ++k) { const int id = lane + 64 * k, row = id >> 3, c16 = id & 7;
            *(LAS u32x4*)(vbuf + row * VROW + 16 * c16) = *(const u32x4*)(zb + (size_t)(s + row) * ZLD + VC + 64 * h + 8 * c16); }
        bf16x8 kfr[4][2];
#pragma unroll
        for (int st = 0; st < 4; ++st) { const bf16_t* kp = kconv + (size_t)(tc + 16 * st + r16) * 384 + 64 * h + 8 * g; kfr[st][0] = *(const bf16x8*)kp; kfr[st][1] = *(const bf16x8*)(kp + 32); }
        bf16x8 cfr[2][4][2];
#pragma unroll
        for (int dir = 0; dir < 2; ++dir) { const int slot = dir ? slot_b : slot_f; const bf16_t* ct = CT + ((size_t)(slot / NCH) * 64 * NCH + (slot % NCH)) * 64;
#pragma unroll
            for (int kp = 0; kp < 2; ++kp)
#pragma unroll
                for (int et = 0; et < 4; ++et) cfr[dir][et][kp] = *(const bf16x8*)(ct + (size_t)(16 * et + r16) * (NCH * 64) + 32 * kp + 8 * g); }
        if (lane < 16) { const int dirn = lane >> 3, c8 = lane & 7; *(LAS u32x4*)(ntab + dirn * 128 + c8 * 16) = *(const u32x4*)(nbuf + (size_t)(dirn ? slot_b : slot_f) * 64 + 8 * c8); }
        WAVE_LDS_FENCE();
        for (int tt = 0; tt < 4; ++tt) {
            const int tau = 16 * tt + r16;
            bf16x8 qfr[2];
            { const bf16_t* qp = qconv + (size_t)(tc + tau) * 384 + 64 * h + 8 * g; qfr[0] = *(const bf16x8*)qp; qfr[1] = *(const bf16x8*)(qp + 32); }
            f32x4 S[4];
#pragma unroll
            for (int st = 0; st < 4; ++st) { S[st] = (f32x4){0.f, 0.f, 0.f, 0.f}; S[st] = mfma16(kfr[st][0], qfr[0], S[st]); S[st] = mfma16(kfr[st][1], qfr[1], S[st]); }
            f32x4 hs[4];
#pragma unroll
            for (int et = 0; et < 4; ++et) hs[et] = zero4();
#pragma unroll
            for (int dir = 0; dir < 2; ++dir) {
                const float Mt = tab[(2 + dir) * 64 + tau], at = tab[(4 + dir) * 64 + tau], flt = tab[(6 + dir) * 64 + tau];
                bf16x8 pfr[2];
#pragma unroll
                for (int kp = 0; kp < 2; ++kp) { float pv[8];
#pragma unroll
                    for (int hf = 0; hf < 2; ++hf) { const int st = 2 * kp + hf; const f32x4 gs = *(const LAS f32x4*)(tab + dir * 64 + 16 * st + 4 * g);
#pragma unroll
                        for (int i = 0; i < 4; ++i) { const int sg = 16 * st + 4 * g + i; const bool ok = dir ? (sg >= tau) : (sg <= tau);
                            const float e = fexp(gs[i] - Mt) * S[st][i]; pv[4 * hf + i] = ok ? e : 0.f; } }
                    u32x4 pw; pw.x = pk2(pv[0], pv[1]); pw.y = pk2(pv[2], pv[3]); pw.z = pk2(pv[4], pv[5]); pw.w = pk2(pv[6], pv[7]); pfr[kp] = __builtin_bit_cast(bf16x8, pw); }
                f32x4 nd[5];
#pragma unroll
                for (int et = 0; et < 5; ++et) nd[et] = zero4();
#pragma unroll
                for (int kp = 0; kp < 2; ++kp) {
                    const u32x4 qw = __builtin_bit_cast(u32x4, qfr[kp]); u32x4 qs;
                    qs.x = pk2(bflo(qw.x) * at, bfhi(qw.x) * at); qs.y = pk2(bflo(qw.y) * at, bfhi(qw.y) * at); qs.z = pk2(bflo(qw.z) * at, bfhi(qw.z) * at); qs.w = pk2(bflo(qw.w) * at, bfhi(qw.w) * at);
                    const bf16x8 qsc = __builtin_bit_cast(bf16x8, qs);
#pragma unroll
                    for (int et = 0; et < 4; ++et) { const bf16x8 vf = cat8(trread(vbuf + (32 * kp + 4 * g + q4) * VROW + 32 * et + 8 * p4), trread(vbuf + (32 * kp + 16 + 4 * g + q4) * VROW + 32 * et + 8 * p4));
                        nd[et] = mfma16(vf, pfr[kp], nd[et]); nd[et] = mfma16(cfr[dir][et][kp], qsc, nd[et]); }
                    { const short one = r16 == 0 ? (short)0x3F80 : (short)0; const bf16x8 of = {one, one, one, one, one, one, one, one}; nd[4] = mfma16(of, pfr[kp], nd[4]); }
                    { bf16x8 nf = {0, 0, 0, 0, 0, 0, 0, 0}; if (r16 == 0) nf = *(const LAS bf16x8*)(ntab + dir * 128 + 64 * kp + 16 * g); nd[4] = mfma16(nf, qsc, nd[4]); }
                }
                const float den = shi(nd[4][0], r16);
                const float inv = 1.f / fmaxf(fabsf(den), flt);
#pragma unroll
                for (int et = 0; et < 4; ++et) hs[et] += nd[et] * inv;
            }
            float ss = 0.f;
#pragma unroll
            for (int et = 0; et < 4; ++et) ss += (hs[et][0] * hs[et][0] + hs[et][1] * hs[et][1]) + (hs[et][2] * hs[et][2] + hs[et][3] * hs[et][3]);
            ss += shx(ss, 16, lane); ss += shx(ss, 32, lane);
            const float rn = 1.f / sqrtf(ss * (1.f / 64.f) + EPS);
            bf16_t* zr = zb + (size_t)(s + tau) * ZLD;
#pragma unroll
            for (int et = 0; et < 4; ++et) { const int e0 = 64 * h + 16 * et + 4 * g;
                const u32x2 ov = *(const u32x2*)(zr + OC + e0); const f32x4 ng = *(const f32x4*)(P.mlstm_norm + l * 384 + e0);
                const float y0 = hs[et][0] * rn * ng[0] * sigmoidf_(bflo(ov.x)), y1 = hs[et][1] * rn * ng[1] * sigmoidf_(bfhi(ov.x));
                const float y2 = hs[et][2] * rn * ng[2] * sigmoidf_(bflo(ov.y)), y3 = hs[et][3] * rn * ng[3] * sigmoidf_(bfhi(ov.y));
                u32x2 w; w.x = pk2(y0, y1); w.y = pk2(y2, y3); *(u32x2*)(zr + QC + e0) = w; }
        }
        WAVE_LDS_FENCE();
    }
}

#ifndef PROBE_MODE
#define PROBE_MODE 0
#endif
#ifndef SKIP_ATTN
#define SKIP_ATTN 0
#endif
#ifndef SKIP_MLSTM
#define SKIP_MLSTM 0
#endif

__global__ void __launch_bounds__(512, 2) fwd_kernel(KParams P) {
    extern __shared__ __attribute__((aligned(16))) unsigned char lds_raw[];
    LAS unsigned char* lds = (LAS unsigned char*)lds_raw;
    cg::grid_group grid = cg::this_grid();
#if PROBE_MODE == 4
#define GSYNC() do { grid.sync(); grid.sync(); } while (0)
#else
#define GSYNC() grid.sync()
#endif
    const int G = gridDim.x, bx = blockIdx.x;
    if (G != 256) return;
    const int pm0 = (bx & 7) * 32 + (bx >> 3);
#define FRESH_IDS int tid = threadIdx.x; asm volatile("" : "+v"(tid)); const int lane = tid & 63, wave = __builtin_amdgcn_readfirstlane(tid >> 6); int pm = pm0; asm volatile("" : "+s"(pm)); (void)lane; (void)wave; (void)pm;
#define WSP() ({ __attribute__((address_space(1))) unsigned char* w_ = (__attribute__((address_space(1))) unsigned char*)P.ws; asm volatile("" : "+s"(w_)); (unsigned char*)w_; })
#define Wall ((bf16_t*)(WSP() + WS_W))
#define PB ((bf16_t*)(WSP() + WS_PB))
#define gates ((float*)(WSP() + WS_GATES))
#define rs ((float*)(WSP() + WS_RS))
#define XBA ((bf16_t*)(WSP() + WS_XBA))
#define XBB ((bf16_t*)(WSP() + WS_XBB))
#define Z ((bf16_t*)(WSP() + WS_Z))
    LAS float* ssq = (LAS float*)(lds + SSQ_OFF);
#define ZERO_SSQ() do { FRESH_IDS; if (tid < 256) { *(LAS f32x4*)(ssq + tid * 4) = zero4(); } } while (0)
#define WRITE_RS() do { FRESH_IDS; if (tid < 256) { const float s_ = (ssq[tid * 4] + ssq[tid * 4 + 1]) + (ssq[tid * 4 + 2] + ssq[tid * 4 + 3]); rs[pm * 256 + tid] = 1.f / sqrtf(s_ * (1.f / DM) + EPS); } } while (0)

#if PROBE_MODE == 3
    { FRESH_IDS;
      prep_weights(P, lds, bx * 8 + wave, G * 8, wave, lane);
      for (int rr = wave; rr < 256; rr += 8) { const size_t row = (size_t)pm * 256 + rr;
        const f32x4* xr = (const f32x4*)(P.x + row * DM) + lane; f32x4 v[4]; float s = 0.f;
#pragma unroll
        for (int j = 0; j < 4; ++j) { v[j] = xr[64 * j]; s += (v[j][0] * v[j][0] + v[j][1] * v[j][1]) + (v[j][2] * v[j][2] + v[j][3] * v[j][3]); }
        s = wave_sum(s, lane);
        u32x2* o = (u32x2*)(XBA + row * DM) + lane;
#pragma unroll
        for (int j = 0; j < 4; ++j) { u32x2 w; w.x = pk2(v[j][0], v[j][1]); w.y = pk2(v[j][2], v[j][3]); o[64 * j] = w; }
        if (lane == 0) rs[row] = 1.f / sqrtf(s * (1.f / DM) + EPS); } }
    __syncthreads();
#endif
    { FRESH_IDS;
      prep_weights(P, lds, bx * 8 + wave, G * 8, wave, lane);
      for (int rr = wave; rr < 256; rr += 8) { const size_t row = (size_t)pm * 256 + rr;
        const f32x4* xr = (const f32x4*)(P.x + row * DM) + lane; f32x4 v[4]; float s = 0.f;
#pragma unroll
        for (int j = 0; j < 4; ++j) { v[j] = xr[64 * j]; s += (v[j][0] * v[j][0] + v[j][1] * v[j][1]) + (v[j][2] * v[j][2] + v[j][3] * v[j][3]); }
        s = wave_sum(s, lane);
        u32x2* o = (u32x2*)(XBA + row * DM) + lane;
#pragma unroll
        for (int j = 0; j < 4; ++j) { u32x2 w; w.x = pk2(v[j][0], v[j][1]); w.y = pk2(v[j][2], v[j][3]); o[64 * j] = w; }
        if (lane == 0) rs[row] = 1.f / sqrtf(s * (1.f / DM) + EPS); } }
    GSYNC();

    for (int l = 0; l < DEPTH; ++l) {
        bf16_t* Wl = Wall + (size_t)l * LAYER_W;
        { pg8::Gemm g{XBA, Wl + OFF_WIN, DM, DM}; pg8::RowOrder S{pm0, NIN_PAD / 256}; pg8::EpiZ E{Z, gates, rs};
          pg8::gemm_phase<pg8::EpiZ, pg8::RowOrder>(lds, g, S, E);
#if PROBE_MODE == 2
          pg8::gemm_phase<pg8::EpiZ, pg8::RowOrder>(lds, g, S, E);
#endif
          }
        GSYNC();
#if PROBE_MODE == 1 || PROBE_MODE == 6
        { FRESH_IDS; build_lut(P, lds, tid); __syncthreads(); attention_phase(P, lds, l, pm, wave, lane, P.out == nullptr); __syncthreads(); }
#endif
#if PROBE_MODE == 1 || PROBE_MODE == 7
        { FRESH_IDS; mlstm_state_phase(P, lds, l, pm, wave, lane); __syncthreads(); }
#endif
        if (!SKIP_ATTN) { FRESH_IDS;
            build_lut(P, lds, tid);
            __syncthreads();
            attention_phase(P, lds, l, pm, wave, lane);
        }
        __syncthreads();
        if (!SKIP_MLSTM) { FRESH_IDS; mlstm_state_phase(P, lds, l, pm, wave, lane); }
        GSYNC();
#if PROBE_MODE == 1 || PROBE_MODE == 8
        { FRESH_IDS; mlstm_scan_phase(P, lds, bx, G, tid, P.out == nullptr); }
#endif
        if (!SKIP_MLSTM) { FRESH_IDS; mlstm_scan_phase(P, lds, bx, G, tid); }
        GSYNC();
#if PROBE_MODE == 1 || PROBE_MODE == 9
        { FRESH_IDS; mlstm_out_phase(P, lds, l, pm, wave, lane); __syncthreads(); }
#endif
        if (!SKIP_MLSTM) { FRESH_IDS; mlstm_out_phase(P, lds, l, pm, wave, lane); }
        ZERO_SSQ();
        LOCAL_SEAM();
#if PROBE_MODE == 5
        { pg8::Gemm g{Z, Wl + OFF_WOUT, ZLD, DM}; pg8::RowOrder S{pm0, 4}; pg8::EpiResid<false> E{l == 0 ? P.x : P.out, P.out, XBA, nullptr, ssq, (P.out == nullptr)};
          pg8::gemm_phase<pg8::EpiResid<false>, pg8::RowOrder>(lds, g, S, E); }
        __syncthreads();
#endif
        { pg8::Gemm g{Z, Wl + OFF_WOUT, ZLD, DM}; pg8::RowOrder S{pm0, 4}; pg8::EpiResid<false> E{l == 0 ? P.x : P.out, P.out, XBA, nullptr, ssq, true};
          pg8::gemm_phase<pg8::EpiResid<false>, pg8::RowOrder>(lds, g, S, E); }
        __syncthreads();
        WRITE_RS();
        LOCAL_SEAM();
        { pg8::Gemm g{XBA, Wl + OFF_WUP, DM, DM}; pg8::RowOrder S{pm0, NUP / 256}; pg8::EpiSwiGLU E{Z, rs};
          pg8::gemm_phase<pg8::EpiSwiGLU, pg8::RowOrder>(lds, g, S, E);
#if PROBE_MODE == 2
          pg8::gemm_phase<pg8::EpiSwiGLU, pg8::RowOrder>(lds, g, S, E);
#endif
          }
        ZERO_SSQ();
        LOCAL_SEAM();
#if PROBE_MODE == 5
        { pg8::Gemm g{Z + ACT_OFF, Wl + OFF_WDOWN, ZLD, DFF}; pg8::RowOrder S{pm0, 4}; pg8::EpiResid<false> E{P.out, P.out, XBB, nullptr, ssq, (P.out == nullptr)};
          pg8::gemm_phase<pg8::EpiResid<false>, pg8::RowOrder>(lds, g, S, E); }
        __syncthreads();
#endif
        { pg8::Gemm g{Z + ACT_OFF, Wl + OFF_WDOWN, ZLD, DFF}; pg8::RowOrder S{pm0, 4}; pg8::EpiResid<false> E{P.out, P.out, XBB, nullptr, ssq, true};
          pg8::gemm_phase<pg8::EpiResid<false>, pg8::RowOrder>(lds, g, S, E); }
        { FRESH_IDS;
          for (int rr = wave; rr < 256; rr += 8) { const size_t row = (size_t)pm * 256 + rr;
            const f32x4 v = *((const f32x4*)(P.p + ((size_t)l * MTOK + row) * PLE) + lane); u32x2 w; w.x = pk2(v[0], v[1]); w.y = pk2(v[2], v[3]); *((u32x2*)(PB + row * PLE) + lane) = w; } }
        LOCAL_SEAM();
        { pg8::Gemm g{XBB, Wl + OFF_WG, DM, DM}; pg8::RowOrder S{pm0, 4}; pg8::EpiSigmoid E{Z};
          pg8::gemm_phase<pg8::EpiSigmoid, pg8::RowOrder>(lds, g, S, E);
#if PROBE_MODE == 2
          pg8::gemm_phase<pg8::EpiSigmoid, pg8::RowOrder>(lds, g, S, E);
#endif
          }
        ZERO_SSQ();
        LOCAL_SEAM();
#if PROBE_MODE == 5
        { pg8::Gemm g{PB, Wl + OFF_WP, PLE, PLE}; pg8::RowOrder S{pm0, 4}; pg8::EpiResid<true> E{P.out, P.out, XBA, Z, ssq, (P.out == nullptr)};
          pg8::gemm_phase<pg8::EpiResid<true>, pg8::RowOrder>(lds, g, S, E); }
        __syncthreads();
#endif
        { pg8::Gemm g{PB, Wl + OFF_WP, PLE, PLE}; pg8::RowOrder S{pm0, 4}; pg8::EpiResid<true> E{P.out, P.out, XBA, Z, ssq, true};
          pg8::gemm_phase<pg8::EpiResid<true>, pg8::RowOrder>(lds, g, S, E); }
        __syncthreads();
        WRITE_RS();
        LOCAL_SEAM();
    }
    { FRESH_IDS;
      for (int rr = wave; rr < 256; rr += 8) { const size_t row = (size_t)pm * 256 + rr; const float sc = rs[row];
        f32x4* xr = (f32x4*)(P.out + row * DM) + lane; const f32x4* gr = (const f32x4*)P.final_norm + lane;
#pragma unroll
        for (int j = 0; j < 4; ++j) xr[64 * j] = xr[64 * j] * sc * gr[64 * j]; } }
}

extern "C" void kernel_launch(void* const* d_in, const int* in_sizes, int n_in, void* d_out, int out_size, void* d_ws, size_t ws_size, hipStream_t stream) {
    static int ready = 0;
    if (ready == 0) {
        if (n_in != 16 || out_size != MTOK * DM || ws_size < WS_END) { fprintf(stderr, "kernel_launch: unexpected sizes (n_in %d, out %d, ws %zu)\n", n_in, out_size, ws_size); ready = -1; return; }
        if (hipFuncSetAttribute((const void*)fwd_kernel, hipFuncAttributeMaxDynamicSharedMemorySize, LDS_BYTES) != hipSuccess) { fprintf(stderr, "kernel_launch: hipFuncSetAttribute failed\n"); ready = -1; return; }
        int dev = 0, cus = 0, per_cu = 0;
        (void)hipGetDevice(&dev); (void)hipDeviceGetAttribute(&cus, hipDeviceAttributeMultiprocessorCount, dev);
        (void)hipOccupancyMaxActiveBlocksPerMultiprocessor(&per_cu, (const void*)fwd_kernel, 512, LDS_BYTES);
        if (cus != 256 || per_cu < 1) fprintf(stderr, "kernel_launch: note: %d CUs, %d blocks/CU (kernel expects 256 x 1)\n", cus, per_cu);
        (void)hipGetLastError();
        ready = 1;
    }
    if (ready < 0) return;
    KParams P{};
    P.x = (const float*)d_in[0]; P.p = (const float*)d_in[1]; P.rel_bias = (const float*)d_in[2]; P.attn_norm = (const float*)d_in[3]; P.w_in = (const float*)d_in[4];
    P.qk_conv = (const float*)d_in[5]; P.gate_bias = (const float*)d_in[6]; P.sink = (const float*)d_in[7]; P.mlstm_norm = (const float*)d_in[8]; P.w_out = (const float*)d_in[9];
    P.ffn_norm = (const float*)d_in[10]; P.w_up = (const float*)d_in[11]; P.w_down = (const float*)d_in[12]; P.ple_proj = (const float*)d_in[13]; P.ple_gate = (const float*)d_in[14];
    P.final_norm = (const float*)d_in[15]; P.out = (float*)d_out; P.ws = (unsigned char*)d_ws;
    void* args[] = {&P};
    hipError_t e = hipLaunchCooperativeKernel((const void*)fwd_kernel, dim3(256), dim3(512), args, LDS_BYTES, stream);
    if (e != hipSuccess) fprintf(stderr, "kernel_launch: cooperative launch failed: %s\n", hipGetErrorString(e));
}
```

```cpp
#include <hip/hip_runtime.h>
#include <hip/hip_cooperative_groups.h>
#include <cstdio>
#include <cstdint>
namespace cg = cooperative_groups;

#define LAS __attribute__((address_space(3)))
#define DI __device__ __forceinline__
typedef unsigned short bf16_t;
typedef short bf16x8 __attribute__((ext_vector_type(8)));
typedef short s16x4 __attribute__((ext_vector_type(4)));
typedef float f32x4 __attribute__((ext_vector_type(4)));
typedef float f32x2 __attribute__((ext_vector_type(2)));
typedef unsigned u32x4 __attribute__((ext_vector_type(4)));
typedef unsigned u32x2 __attribute__((ext_vector_type(2)));
typedef __bf16 bf16v2 __attribute__((ext_vector_type(2)));

constexpr int NB = 8, SEQ = 8192, DM = 1024, DEPTH = 4, MTOK = NB * SEQ;
constexpr int ZLD = 3200, NIN_PAD = 3328, DFF = 2816, NUP = 2 * DFF, PLE = 256, DIN = 3224;
constexpr int QA = 0, QB = 384, QC = 640, KA = 1024, KB = 1408, KC = 1536, VA = 1920, VB = 2304, VC = 2432, OC = 2816;
constexpr int ACT_OFF = 384;
constexpr float LOG2E = 1.4426950408889634f;
constexpr float QSCALE = 0.125f * LOG2E;
constexpr float EPS = 1e-6f;
constexpr float NEGBIG = -1e30f;
constexpr int NSEQ = 2 * NB * 6, NCH = SEQ / 64;

constexpr size_t OFF_WIN = 0, OFF_WOUT = OFF_WIN + (size_t)NIN_PAD * DM, OFF_WUP = OFF_WOUT + (size_t)DM * DM, OFF_WDOWN = OFF_WUP + (size_t)NUP * DM,
                 OFF_WP = OFF_WDOWN + (size_t)DM * DFF, OFF_WG = OFF_WP + (size_t)DM * PLE, LAYER_W = OFF_WG + (size_t)DM * DM;
constexpr size_t MiB = 1u << 20;
constexpr size_t WS_W = 1 * MiB, WS_PB = 112 * MiB, WS_GATES = 144 * MiB, WS_RS = 150 * MiB, WS_NB = 151 * MiB, WS_ML = 153 * MiB, WS_BL = WS_ML + 256 * 1024,
                 WS_MP = WS_ML + 512 * 1024, WS_QCONV = 154 * MiB, WS_KCONV = 202 * MiB, WS_XBA = 250 * MiB, WS_XBB = 378 * MiB, WS_Z = 506 * MiB, WS_CT = 906 * MiB,
                 WS_END = 1002 * MiB;
static_assert(WS_W + 4 * LAYER_W * 2 <= WS_PB, "weights");
static_assert(WS_Z + (size_t)MTOK * ZLD * 2 <= WS_CT, "z");
static_assert(WS_CT + (size_t)NSEQ * NCH * 4096 * 2 <= WS_END, "ct");

constexpr int LDS_BYTES = 155648;
constexpr int RING_BYTES = 131072, SSQ_OFF = 131072;

DI unsigned pk2(float lo, float hi) { f32x2 v = {lo, hi}; bf16v2 b = __builtin_convertvector(v, bf16v2); return __builtin_bit_cast(unsigned, b); }
DI float bf2f(unsigned short u) { return __uint_as_float(((unsigned)u) << 16); }
DI float bflo(unsigned u) { return __uint_as_float(u << 16); }
DI float bfhi(unsigned u) { return __uint_as_float(u & 0xffff0000u); }
DI float ex2(float x) { return __builtin_amdgcn_exp2f(x); }
DI float fexp(float x) { return __builtin_amdgcn_exp2f(x * LOG2E); }
DI float frcp(float x) { return __builtin_amdgcn_rcpf(x); }
DI float sigmoidf_(float x) { return frcp(1.f + fexp(-x)); }
DI f32x4 mfma16(bf16x8 a, bf16x8 b, f32x4 c) { return __builtin_amdgcn_mfma_f32_16x16x32_bf16(a, b, c, 0, 0, 0); }
DI f32x4 zero4() { float z; asm volatile("v_mov_b32 %0, 0" : "=v"(z)); return (f32x4){z, z, z, z}; }
DI s16x4 trread(LAS unsigned char* p) { return __builtin_amdgcn_ds_read_tr16_b64_v4i16((LAS s16x4*)p); }
DI bf16x8 cat8(s16x4 a, s16x4 b) { return __builtin_shufflevector(a, b, 0, 1, 2, 3, 4, 5, 6, 7); }
DI float shx(float v, int mask, int lane) { return __builtin_bit_cast(float, __builtin_amdgcn_ds_bpermute((lane ^ mask) << 2, __builtin_bit_cast(int, v))); }
DI float shi(float v, int idx) { return __builtin_bit_cast(float, __builtin_amdgcn_ds_bpermute(idx << 2, __builtin_bit_cast(int, v))); }
#define WAVE_LDS_FENCE() asm volatile("s_waitcnt lgkmcnt(0)" ::: "memory")
#define LOCAL_SEAM() do { asm volatile("s_waitcnt vmcnt(0) lgkmcnt(0)" ::: "memory"); __syncthreads(); __builtin_amdgcn_fence(__ATOMIC_ACQUIRE, "agent"); } while (0)

namespace pg8 {
constexpr int BM = 256, BK = 64, HALF = 128, HTB = HALF * BK * 2, STAGE_BYTES = 8 * HTB;
DI int lds_byte(int r, int c) { const int st = (r >> 4) * 2 + (c >> 5), rr = r & 15, cc = c & 31, ob = rr * 64 + cc * 2; return st * 1024 + (ob ^ (((ob >> 9) & 1) << 5)); }
DI void stage_rc(int b, int& R, int& C) { const int st = b / 1024, sb = b % 1024, swz = sb ^ (((sb >> 9) & 1) << 5); R = (st >> 1) * 16 + swz / 64; C = (st & 1) * 32 + (swz % 64) / 2; }
DI int perm32(int rho) { const int n = rho >> 4, i = rho & 15; return 8 * (i >> 2) + 4 * n + (i & 3); }
struct Unit { int pm, pn; };
struct Gemm { const bf16_t* A; const bf16_t* Bt; int lda, K; };
struct RowOrder {
    int pm, nN;
    DI bool next(int i, Unit& u) const { if (i >= nN) return false; u.pm = pm; u.pn = i; return true; }
};

template <class Epi, class Sched>
DI void gemm_phase(LAS unsigned char* lds, const Gemm g, const Sched& S, const Epi& E) {
    int tid = threadIdx.x; asm volatile("" : "+v"(tid));
    const int wid = __builtin_amdgcn_readfirstlane(tid >> 6), lane = tid & 63, wr = wid >> 2, wc = wid & 3, fr = lane & 15, fq = lane >> 4;
    const int K = g.K, nt = K / BK, lda = g.lda;
    unsigned voffA[2], voffB[2];
#pragma unroll
    for (int i = 0; i < 2; ++i) { int R, C; stage_rc(tid * 16 + i * 8192, R, C); const int Rb = Epi::PERM ? ((R & ~31) + perm32(R & 31)) : R;
        voffA[i] = (unsigned)(R * lda + C) * 2u; voffB[i] = (unsigned)(Rb * K + C) * 2u; }
    const size_t kstep = (size_t)(BK * 2);
    const size_t hsA = (size_t)HALF * lda * 2, hsB = (size_t)HALF * K * 2;
    const size_t tsA = 2 * hsA, tsB = 2 * hsB;
    const unsigned ldsw = (unsigned)wid * 1024u;
    const int aoff = lds_byte(wr * 64 + fr, fq * 8), boff = lds_byte(wc * 32 + fr, fq * 8);
#define PG8_SA(b, h) (((b) * 2 + (h)) * HTB)
#define PG8_SB(b, h) ((4 + (b) * 2 + (h)) * HTB)
#define PG8_STAGE(bufoff, gbase, voff) do { _Pragma("unroll") for (int _i = 0; _i < 2; ++_i) \
        __builtin_amdgcn_global_load_lds((const unsigned*)((const char*)(gbase) + (voff)[_i]), (LAS unsigned*)(lds + (bufoff) + ldsw + _i * 8192), 16, 0, 0); } while (0)
#define PG8_LDA(dst, b, h) do { _Pragma("unroll") for (int m = 0; m < 4; ++m) _Pragma("unroll") for (int k = 0; k < 2; ++k) dst[m][k] = *(const LAS bf16x8*)(lds + PG8_SA(b, h) + aoff + m * 2048 + k * 1024); } while (0)
#define PG8_LDB(dst, b, h) do { _Pragma("unroll") for (int n = 0; n < 2; ++n) _Pragma("unroll") for (int k = 0; k < 2; ++k) dst[n][k] = *(const LAS bf16x8*)(lds + PG8_SB(b, h) + boff + n * 2048 + k * 1024); } while (0)
#define PG8_MMA(ai, bj, At, Bt) do { __builtin_amdgcn_s_setprio(1); _Pragma("unroll") for (int m = 0; m < 4; ++m) _Pragma("unroll") for (int n = 0; n < 2; ++n) _Pragma("unroll") for (int k = 0; k < 2; ++k) \
        acc[ai][bj][m][n] = __builtin_amdgcn_mfma_f32_16x16x32_bf16(Bt[n][k], At[m][k], acc[ai][bj][m][n], 0, 0, 0); __builtin_amdgcn_s_setprio(0); } while (0)
#define PG8_WAIT_V(n) asm volatile("s_waitcnt vmcnt(" #n ")" ::: "memory")
#define PG8_WAIT_L(n) asm volatile("s_waitcnt lgkmcnt(" #n ")" ::: "memory")
#define PG8_BAR __builtin_amdgcn_s_barrier()
#define PG8_SCHED __builtin_amdgcn_sched_barrier(0)
    Unit cur, nxt; int ui = 0;
    if (!S.next(0, cur)) return;
    f32x4 acc[2][2][4][2];
    { float z0; asm volatile("v_mov_b32 %0, 0" : "=v"(z0));
#pragma unroll
    for (int a = 0; a < 2; ++a)
#pragma unroll
        for (int b = 0; b < 2; ++b)
#pragma unroll
            for (int m = 0; m < 4; ++m)
#pragma unroll
                for (int n = 0; n < 2; ++n) acc[a][b][m][n] = (f32x4){z0, z0, z0, z0}; }
    bf16x8 At[4][2], B0[2][2], B1[2][2];
    const char* cA = (const char*)g.A + (size_t)cur.pm * tsA; const char* cB = (const char*)g.Bt + (size_t)cur.pn * tsB;
    PG8_STAGE(PG8_SB(0, 0), cB, voffB); PG8_STAGE(PG8_SB(0, 1), cB + hsB, voffB); PG8_STAGE(PG8_SA(0, 0), cA, voffA); PG8_STAGE(PG8_SA(0, 1), cA + hsA, voffA);
    if (wr == 1) PG8_BAR;
    PG8_WAIT_V(2); PG8_BAR;
    PG8_STAGE(PG8_SB(1, 0), cB + kstep, voffB); PG8_STAGE(PG8_SA(1, 0), cA + kstep, voffA); PG8_STAGE(PG8_SB(1, 1), cB + hsB + kstep, voffB);
    PG8_WAIT_V(6); PG8_BAR;
    for (;;) {
        const bool has_next = S.next(ui + 1, nxt);
        const char* nA = has_next ? (const char*)g.A + (size_t)nxt.pm * tsA : cA; const char* nB = has_next ? (const char*)g.Bt + (size_t)nxt.pn * tsB : cB;
        for (int t = 0; t < nt; t += 2) {
            const bool last = (t == nt - 2);
            const char* a1 = cA + (size_t)(t + 1) * kstep;
            const char* a2 = last ? nA : cA + (size_t)(t + 2) * kstep; const char* b2 = last ? nB : cB + (size_t)(t + 2) * kstep;
            const char* a3 = a2 + kstep; const char* b3 = b2 + kstep;
            PG8_LDB(B0, 0, 0); PG8_LDB(B1, 0, 1); PG8_SCHED; PG8_LDA(At, 0, 0); PG8_STAGE(PG8_SA(1, 1), a1 + hsA, voffA);
            PG8_WAIT_V(8); PG8_WAIT_L(0); PG8_BAR; PG8_MMA(0, 0, At, B0); PG8_MMA(0, 1, At, B1); PG8_BAR; PG8_SCHED;
            PG8_LDA(At, 0, 1); PG8_STAGE(PG8_SB(0, 0), b2, voffB); PG8_STAGE(PG8_SB(0, 1), b2 + hsB, voffB); PG8_STAGE(PG8_SA(0, 0), a2, voffA);
            PG8_WAIT_V(8); PG8_WAIT_L(0); PG8_BAR; PG8_MMA(1, 0, At, B0); PG8_MMA(1, 1, At, B1); PG8_BAR; PG8_SCHED;
            PG8_LDB(B0, 1, 0); PG8_LDB(B1, 1, 1); PG8_SCHED; PG8_LDA(At, 1, 0); PG8_STAGE(PG8_SA(0, 1), a2 + hsA, voffA);
            PG8_WAIT_V(8); PG8_WAIT_L(0); PG8_BAR; PG8_MMA(0, 0, At, B0); PG8_MMA(0, 1, At, B1); PG8_BAR; PG8_SCHED;
            PG8_LDA(At, 1, 1); PG8_STAGE(PG8_SB(1, 0), b3, voffB); PG8_STAGE(PG8_SB(1, 1), b3 + hsB, voffB); PG8_STAGE(PG8_SA(1, 0), a3, voffA);
            PG8_WAIT_V(8); PG8_WAIT_L(0); PG8_BAR; PG8_MMA(1, 0, At, B0); PG8_MMA(1, 1, At, B1); PG8_BAR; PG8_SCHED;
        }
        if (wr == 0) PG8_BAR;
        E(acc, cur, wr, wc, fr, fq);
        if (!has_next) break;
        { float z0; asm volatile("v_mov_b32 %0, 0" : "=v"(z0));
#pragma unroll
        for (int a = 0; a < 2; ++a)
#pragma unroll
            for (int b = 0; b < 2; ++b)
#pragma unroll
                for (int m = 0; m < 4; ++m)
#pragma unroll
                    for (int n = 0; n < 2; ++n) acc[a][b][m][n] = (f32x4){z0, z0, z0, z0}; }
        cur = nxt; cA = nA; cB = nB; ++ui;
        if (wr == 1) PG8_BAR;
    }
    PG8_WAIT_V(0);
    PG8_BAR;
#undef PG8_SA
#undef PG8_SB
#undef PG8_STAGE
#undef PG8_LDA
#undef PG8_LDB
#undef PG8_MMA
#undef PG8_WAIT_V
#undef PG8_WAIT_L
#undef PG8_BAR
#undef PG8_SCHED
}

struct EpiZ {
    static constexpr bool PERM = true;
    bf16_t* Z; float* gates; const float* rs;
    DI void operator()(const f32x4 (&acc)[2][2][4][2], const Unit& u, int wr, int wc, int fr, int fq) const {
        asm volatile("" : "+v"(fr), "+v"(fq));
        const int row0 = u.pm * BM + wr * 64 + fr, col0 = u.pn * BM + wc * 32 + 8 * fq;
#pragma unroll
        for (int ai = 0; ai < 2; ++ai)
#pragma unroll
            for (int m = 0; m < 4; ++m) { const int row = row0 + ai * HALF + m * 16; const float sc = rs[row];
#pragma unroll
                for (int bj = 0; bj < 2; ++bj) { const int col = col0 + bj * HALF; const f32x4 v0 = acc[ai][bj][m][0] * sc, v1 = acc[ai][bj][m][1] * sc;
                    if (col < ZLD) { u32x4 w; w.x = pk2(v0[0], v0[1]); w.y = pk2(v0[2], v0[3]); w.z = pk2(v1[0], v1[1]); w.w = pk2(v1[2], v1[3]); *(u32x4*)(Z + (size_t)row * ZLD + col) = w; }
                    else if (col < DIN) { float* gp = gates + (size_t)row * 24 + (col - ZLD); *(f32x4*)gp = v0; *(f32x4*)(gp + 4) = v1; } }
                asm volatile("" ::: "memory"); }
    }
};
struct EpiSwiGLU {
    static constexpr bool PERM = true;
    bf16_t* Z; const float* rs;
    DI void operator()(const f32x4 (&acc)[2][2][4][2], const Unit& u, int wr, int wc, int fr, int fq) const {
        asm volatile("" : "+v"(fr), "+v"(fq));
        const int row0 = u.pm * BM + wr * 64 + fr, col0 = ACT_OFF + u.pn * HALF + wc * 32 + 8 * fq;
#pragma unroll
        for (int ai = 0; ai < 2; ++ai)
#pragma unroll
            for (int m = 0; m < 4; ++m) { const int row = row0 + ai * HALF + m * 16; const float sc = rs[row]; float o[8];
#pragma unroll
                for (int n = 0; n < 2; ++n)
#pragma unroll
                    for (int i = 0; i < 4; ++i) { const float gg = acc[ai][0][m][n][i] * sc, uu = acc[ai][1][m][n][i] * sc; o[4 * n + i] = gg * sigmoidf_(gg) * uu; }
                u32x4 w; w.x = pk2(o[0], o[1]); w.y = pk2(o[2], o[3]); w.z = pk2(o[4], o[5]); w.w = pk2(o[6], o[7]);
                *(u32x4*)(Z + (size_t)row * ZLD + col0) = w;
                asm volatile("" ::: "memory"); }
    }
};
struct EpiSigmoid {
    static constexpr bool PERM = true;
    bf16_t* Z;
    DI void operator()(const f32x4 (&acc)[2][2][4][2], const Unit& u, int wr, int wc, int fr, int fq) const {
        asm volatile("" : "+v"(fr), "+v"(fq));
        const int row0 = u.pm * BM + wr * 64 + fr, col0 = u.pn * BM + wc * 32 + 8 * fq;
#pragma unroll
        for (int ai = 0; ai < 2; ++ai)
#pragma unroll
            for (int m = 0; m < 4; ++m) { const int row = row0 + ai * HALF + m * 16;
#pragma unroll
                for (int bj = 0; bj < 2; ++bj) { const f32x4 v0 = acc[ai][bj][m][0], v1 = acc[ai][bj][m][1]; u32x4 w;
                    w.x = pk2(sigmoidf_(v0[0]), sigmoidf_(v0[1])); w.y = pk2(sigmoidf_(v0[2]), sigmoidf_(v0[3])); w.z = pk2(sigmoidf_(v1[0]), sigmoidf_(v1[1])); w.w = pk2(sigmoidf_(v1[2]), sigmoidf_(v1[3]));
                    *(u32x4*)(Z + (size_t)row * ZLD + col0 + bj * HALF) = w; }
                asm volatile("" ::: "memory"); }
    }
};
template <bool MUL> struct EpiResid {
    static constexpr bool PERM = false;
    const bf16_t* resid; bf16_t* xb; const bf16_t* mul; LAS float* ssq; bool wr_en;
    DI void operator()(const f32x4 (&acc)[2][2][4][2], const Unit& u, int wr, int wc, int fr, int fq) const {
        asm volatile("" : "+v"(fr), "+v"(fq));
        const int col0 = u.pn * BM + wc * 32 + 4 * fq;
#pragma unroll
        for (int ai = 0; ai < 2; ++ai)
#pragma unroll
            for (int m = 0; m < 4; ++m) { const int rl = ai * HALF + wr * 64 + m * 16 + fr; const size_t row = (size_t)(u.pm * BM + rl); float s = 0.f;
#pragma unroll
                for (int bj = 0; bj < 2; ++bj)
#pragma unroll
                    for (int n = 0; n < 2; ++n) { const int col = col0 + bj * HALF + n * 16; f32x4 a = acc[ai][bj][m][n];
                        if (MUL) { const u32x2 mv = *(const u32x2*)(mul + row * ZLD + col); a[0] *= bflo(mv.x); a[1] *= bfhi(mv.x); a[2] *= bflo(mv.y); a[3] *= bfhi(mv.y); }
                        const u32x2 rv = *(const u32x2*)(resid + row * DM + col);
                        const f32x4 x = {bflo(rv.x) + a[0], bfhi(rv.x) + a[1], bflo(rv.y) + a[2], bfhi(rv.y) + a[3]};
                        if (wr_en) { u32x2 w; w.x = pk2(x[0], x[1]); w.y = pk2(x[2], x[3]); *(u32x2*)(xb + row * DM + col) = w; }
                        s += (x[0] * x[0] + x[1] * x[1]) + (x[2] * x[2] + x[3] * x[3]); }
                { const int lid = fr + 16 * fq;
                  s += __builtin_bit_cast(float, __builtin_amdgcn_ds_bpermute((lid ^ 16) << 2, __builtin_bit_cast(int, s)));
                  s += __builtin_bit_cast(float, __builtin_amdgcn_ds_bpermute((lid ^ 32) << 2, __builtin_bit_cast(int, s))); }
                if (fq == 0 && wr_en) ssq[rl * 4 + wc] += s;
                asm volatile("" ::: "memory"); }
    }
};
}

struct KParams {
    const float* x; const float* p; const float* rel_bias; const float* attn_norm; const float* w_in; const float* qk_conv; const float* gate_bias; const float* sink;
    const float* mlstm_norm; const float* w_out; const float* ffn_norm; const float* w_up; const float* w_down; const float* ple_proj; const float* ple_gate; const float* final_norm;
    float* out; unsigned char* ws;
};

DI void transpose_item(const float* __restrict__ W, int K, int Nsrc, int n0, int nvalid, const float* __restrict__ gk, float cs,
                       bf16_t* __restrict__ WT, int dst_row0, int k0, LAS float* scr, int lane) {
    const int c = lane & 31, kh = lane >> 5;
#pragma unroll 8
    for (int i = 0; i < 32; ++i) { const int kk = 2 * i + kh; float v = 0.f;
        if (c < nvalid) { v = W[(size_t)(k0 + kk) * Nsrc + n0 + c] * cs; if (gk) v *= gk[k0 + kk]; }
        scr[kk * 33 + c] = v; }
    WAVE_LDS_FENCE();
    const int c8 = lane & 7;
#pragma unroll
    for (int j = 0; j < 4; ++j) { const int n = (lane >> 3) + 8 * j; const LAS float* s = scr + (8 * c8) * 33 + n;
        u32x4 o; o.x = pk2(s[0 * 33], s[1 * 33]); o.y = pk2(s[2 * 33], s[3 * 33]); o.z = pk2(s[4 * 33], s[5 * 33]); o.w = pk2(s[6 * 33], s[7 * 33]);
        *(u32x4*)(WT + (size_t)(dst_row0 + n) * K + k0 + 8 * c8) = o; }
    WAVE_LDS_FENCE();
}
constexpr int IT_WIN = 16 * 104, IT_WOUT = 16 * 32, IT_WUP = 16 * 176, IT_WDOWN = 44 * 32, IT_WP = 4 * 32, IT_WG = 16 * 32;
constexpr int IT_LAYER = IT_WIN + IT_WOUT + IT_WUP + IT_WDOWN + IT_WP + IT_WG;

DI void prep_weights(const KParams& P, LAS unsigned char* lds, int gw, int NGW, int wave, int lane) {
    LAS float* scr = (LAS float*)(lds + wave * 16384);
    bf16_t* Wall = (bf16_t*)(P.ws + WS_W);
    for (int it = gw; it < DEPTH * IT_LAYER; it += NGW) {
        const int l = it / IT_LAYER; int r = it % IT_LAYER;
        bf16_t* Wl = Wall + (size_t)l * LAYER_W;
        if (r < IT_WIN) { const int kb = r / 104, jb = r % 104, d0 = 32 * jb; int src = d0, nv = 32; float cs = 1.f;
            if (d0 < 384) { src = d0; cs = QSCALE; } else if (d0 < 640) { src = 1152 + d0 - 384; cs = QSCALE; } else if (d0 < 1024) src = 1664 + d0 - 640;
            else if (d0 < 1408) src = 384 + d0 - 1024; else if (d0 < 1536) src = d0; else if (d0 < 1920) src = 2048 + d0 - 1536;
            else if (d0 < 2304) src = 768 + d0 - 1920; else if (d0 < 2432) src = 1536 + d0 - 2304; else if (d0 < 3200) src = d0;
            else if (d0 == 3200) { src = 3200; nv = 24; } else { src = 0; nv = 0; }
            transpose_item(P.w_in + (size_t)l * DM * DIN, DM, DIN, src, nv, P.attn_norm + l * DM, cs, Wl + OFF_WIN, d0, 64 * kb, scr, lane); continue; }
        r -= IT_WIN;
        if (r < IT_WOUT) { const int kb = r / 32, jb = r % 32; transpose_item(P.w_out + (size_t)l * DM * DM, DM, DM, 32 * jb, 32, nullptr, 1.f, Wl + OFF_WOUT, 32 * jb, 64 * kb, scr, lane); continue; }
        r -= IT_WOUT;
        if (r < IT_WUP) { const int kb = r / 176, jb = r % 176, d0 = 32 * jb, pn = d0 >> 8, c0 = d0 & 255; const int src = c0 < 128 ? 128 * pn + c0 : DFF + 128 * pn + (c0 - 128);
            transpose_item(P.w_up + (size_t)l * DM * NUP, DM, NUP, src, 32, P.ffn_norm + l * DM, 1.f, Wl + OFF_WUP, d0, 64 * kb, scr, lane); continue; }
        r -= IT_WUP;
        if (r < IT_WDOWN) { const int kb = r / 32, jb = r % 32; transpose_item(P.w_down + (size_t)l * DFF * DM, DFF, DM, 32 * jb, 32, nullptr, 1.f, Wl + OFF_WDOWN, 32 * jb, 64 * kb, scr, lane); continue; }
        r -= IT_WDOWN;
        if (r < IT_WP) { const int kb = r / 32, jb = r % 32; transpose_item(P.ple_proj + (size_t)l * PLE * DM, PLE, DM, 32 * jb, 32, nullptr, 1.f, Wl + OFF_WP, 32 * jb, 64 * kb, scr, lane); continue; }
        r -= IT_WP;
        { const int kb = r / 32, jb = r % 32; transpose_item(P.ple_gate + (size_t)l * DM * DM, DM, DM, 32 * jb, 32, nullptr, 1.f, Wl + OFF_WG, 32 * jb, 64 * kb, scr, lane); }
    }
}
DI float wave_sum(float v, int lane) {
#pragma unroll
    for (int o = 1; o < 64; o <<= 1) v += shx(v, o, lane);
    return v;
}
DI float wave_max(float v, int lane) {
#pragma unroll
    for (int o = 1; o < 64; o <<= 1) v = fmaxf(v, shx(v, o, lane));
    return v;
}

constexpr int VROW = 144;
constexpr int VBUF = 32 * VROW;
constexpr int LUTN = 640, LUTC = 320;

DI void load_kv(const bf16_t* __restrict__ zb, int kcol, int vcol, int dstr, int rd, int u0, int lane, bf16x8 (&kn)[2][2], u32x4 (&vn)[4]) {
    const int r16 = lane & 15, g = lane >> 4;
#pragma unroll
    for (int T = 0; T < 2; ++T) { int pos = dstr * (u0 + 16 * T + r16) + rd; pos = pos < 0 ? 0 : (pos > SEQ - 1 ? SEQ - 1 : pos);
        const bf16_t* p = zb + (size_t)pos * ZLD + kcol + 8 * g; kn[T][0] = *(const bf16x8*)p; kn[T][1] = *(const bf16x8*)(p + 32); }
#pragma unroll
    for (int k = 0; k < 4; ++k) { const int id = lane + 64 * k, row = id >> 3, c16 = id & 7; int pos = dstr * (u0 + row) + rd; pos = pos < 0 ? 0 : (pos > SEQ - 1 ? SEQ - 1 : pos);
        vn[k] = *(const u32x4*)(zb + (size_t)pos * ZLD + vcol + 8 * c16); }
}

struct DescA {
    int rd0, rd1, ub0, ub1, ub2, uq0, uq1, uq2, tb;
    DI void get(int ci, int g, int& dstr, int& rd, int& u0, int& li) const {
        const int cf = ci < 5 ? 0 : (ci < 11 ? 1 : 2); const int lc = ci - (cf == 0 ? 0 : (cf == 1 ? 5 : 11));
        dstr = cf == 0 ? 16 : (cf == 1 ? 4 : 1); rd = cf == 0 ? rd0 : (cf == 1 ? rd1 : 0);
        u0 = (cf == 0 ? ub0 : (cf == 1 ? ub1 : ub2)) + 32 * lc;
        const int uq = cf == 0 ? uq0 : (cf == 1 ? uq1 : uq2);
        li = u0 - uq + 4 * g + LUTC + tb + cf * 6 * LUTN; }
};
struct DescB {
    int ub, uq, tb;
    DI void get(int ci, int g, int& dstr, int& rd, int& u0, int& li) const { dstr = 1; rd = 0; u0 = ub + 32 * ci; li = u0 - uq + 4 * g + LUTC + tb; }
};

template <int NH, int D, class Desc>
DI void attn_stream(const bf16_t* __restrict__ zb, int kcol, int vcol, int nch, const Desc& ds, const LAS float* lutbase,
                    const bf16x8 (&qf)[NH][2], float (&m)[NH], float (&l)[NH], f32x4 (&o)[NH][4], LAS unsigned char* vbase, int lane) {
    const int r16 = lane & 15, g = lane >> 4, q4 = r16 >> 2, p4 = r16 & 3;
    bf16x8 kn[D][2][2]; u32x4 vn[D][4];
#pragma unroll
    for (int j = 0; j < D; ++j) if (j < nch) { int dstr, rd, u0, li; ds.get(j, g, dstr, rd, u0, li); load_kv(zb, kcol, vcol, dstr, rd, u0, lane, kn[j], vn[j]); }
    for (int c0 = 0; c0 < nch; c0 += D) {
#pragma unroll
        for (int j = 0; j < D; ++j) {
            const int c = c0 + j;
            if (c < nch) {
                int dstr, rd, u0, li; ds.get(c, g, dstr, rd, u0, li);
                LAS unsigned char* vb = vbase + (c & 1) * VBUF;
#pragma unroll
                for (int k = 0; k < 4; ++k) { const int id = lane + 64 * k, row = id >> 3, c16 = id & 7; *(LAS u32x4*)(vb + row * VROW + c16 * 16) = vn[j][k]; }
                f32x4 stt[NH][2];
#pragma unroll
                for (int hh = 0; hh < NH; ++hh)
#pragma unroll
                    for (int T = 0; T < 2; ++T) { f32x4 st = {0.f, 0.f, 0.f, 0.f}; st = mfma16(kn[j][T][0], qf[hh][0], st); st = mfma16(kn[j][T][1], qf[hh][1], st); stt[hh][T] = st; }
                if (c + D < nch) { int d2, r2, u2, l2; ds.get(c + D, g, d2, r2, u2, l2); load_kv(zb, kcol, vcol, d2, r2, u2, lane, kn[j], vn[j]); }
                float rm[2][4];
#pragma unroll
                for (int T = 0; T < 2; ++T)
#pragma unroll
                    for (int i = 0; i < 4; ++i) { const int pos = dstr * (u0 + 16 * T + 4 * g + i) + rd; rm[T][i] = ((unsigned)pos < (unsigned)SEQ) ? 0.f : NEGBIG; }
                bf16x8 vf[4];
#pragma unroll
                for (int c4 = 0; c4 < 4; ++c4) { const s16x4 a0 = trread(vb + (4 * g + q4) * VROW + 32 * c4 + 8 * p4), a1 = trread(vb + (16 + 4 * g + q4) * VROW + 32 * c4 + 8 * p4); vf[c4] = cat8(a0, a1); }
#pragma unroll
                for (int hh = 0; hh < NH; ++hh) {
                    const LAS float* lut = lutbase + hh * LUTN + li;
                    float sv[8];
#pragma unroll
                    for (int T = 0; T < 2; ++T) {
#pragma unroll
                        for (int i = 0; i < 4; ++i) sv[4 * T + i] = stt[hh][T][i] + lut[16 * T + i] + rm[T][i]; }
                    float cm = fmaxf(fmaxf(fmaxf(sv[0], sv[1]), fmaxf(sv[2], sv[3])), fmaxf(fmaxf(sv[4], sv[5]), fmaxf(sv[6], sv[7])));
                    cm = fmaxf(cm, shx(cm, 16, lane)); cm = fmaxf(cm, shx(cm, 32, lane));
                    const float mn = fmaxf(m[hh], cm), alpha = ex2(m[hh] - mn); m[hh] = mn;
                    float pv[8], ps = 0.f;
#pragma unroll
                    for (int k = 0; k < 8; ++k) { pv[k] = ex2(sv[k] - mn); ps += pv[k]; }
                    l[hh] = l[hh] * alpha + ps;
                    u32x4 pw; pw.x = pk2(pv[0], pv[1]); pw.y = pk2(pv[2], pv[3]); pw.z = pk2(pv[4], pv[5]); pw.w = pk2(pv[6], pv[7]);
                    const bf16x8 pf = __builtin_bit_cast(bf16x8, pw);
#pragma unroll
                    for (int c4 = 0; c4 < 4; ++c4) { o[hh][c4] = o[hh][c4] * alpha; o[hh][c4] = mfma16(vf[c4], pf, o[hh][c4]); }
                }
            }
        }
    }
}

DI void build_lut(const KParams& P, LAS unsigned char* lds, int tid) {
    LAS float* lut = (LAS float*)lds;
    for (int idx = tid; idx < 22 * LUTN; idx += 512) {
        const int t = idx / LUTN, rel = idx % LUTN - LUTC; int dil, half, hc;
        if (t < 18) { const int cfg = t / 6; dil = cfg == 0 ? 16 : (cfg == 1 ? 4 : 1); half = 64; hc = t % 6; } else { dil = 1; half = 128; hc = 6 + (t - 18); }
        float v = NEGBIG; const int ar = rel < 0 ? -rel : rel;
        if (ar <= half) { const int n = ar * dil; int bk;
            if (n < 8) bk = n; else { const float nf = (float)n; bk = 8 + (int)(logf(nf / 8.0f) / 4.852030263919617f * 8.0f); bk = bk > 15 ? 15 : bk; }
            if (rel > 0) bk += 16;
            v = P.rel_bias[bk * 10 + hc] * LOG2E; }
        lut[idx] = v;
    }
}

DI void attention_phase(const KParams& P0_, LAS unsigned char* lds, int l, int pm, int wave, int lane, bool wr_en = true) {
    KParams P = P0_; { __attribute__((address_space(1))) unsigned char* w1_ = (__attribute__((address_space(1))) unsigned char*)P.ws; asm volatile("" : "+s"(w1_)); P.ws = (unsigned char*)w1_; }

    bf16_t* Z = (bf16_t*)(P.ws + WS_Z);
    const int r16 = lane & 15, g = lane >> 4;
    const int row0 = pm * 256, b = row0 / SEQ, s0 = row0 % SEQ;
    bf16_t* zb = Z + (size_t)b * SEQ * ZLD;
    const LAS float* lut = (const LAS float*)lds;
    LAS unsigned char* vbase = lds + 22 * LUTN * 4 + wave * (2 * VBUF);
    for (int ua = wave; ua < 96; ua += 8) {
        const int h = ua >> 4, rho = ua & 15;
        const int posq = s0 + rho + 16 * r16;
        bf16x8 qf[1][2];
        { const bf16_t* qp = zb + (size_t)posq * ZLD + QA + 64 * h + 8 * g; qf[0][0] = *(const bf16x8*)qp; qf[0][1] = *(const bf16x8*)(qp + 32); }
        float m[1] = {-1e20f}, lsum[1] = {0.f}; f32x4 o[1][4];
#pragma unroll
        for (int c4 = 0; c4 < 4; ++c4) o[0][c4] = zero4();
        { DescA ds; const int U16 = s0 >> 4, U4 = (s0 >> 2) + (rho >> 2), U1 = s0 + rho;
          ds.rd0 = rho; ds.rd1 = rho & 3; ds.ub0 = U16 - 64; ds.ub1 = U4 - 64; ds.ub2 = U1 - 64; ds.uq0 = U16 + r16; ds.uq1 = U4 + 4 * r16; ds.uq2 = U1 + 16 * r16; ds.tb = h * LUTN;
          attn_stream<1, 2, DescA>(zb, KA + 64 * h, VA + 64 * h, 23, ds, lut, qf, m, lsum, o, vbase, lane); }
        float lt = lsum[0]; lt += shx(lt, 16, lane); lt += shx(lt, 32, lane);
        const float inv = 1.f / lt;
        bf16_t* yp = zb + (size_t)posq * ZLD + QA + 64 * h + 4 * g;
        if (wr_en)
#pragma unroll
        for (int c4 = 0; c4 < 4; ++c4) { const f32x4 v = o[0][c4] * inv; u32x2 w; w.x = pk2(v[0], v[1]); w.y = pk2(v[2], v[3]); *(u32x2*)(yp + 16 * c4) = w; }
    }
    for (int ub = wave; ub < 32; ub += 8) {
        const int kvh = ub >> 4, qg = ub & 15;
        const int posq = s0 + 16 * qg + r16;
        bf16x8 qf[2][2];
#pragma unroll
        for (int hh = 0; hh < 2; ++hh) { const bf16_t* qp = zb + (size_t)posq * ZLD + QB + 64 * (2 * kvh + hh) + 8 * g; qf[hh][0] = *(const bf16x8*)qp; qf[hh][1] = *(const bf16x8*)(qp + 32); }
        float m[2] = {-1e20f, -1e20f}, lsum[2] = {0.f, 0.f}; f32x4 o[2][4];
#pragma unroll
        for (int hh = 0; hh < 2; ++hh)
#pragma unroll
            for (int c4 = 0; c4 < 4; ++c4) o[hh][c4] = zero4();
        const int U0 = s0 + 16 * qg;
        { DescB ds; ds.ub = U0 - 128; ds.uq = U0 + r16; ds.tb = (18 + 2 * kvh) * LUTN;
          attn_stream<2, 2, DescB>(zb, KB + 64 * kvh, VB + 64 * kvh, 9, ds, lut, qf, m, lsum, o, vbase, lane); }
#pragma unroll
        for (int hh = 0; hh < 2; ++hh) { const int hq = 2 * kvh + hh;
            float lt = lsum[hh]; lt += shx(lt, 16, lane); lt += shx(lt, 32, lane);
            const float sk = P.sink[l * 4 + hq] * LOG2E, mf = fmaxf(m[hh], sk), sc = ex2(m[hh] - mf);
            const float den = lt * sc + ex2(sk - mf), f = sc / den;
            bf16_t* yp = zb + (size_t)posq * ZLD + QB + 64 * hq + 4 * g;
            if (wr_en)
#pragma unroll
            for (int c4 = 0; c4 < 4; ++c4) { const f32x4 v = o[hh][c4] * f; u32x2 w; w.x = pk2(v[0], v[1]); w.y = pk2(v[2], v[3]); *(u32x2*)(yp + 16 * c4) = w; } }
    }
}

DI float logsig(float x) { return fminf(x, 0.f) - log1pf(fexp(-fabsf(x))); }
DI float scan_add_up(float v, int lane) {
#pragma unroll
    for (int o = 1; o < 64; o <<= 1) { const float t = shi(v, lane - o); if (lane >= o) v += t; }
    return v;
}
DI float scan_add_down(float v, int lane) {
#pragma unroll
    for (int o = 1; o < 64; o <<= 1) { const float t = shi(v, lane + o); if (lane + o < 64) v += t; }
    return v;
}
DI float scan_max_up(float v, int lane) {
#pragma unroll
    for (int o = 1; o < 64; o <<= 1) { const float t = shi(v, lane - o); if (lane >= o) v = fmaxf(v, t); }
    return v;
}
DI float scan_max_down(float v, int lane) {
#pragma unroll
    for (int o = 1; o < 64; o <<= 1) { const float t = shi(v, lane + o); if (lane + o < 64) v = fmaxf(v, t); }
    return v;
}

DI void conv8(const bf16_t* __restrict__ zb, int s, int col, const float* __restrict__ cw  , int lane, float (&acc)[8][8]) {
    const int r8 = lane >> 3;
    float w[5][8];
#pragma unroll
    for (int j = 0; j < 5; ++j) { const f32x4 a = *(const f32x4*)(cw + j * 768), b = *(const f32x4*)(cw + j * 768 + 4);
        w[j][0] = a[0]; w[j][1] = a[1]; w[j][2] = a[2]; w[j][3] = a[3]; w[j][4] = b[0]; w[j][5] = b[1]; w[j][6] = b[2]; w[j][7] = b[3]; }
#pragma unroll
    for (int k = 0; k < 8; ++k)
#pragma unroll
        for (int e = 0; e < 8; ++e) acc[k][e] = 0.f;
#pragma unroll
    for (int rr = -2; rr < 10; ++rr) {
        const int pos = s + 8 * r8 + rr;
        u32x4 raw = {0u, 0u, 0u, 0u};
        if ((unsigned)pos < (unsigned)SEQ) raw = *(const u32x4*)(zb + (size_t)pos * ZLD + col);
        float x[8] = {bflo(raw.x), bfhi(raw.x), bflo(raw.y), bfhi(raw.y), bflo(raw.z), bfhi(raw.z), bflo(raw.w), bfhi(raw.w)};
#pragma unroll
        for (int k = 0; k < 8; ++k) { const int j = rr - k + 2;
            if (j >= 0 && j <= 4) {
#pragma unroll
                for (int e = 0; e < 8; ++e) acc[k][e] += w[j][e] * x[e]; } }
    }
#pragma unroll
    for (int k = 0; k < 8; ++k)
#pragma unroll
        for (int e = 0; e < 8; ++e) { const float a = acc[k][e]; acc[k][e] = a * sigmoidf_(a); }
}

DI void mlstm_state_phase(const KParams& P0_, LAS unsigned char* lds, int l, int pm, int wave, int lane) {
    KParams P = P0_; { __attribute__((address_space(1))) unsigned char* w1_ = (__attribute__((address_space(1))) unsigned char*)P.ws; asm volatile("" : "+s"(w1_)); P.ws = (unsigned char*)w1_; }

    bf16_t* Z = (bf16_t*)(P.ws + WS_Z);
    const float* gates = (const float*)(P.ws + WS_GATES);
    bf16_t* qconv = (bf16_t*)(P.ws + WS_QCONV); bf16_t* kconv = (bf16_t*)(P.ws + WS_KCONV);
    bf16_t* CT = (bf16_t*)(P.ws + WS_CT); bf16_t* nbuf = (bf16_t*)(P.ws + WS_NB);
    float* mloc = (float*)(P.ws + WS_ML); float* blast = (float*)(P.ws + WS_BL);
    const float* gb = P.gate_bias + l * 24;
    const int r16 = lane & 15, g = lane >> 4, q4 = r16 >> 2, p4 = r16 & 3, r8 = lane >> 3, pc = lane & 7;
    LAS unsigned char* kbuf = lds + wave * (2 * 64 * VROW);
    LAS unsigned char* vbuf = kbuf + 64 * VROW;
    for (int um = wave; um < 24; um += 8) {
        asm volatile("" : "+v"(lane));
        const int cc = um / 6, h = um % 6;
        const int tc = pm * 256 + 64 * cc, b = tc / SEQ, s = tc % SEQ, ci = s >> 6;
        const bf16_t* zb = Z + (size_t)b * SEQ * ZLD;
        const float* G = gates + (size_t)(tc + lane) * 24;
        const float igf = G[h] + gb[h], fgf = G[6 + h] + gb[6 + h], igb = G[12 + h] + gb[12 + h], fgb = G[18 + h] + gb[18 + h];
        const float bfw = scan_add_up(logsig(fgf), lane), bbw = scan_add_down(logsig(fgb), lane);
        const float blf = shi(bfw, 63), blb = shi(bbw, 0);
        const float wf = blf - bfw + igf, wb = blb - bbw + igb;
        const float mlf = wave_max(wf, lane), mlb = wave_max(wb, lane);
        const float ef = fexp(wf - mlf), eb = fexp(wb - mlb);
        const int slot_f = ((0 * NB + b) * 6 + h) * NCH + ci, slot_b = ((1 * NB + b) * 6 + h) * NCH + ci;
        if (lane == 0) { mloc[slot_f] = mlf; blast[slot_f] = blf; mloc[slot_b] = mlb; blast[slot_b] = blb; }
        float acc[8][8];
        conv8(zb, s, QC + 64 * h + 8 * pc, P.qk_conv + (size_t)l * 5 * 768 + 64 * h + 8 * pc, lane, acc);
#pragma unroll
        for (int k = 0; k < 8; ++k) { u32x4 w; w.x = pk2(acc[k][0], acc[k][1]); w.y = pk2(acc[k][2], acc[k][3]); w.z = pk2(acc[k][4], acc[k][5]); w.w = pk2(acc[k][6], acc[k][7]);
            *(u32x4*)(qconv + (size_t)(tc + 8 * r8 + k) * 384 + 64 * h + 8 * pc) = w; }
        conv8(zb, s, KC + 64 * h + 8 * pc, P.qk_conv + (size_t)l * 5 * 768 + 384 + 64 * h + 8 * pc, lane, acc);
        u32x4 kpk[8];
#pragma unroll
        for (int k = 0; k < 8; ++k) {
#pragma unroll
            for (int e = 0; e < 8; ++e) acc[k][e] *= 0.125f;
            u32x4 w; w.x = pk2(acc[k][0], acc[k][1]); w.y = pk2(acc[k][2], acc[k][3]); w.z = pk2(acc[k][4], acc[k][5]); w.w = pk2(acc[k][6], acc[k][7]);
            kpk[k] = w;
            *(u32x4*)(kconv + (size_t)(tc + 8 * r8 + k) * 384 + 64 * h + 8 * pc) = w; }
#pragma unroll
        for (int k = 0; k < 8; ++k) { const int id = lane + 64 * k, row = id >> 3, c16 = id & 7;
            *(LAS u32x4*)(vbuf + row * VROW + 16 * c16) = *(const u32x4*)(zb + (size_t)(s + row) * ZLD + VC + 64 * h + 8 * c16); }
#pragma unroll
        for (int dir = 0; dir < 2; ++dir) {
            const float ed = dir ? eb : ef;
#pragma unroll
            for (int k = 0; k < 8; ++k) { const float e = shi(ed, 8 * r8 + k); const u32x4 kk = kpk[k];
                u32x4 w; w.x = pk2(bflo(kk.x) * e, bfhi(kk.x) * e); w.y = pk2(bflo(kk.y) * e, bfhi(kk.y) * e); w.z = pk2(bflo(kk.z) * e, bfhi(kk.z) * e); w.w = pk2(bflo(kk.w) * e, bfhi(kk.w) * e);
                *(LAS u32x4*)(kbuf + (8 * r8 + k) * VROW + 16 * pc) = w; }
            WAVE_LDS_FENCE();
            f32x4 c[4][5];
#pragma unroll
            for (int dt = 0; dt < 4; ++dt)
#pragma unroll
                for (int et = 0; et < 5; ++et) c[dt][et] = zero4();
#pragma unroll
            for (int ks = 0; ks < 2; ++ks) {
                bf16x8 af[4], bfr[5];
#pragma unroll
                for (int t4 = 0; t4 < 4; ++t4) {
                    af[t4] = cat8(trread(kbuf + (32 * ks + 8 * g + q4) * VROW + 32 * t4 + 8 * p4), trread(kbuf + (32 * ks + 8 * g + 4 + q4) * VROW + 32 * t4 + 8 * p4));
                    bfr[t4] = cat8(trread(vbuf + (32 * ks + 8 * g + q4) * VROW + 32 * t4 + 8 * p4), trread(vbuf + (32 * ks + 8 * g + 4 + q4) * VROW + 32 * t4 + 8 * p4)); }
                { const short one = r16 == 0 ? (short)0x3F80 : (short)0; bfr[4] = (bf16x8){one, one, one, one, one, one, one, one}; }
#pragma unroll
                for (int dt = 0; dt < 4; ++dt)
#pragma unroll
                    for (int et = 0; et < 5; ++et) c[dt][et] = mfma16(af[dt], bfr[et], c[dt][et]);
            }
            const int slot = dir ? slot_b : slot_f;
            bf16_t* ct = CT + ((size_t)(slot / NCH) * 64 * NCH + (slot % NCH)) * 64;
#pragma unroll
            for (int dt = 0; dt < 4; ++dt) {
#pragma unroll
                for (int et = 0; et < 4; ++et) { const f32x4 v = c[dt][et]; u32x2 w; w.x = pk2(v[0], v[1]); w.y = pk2(v[2], v[3]); *(u32x2*)(ct + (size_t)(16 * et + r16) * (NCH * 64) + 16 * dt + 4 * g) = w; }
                if (r16 == 0) { const f32x4 v = c[dt][4]; u32x2 w; w.x = pk2(v[0], v[1]); w.y = pk2(v[2], v[3]); *(u32x2*)(nbuf + (size_t)slot * 64 + 16 * dt + 4 * g) = w; } }
            WAVE_LDS_FENCE();
        }
    }
}

DI void mlstm_scan_phase(const KParams& P0_, LAS unsigned char* lds, int bid, int G, int tid, bool wr_en = true) {
    KParams P = P0_; { __attribute__((address_space(1))) unsigned char* w1_ = (__attribute__((address_space(1))) unsigned char*)P.ws; asm volatile("" : "+s"(w1_)); P.ws = (unsigned char*)w1_; }
    bf16_t* CT = (bf16_t*)(P.ws + WS_CT); bf16_t* nbuf = (bf16_t*)(P.ws + WS_NB);
    const float* mloc = (const float*)(P.ws + WS_ML); const float* blast = (const float*)(P.ws + WS_BL); float* mprev = (float*)(P.ws + WS_MP);
    LAS float* sbl = (LAS float*)lds; LAS float* sml = sbl + 512; LAS float* sa = sml + 512; LAS float* scc = sa + 512;
    const int wave = tid >> 6, lane = tid & 63;
    { const int k = tid >> 7, st = tid & 127; const int sq = k < 3 ? ((bid * 8 + 2048 * k) >> 6) : (bid < NSEQ ? bid : 0); const int c = sq >= NSEQ / 2 ? (NCH - 1 - st) : st;
      sbl[tid] = blast[sq * NCH + c]; sml[tid] = mloc[sq * NCH + c]; }
    __syncthreads();
    if (tid < 4) { const int k = tid; const int sq = k < 3 ? ((bid * 8 + 2048 * k) >> 6) : (bid < NSEQ ? bid : 0); const bool dirb = sq >= NSEQ / 2;
        const bool wm = wr_en && k < 3 && ((bid * 8) & 63) == 0;
        float m = 0.f;
        for (int st = 0; st < NCH; ++st) { const float bl = sbl[k * 128 + st], ml = sml[k * 128 + st]; const float mn = fmaxf(bl + m, ml);
            sa[k * 128 + st] = fexp(bl + m - mn); scc[k * 128 + st] = fexp(ml - mn);
            if (wm) mprev[sq * NCH + (dirb ? (NCH - 1 - st) : st)] = m;
            m = mn; } }
    __syncthreads();
    bf16_t* ptr[4]; bool act[4]; bool dirb[4];
#pragma unroll
    for (int k = 0; k < 3; ++k) { const int row = bid * 8 + wave + 2048 * k; ptr[k] = CT + (size_t)row * (NCH * 64) + lane; act[k] = true; dirb[k] = (row >> 6) >= NSEQ / 2; }
    { ptr[3] = nbuf + (size_t)(bid < NSEQ ? bid : 0) * NCH * 64 + lane; act[3] = bid < NSEQ && wave == 0; dirb[3] = bid >= NSEQ / 2; }
    float C[4] = {0.f, 0.f, 0.f, 0.f};
    for (int st0 = 0; st0 < NCH; st0 += 8) {
        float cl[4][8];
#pragma unroll
        for (int k = 0; k < 4; ++k)
#pragma unroll
            for (int j = 0; j < 8; ++j) { const int c = dirb[k] ? (NCH - 1 - (st0 + j)) : (st0 + j); cl[k][j] = act[k] ? bf2f(ptr[k][c * 64]) : 0.f; }
#pragma unroll
        for (int k = 0; k < 4; ++k)
#pragma unroll
            for (int j = 0; j < 8; ++j) { const int c = dirb[k] ? (NCH - 1 - (st0 + j)) : (st0 + j);
                if (act[k] && wr_en) ptr[k][c * 64] = (bf16_t)(pk2(C[k], 0.f) & 0xffffu);
                C[k] = sa[k * 128 + st0 + j] * C[k] + scc[k * 128 + st0 + j] * cl[k][j]; }
    }
    __syncthreads();
}

DI void mlstm_out_phase(const KParams& P0_, LAS unsigned char* lds, int l, int pm, int wave, int lane) {
    KParams P = P0_; { __attribute__((address_space(1))) unsigned char* w1_ = (__attribute__((address_space(1))) unsigned char*)P.ws; asm volatile("" : "+s"(w1_)); P.ws = (unsigned char*)w1_; }

    bf16_t* Z = (bf16_t*)(P.ws + WS_Z);
    const float* gates = (const float*)(P.ws + WS_GATES);
    const bf16_t* qconv = (const bf16_t*)(P.ws + WS_QCONV); const bf16_t* kconv = (const bf16_t*)(P.ws + WS_KCONV);
    const bf16_t* CT = (const bf16_t*)(P.ws + WS_CT); const bf16_t* nbuf = (const bf16_t*)(P.ws + WS_NB);
    const float* mprev = (const float*)(P.ws + WS_MP);
    const float* gb = P.gate_bias + l * 24;
    const int r16 = lane & 15, g = lane >> 4, q4 = r16 >> 2, p4 = r16 & 3;
    LAS unsigned char* vbuf = lds + wave * (64 * VROW + 2048 + 256);
    LAS float* tab = (LAS float*)(vbuf + 64 * VROW);
    LAS unsigned char* ntab = vbuf + 64 * VROW + 2048;
    for (int um = wave; um < 24; um += 8) {
        asm volatile("" : "+v"(lane));
        const int cc = um / 6, h = um % 6;
        const int tc = pm * 256 + 64 * cc, b = tc / SEQ, s = tc % SEQ, ci = s >> 6;
        bf16_t* zb = Z + (size_t)b * SEQ * ZLD;
        const int slot_f = ((0 * NB + b) * 6 + h) * NCH + ci, slot_b = ((1 * NB + b) * 6 + h) * NCH + ci;
        {
            const float* G = gates + (size_t)(tc + lane) * 24;
            const float igf = G[h] + gb[h], fgf = G[6 + h] + gb[6 + h], igb = G[12 + h] + gb[12 + h], fgb = G[18 + h] + gb[18 + h];
            const float bfw = scan_add_up(logsig(fgf), lane), bbw = scan_add_down(logsig(fgb), lane);
            const float gf = igf - bfw, gbk = igb - bbw;
            const float pmf = scan_max_up(gf, lane), pmb = scan_max_down(gbk, lane);
            const float mpf = mprev[slot_f], mpb = mprev[slot_b];
            const float Mf = fmaxf(pmf, mpf), Mb = fmaxf(pmb, mpb);
            tab[0 * 64 + lane] = gf; tab[1 * 64 + lane] = gbk; tab[2 * 64 + lane] = Mf; tab[3 * 64 + lane] = Mb;
            tab[4 * 64 + lane] = fexp(mpf - Mf); tab[5 * 64 + lane] = fexp(mpb - Mb); tab[6 * 64 + lane] = fexp(-(bfw + Mf)); tab[7 * 64 + lane] = fexp(-(bbw + Mb));
        }
#pragma unroll
        for (int k = 0; k < 8; ++k) { const int id = lane + 64 * k, row = id >> 3, c16 = id & 7;
            *(LAS u32x4*)(vbuf + row * VROW + 16 * c16) = *(const u32x4*)(zb + (size_t)(s + row) * ZLD + VC + 64 * h + 8 * c16); }
        bf16x8 kfr[4][2];
#pragma unroll
        for (int st = 0; st < 4; ++st) { const bf16_t* kp = kconv + (size_t)(tc + 16 * st + r16) * 384 + 64 * h + 8 * g; kfr[st][0] = *(const bf16x8*)kp; kfr[st][1] = *(const bf16x8*)(kp + 32); }
        bf16x8 cfr[2][4][2];
#pragma unroll
        for (int dir = 0; dir < 2; ++dir) { const int slot = dir ? slot_b : slot_f; const bf16_t* ct = CT + ((size_t)(slot / NCH) * 64 * NCH + (slot % NCH)) * 64;
#pragma unroll
            for (int kp = 0; kp < 2; ++kp)
#pragma unroll
                for (int et = 0; et < 4; ++et) cfr[dir][et][kp] = *(const bf16x8*)(ct + (size_t)(16 * et + r16) * (NCH * 64) + 32 * kp + 8 * g); }
        if (lane < 16) { const int dirn = lane >> 3, c8 = lane & 7; *(LAS u32x4*)(ntab + dirn * 128 + c8 * 16) = *(const u32x4*)(nbuf + (size_t)(dirn ? slot_b : slot_f) * 64 + 8 * c8); }
        WAVE_LDS_FENCE();
        for (int tt = 0; tt < 4; ++tt) {
            const int tau = 16 * tt + r16;
            bf16x8 qfr[2];
            { const bf16_t* qp = qconv + (size_t)(tc + tau) * 384 + 64 * h + 8 * g; qfr[0] = *(const bf16x8*)qp; qfr[1] = *(const bf16x8*)(qp + 32); }
            f32x4 S[4];
#pragma unroll
            for (int st = 0; st < 4; ++st) { S[st] = (f32x4){0.f, 0.f, 0.f, 0.f}; S[st] = mfma16(kfr[st][0], qfr[0], S[st]); S[st] = mfma16(kfr[st][1], qfr[1], S[st]); }
            f32x4 hs[4];
#pragma unroll
            for (int et = 0; et < 4; ++et) hs[et] = zero4();
#pragma unroll
            for (int dir = 0; dir < 2; ++dir) {
                const float Mt = tab[(2 + dir) * 64 + tau], at = tab[(4 + dir) * 64 + tau], flt = tab[(6 + dir) * 64 + tau];
                bf16x8 pfr[2];
#pragma unroll
                for (int kp = 0; kp < 2; ++kp) { float pv[8];
#pragma unroll
                    for (int hf = 0; hf < 2; ++hf) { const int st = 2 * kp + hf; const f32x4 gs = *(const LAS f32x4*)(tab + dir * 64 + 16 * st + 4 * g);
#pragma unroll
                        for (int i = 0; i < 4; ++i) { const int sg = 16 * st + 4 * g + i; const bool ok = dir ? (sg >= tau) : (sg <= tau);
                            const float e = fexp(gs[i] - Mt) * S[st][i]; pv[4 * hf + i] = ok ? e : 0.f; } }
                    u32x4 pw; pw.x = pk2(pv[0], pv[1]); pw.y = pk2(pv[2], pv[3]); pw.z = pk2(pv[4], pv[5]); pw.w = pk2(pv[6], pv[7]); pfr[kp] = __builtin_bit_cast(bf16x8, pw); }
                f32x4 nd[5];
#pragma unroll
                for (int et = 0; et < 5; ++et) nd[et] = zero4();
#pragma unroll
                for (int kp = 0; kp < 2; ++kp) {
                    const u32x4 qw = __builtin_bit_cast(u32x4, qfr[kp]); u32x4 qs;
                    qs.x = pk2(bflo(qw.x) * at, bfhi(qw.x) * at); qs.y = pk2(bflo(qw.y) * at, bfhi(qw.y) * at); qs.z = pk2(bflo(qw.z) * at, bfhi(qw.z) * at); qs.w = pk2(bflo(qw.w) * at, bfhi(qw.w) * at);
                    const bf16x8 qsc = __builtin_bit_cast(bf16x8, qs);
#pragma unroll
                    for (int et = 0; et < 4; ++et) { const bf16x8 vf = cat8(trread(vbuf + (32 * kp + 4 * g + q4) * VROW + 32 * et + 8 * p4), trread(vbuf + (32 * kp + 16 + 4 * g + q4) * VROW + 32 * et + 8 * p4));
                        nd[et] = mfma16(vf, pfr[kp], nd[et]); nd[et] = mfma16(cfr[dir][et][kp], qsc, nd[et]); }
                    { const short one = r16 == 0 ? (short)0x3F80 : (short)0; const bf16x8 of = {one, one, one, one, one, one, one, one}; nd[4] = mfma16(of, pfr[kp], nd[4]); }
                    { bf16x8 nf = {0, 0, 0, 0, 0, 0, 0, 0}; if (r16 == 0) nf = *(const LAS bf16x8*)(ntab + dir * 128 + 64 * kp + 16 * g); nd[4] = mfma16(nf, qsc, nd[4]); }
                }
                const float den = shi(nd[4][0], r16);
                const float inv = 1.f / fmaxf(fabsf(den), flt);
#pragma unroll
                for (int et = 0; et < 4; ++et) hs[et] += nd[et] * inv;
            }
            float ss = 0.f;
#pragma unroll
            for (int et = 0; et < 4; ++et) ss += (hs[et][0] * hs[et][0] + hs[et][1] * hs[et][1]) + (hs[et][2] * hs[et][2] + hs[et][3] * hs[et][3]);
            ss += shx(ss, 16, lane); ss += shx(ss, 32, lane);
            const float rn = 1.f / sqrtf(ss * (1.f / 64.f) + EPS);
            bf16_t* zr = zb + (size_t)(s + tau) * ZLD;
#pragma unroll
            for (int et = 0; et < 4; ++et) { const int e0 = 64 * h + 16 * et + 4 * g;
                const u32x2 ov = *(const u32x2*)(zr + OC + e0); const f32x4 ng = *(const f32x4*)(P.mlstm_norm + l * 384 + e0);
                const float y0 = hs[et][0] * rn * ng[0] * sigmoidf_(bflo(ov.x)), y1 = hs[et][1] * rn * ng[1] * sigmoidf_(bfhi(ov.x));
                const float y2 = hs[et][2] * rn * ng[2] * sigmoidf_(bflo(ov.y)), y3 = hs[et][3] * rn * ng[3] * sigmoidf_(bfhi(ov.y));
                u32x2 w; w.x = pk2(y0, y1); w.y = pk2(y2, y3); *(u32x2*)(zr + QC + e0) = w; }
        }
        WAVE_LDS_FENCE();
    }
}

#ifndef PROBE_MODE
#define PROBE_MODE 0
#endif
#ifndef SKIP_ATTN
#define SKIP_ATTN 0
#endif
#ifndef SKIP_MLSTM
#define SKIP_MLSTM 0
#endif

__global__ void __launch_bounds__(512, 2) fwd_kernel(KParams P) {
    extern __shared__ __attribute__((aligned(16))) unsigned char lds_raw[];
    LAS unsigned char* lds = (LAS unsigned char*)lds_raw;
    cg::grid_group grid = cg::this_grid();
#if PROBE_MODE == 4
#define GSYNC() do { grid.sync(); grid.sync(); } while (0)
#else
#define GSYNC() grid.sync()
#endif
    const int G = gridDim.x, bx = blockIdx.x;
    if (G != 256) return;
    const int pm0 = (bx & 7) * 32 + (bx >> 3);
#define FRESH_IDS int tid = threadIdx.x; asm volatile("" : "+v"(tid)); const int lane = tid & 63, wave = __builtin_amdgcn_readfirstlane(tid >> 6); int pm = pm0; asm volatile("" : "+s"(pm)); (void)lane; (void)wave; (void)pm;
#define WSP() ({ __attribute__((address_space(1))) unsigned char* w_ = (__attribute__((address_space(1))) unsigned char*)P.ws; asm volatile("" : "+s"(w_)); (unsigned char*)w_; })
#define Wall ((bf16_t*)(WSP() + WS_W))
#define PB ((bf16_t*)(WSP() + WS_PB))
#define gates ((float*)(WSP() + WS_GATES))
#define rs ((float*)(WSP() + WS_RS))
#define XBA ((bf16_t*)(WSP() + WS_XBA))
#define XBB ((bf16_t*)(WSP() + WS_XBB))
#define Z ((bf16_t*)(WSP() + WS_Z))
    LAS float* ssq = (LAS float*)(lds + SSQ_OFF);
#define ZERO_SSQ() do { FRESH_IDS; if (tid < 256) { *(LAS f32x4*)(ssq + tid * 4) = zero4(); } } while (0)
#define WRITE_RS() do { FRESH_IDS; if (tid < 256) { const float s_ = (ssq[tid * 4] + ssq[tid * 4 + 1]) + (ssq[tid * 4 + 2] + ssq[tid * 4 + 3]); rs[pm * 256 + tid] = 1.f / sqrtf(s_ * (1.f / DM) + EPS); } } while (0)

#if PROBE_MODE == 3
    { FRESH_IDS;
      prep_weights(P, lds, bx * 8 + wave, G * 8, wave, lane);
      for (int rr = wave; rr < 256; rr += 8) { const size_t row = (size_t)pm * 256 + rr;
        const f32x4* xr = (const f32x4*)(P.x + row * DM) + lane; f32x4 v[4]; float s = 0.f;
#pragma unroll
        for (int j = 0; j < 4; ++j) { v[j] = xr[64 * j]; s += (v[j][0] * v[j][0] + v[j][1] * v[j][1]) + (v[j][2] * v[j][2] + v[j][3] * v[j][3]); }
        s = wave_sum(s, lane);
        u32x2* o = (u32x2*)(XBA + row * DM) + lane;
#pragma unroll
        for (int j = 0; j < 4; ++j) { u32x2 w; w.x = pk2(v[j][0], v[j][1]); w.y = pk2(v[j][2], v[j][3]); o[64 * j] = w; }
        if (lane == 0) rs[row] = 1.f / sqrtf(s * (1.f / DM) + EPS); } }
    __syncthreads();
#endif
    { FRESH_IDS;
      prep_weights(P, lds, bx * 8 + wave, G * 8, wave, lane);
      for (int rr = wave; rr < 256; rr += 8) { const size_t row = (size_t)pm * 256 + rr;
        const f32x4* xr = (const f32x4*)(P.x + row * DM) + lane; f32x4 v[4]; float s = 0.f;
#pragma unroll
        for (int j = 0; j < 4; ++j) { v[j] = xr[64 * j]; s += (v[j][0] * v[j][0] + v[j][1] * v[j][1]) + (v[j][2] * v[j][2] + v[j][3] * v[j][3]); }
        s = wave_sum(s, lane);
        u32x2* o = (u32x2*)(XBA + row * DM) + lane;
#pragma unroll
        for (int j = 0; j < 4; ++j) { u32x2 w; w.x = pk2(v[j][0], v[j][1]); w.y = pk2(v[j][2], v[j][3]); o[64 * j] = w; }
        if (lane == 0) rs[row] = 1.f / sqrtf(s * (1.f / DM) + EPS); } }
    GSYNC();

    for (int l = 0; l < DEPTH; ++l) {
        bf16_t* Wl = Wall + (size_t)l * LAYER_W;
        { pg8::Gemm g{XBA, Wl + OFF_WIN, DM, DM}; pg8::RowOrder S{pm0, NIN_PAD / 256}; pg8::EpiZ E{Z, gates, rs};
          pg8::gemm_phase<pg8::EpiZ, pg8::RowOrder>(lds, g, S, E);
#if PROBE_MODE == 2
          pg8::gemm_phase<pg8::EpiZ, pg8::RowOrder>(lds, g, S, E);
#endif
          }
        GSYNC();
#if PROBE_MODE == 1 || PROBE_MODE == 6
        { FRESH_IDS; build_lut(P, lds, tid); __syncthreads(); attention_phase(P, lds, l, pm, wave, lane, P.out == nullptr); __syncthreads(); }
#endif
#if PROBE_MODE == 1 || PROBE_MODE == 7
        { FRESH_IDS; mlstm_state_phase(P, lds, l, pm, wave, lane); __syncthreads(); }
#endif
        if (!SKIP_ATTN) { FRESH_IDS;
            build_lut(P, lds, tid);
            __syncthreads();
            attention_phase(P, lds, l, pm, wave, lane);
        }
        __syncthreads();
        if (!SKIP_MLSTM) { FRESH_IDS; mlstm_state_phase(P, lds, l, pm, wave, lane); }
        GSYNC();
#if PROBE_MODE == 1 || PROBE_MODE == 8
        { FRESH_IDS; mlstm_scan_phase(P, lds, bx, G, tid, P.out == nullptr); }
#endif
        if (!SKIP_MLSTM) { FRESH_IDS; mlstm_scan_phase(P, lds, bx, G, tid); }
        GSYNC();
#if PROBE_MODE == 1 || PROBE_MODE == 9
        { FRESH_IDS; mlstm_out_phase(P, lds, l, pm, wave, lane); __syncthreads(); }
#endif
        if (!SKIP_MLSTM) { FRESH_IDS; mlstm_out_phase(P, lds, l, pm, wave, lane); }
        ZERO_SSQ();
        LOCAL_SEAM();
#if PROBE_MODE == 5
        { pg8::Gemm g{Z, Wl + OFF_WOUT, ZLD, DM}; pg8::RowOrder S{pm0, 4}; pg8::EpiResid<false> E{XBA, XBA, nullptr, ssq, (P.out == nullptr)};
          pg8::gemm_phase<pg8::EpiResid<false>, pg8::RowOrder>(lds, g, S, E); }
        __syncthreads();
#endif
        { pg8::Gemm g{Z, Wl + OFF_WOUT, ZLD, DM}; pg8::RowOrder S{pm0, 4}; pg8::EpiResid<false> E{XBA, XBA, nullptr, ssq, true};
          pg8::gemm_phase<pg8::EpiResid<false>, pg8::RowOrder>(lds, g, S, E); }
        __syncthreads();
        WRITE_RS();
        LOCAL_SEAM();
        { pg8::Gemm g{XBA, Wl + OFF_WUP, DM, DM}; pg8::RowOrder S{pm0, NUP / 256}; pg8::EpiSwiGLU E{Z, rs};
          pg8::gemm_phase<pg8::EpiSwiGLU, pg8::RowOrder>(lds, g, S, E);
#if PROBE_MODE == 2
          pg8::gemm_phase<pg8::EpiSwiGLU, pg8::RowOrder>(lds, g, S, E);
#endif
          }
        ZERO_SSQ();
        LOCAL_SEAM();
#if PROBE_MODE == 5
        { pg8::Gemm g{Z + ACT_OFF, Wl + OFF_WDOWN, ZLD, DFF}; pg8::RowOrder S{pm0, 4}; pg8::EpiResid<false> E{XBA, XBB, nullptr, ssq, (P.out == nullptr)};
          pg8::gemm_phase<pg8::EpiResid<false>, pg8::RowOrder>(lds, g, S, E); }
        __syncthreads();
#endif
        { pg8::Gemm g{Z + ACT_OFF, Wl + OFF_WDOWN, ZLD, DFF}; pg8::RowOrder S{pm0, 4}; pg8::EpiResid<false> E{XBA, XBB, nullptr, ssq, true};
          pg8::gemm_phase<pg8::EpiResid<false>, pg8::RowOrder>(lds, g, S, E); }
        { FRESH_IDS;
          for (int rr = wave; rr < 256; rr += 8) { const size_t row = (size_t)pm * 256 + rr;
            const f32x4 v = *((const f32x4*)(P.p + ((size_t)l * MTOK + row) * PLE) + lane); u32x2 w; w.x = pk2(v[0], v[1]); w.y = pk2(v[2], v[3]); *((u32x2*)(PB + row * PLE) + lane) = w; } }
        LOCAL_SEAM();
        { pg8::Gemm g{XBB, Wl + OFF_WG, DM, DM}; pg8::RowOrder S{pm0, 4}; pg8::EpiSigmoid E{Z};
          pg8::gemm_phase<pg8::EpiSigmoid, pg8::RowOrder>(lds, g, S, E);
#if PROBE_MODE == 2
          pg8::gemm_phase<pg8::EpiSigmoid, pg8::RowOrder>(lds, g, S, E);
#endif
          }
        ZERO_SSQ();
        LOCAL_SEAM();
#if PROBE_MODE == 5
        { pg8::Gemm g{PB, Wl + OFF_WP, PLE, PLE}; pg8::RowOrder S{pm0, 4}; pg8::EpiResid<true> E{XBB, XBA, Z, ssq, (P.out == nullptr)};
          pg8::gemm_phase<pg8::EpiResid<true>, pg8::RowOrder>(lds, g, S, E); }
        __syncthreads();
#endif
        { pg8::Gemm g{PB, Wl + OFF_WP, PLE, PLE}; pg8::RowOrder S{pm0, 4}; pg8::EpiResid<true> E{XBB, XBA, Z, ssq, true};
          pg8::gemm_phase<pg8::EpiResid<true>, pg8::RowOrder>(lds, g, S, E); }
        __syncthreads();
        WRITE_RS();
        LOCAL_SEAM();
    }
    { FRESH_IDS;
      for (int rr = wave; rr < 256; rr += 8) { const size_t row = (size_t)pm * 256 + rr; const float sc = rs[row];
        const u32x2* xr = (const u32x2*)(XBA + row * DM) + lane; f32x4* orow = (f32x4*)(P.out + row * DM) + lane; const f32x4* gr = (const f32x4*)P.final_norm + lane;
#pragma unroll
        for (int j = 0; j < 4; ++j) { const u32x2 v = xr[64 * j]; const f32x4 gg = gr[64 * j]; orow[64 * j] = (f32x4){bflo(v.x) * sc * gg[0], bfhi(v.x) * sc * gg[1], bflo(v.y) * sc * gg[2], bfhi(v.y) * sc * gg[3]}; } } }
}

extern "C" void kernel_launch(void* const* d_in, const int* in_sizes, int n_in, void* d_out, int out_size, void* d_ws, size_t ws_size, hipStream_t stream) {
    static int ready = 0;
    if (ready == 0) {
        if (n_in != 16 || out_size != MTOK * DM || ws_size < WS_END) { fprintf(stderr, "kernel_launch: unexpected sizes (n_in %d, out %d, ws %zu)\n", n_in, out_size, ws_size); ready = -1; return; }
        if (hipFuncSetAttribute((const void*)fwd_kernel, hipFuncAttributeMaxDynamicSharedMemorySize, LDS_BYTES) != hipSuccess) { fprintf(stderr, "kernel_launch: hipFuncSetAttribute failed\n"); ready = -1; return; }
        int dev = 0, cus = 0, per_cu = 0;
        (void)hipGetDevice(&dev); (void)hipDeviceGetAttribute(&cus, hipDeviceAttributeMultiprocessorCount, dev);
        (void)hipOccupancyMaxActiveBlocksPerMultiprocessor(&per_cu, (const void*)fwd_kernel, 512, LDS_BYTES);
        if (cus != 256 || per_cu < 1) fprintf(stderr, "kernel_launch: note: %d CUs, %d blocks/CU (kernel expects 256 x 1)\n", cus, per_cu);
        (void)hipGetLastError();
        ready = 1;
    }
    if (ready < 0) return;
    KParams P{};
    P.x = (const float*)d_in[0]; P.p = (const float*)d_in[1]; P.rel_bias = (const float*)d_in[2]; P.attn_norm = (const float*)d_in[3]; P.w_in = (const float*)d_in[4];
    P.qk_conv = (const float*)d_in[5]; P.gate_bias = (const float*)d_in[6]; P.sink = (const float*)d_in[7]; P.mlstm_norm = (const float*)d_in[8]; P.w_out = (const float*)d_in[9];
    P.ffn_norm = (const float*)d_in[10]; P.w_up = (const float*)d_in[11]; P.w_down = (const float*)d_in[12]; P.ple_proj = (const float*)d_in[13]; P.ple_gate = (const float*)d_in[14];
    P.final_norm = (const float*)d_in[15]; P.out = (float*)d_out; P.ws = (unsigned char*)d_ws;
    void* args[] = {&P};
    hipError_t e = hipLaunchCooperativeKernel((const void*)fwd_kernel, dim3(256), dim3(512), args, LDS_BYTES, stream);
    if (e != hipSuccess) fprintf(stderr, "kernel_launch: cooperative launch failed: %s\n", hipGetErrorString(e));
}
```

```cpp
#include <hip/hip_runtime.h>
#include <hip/hip_cooperative_groups.h>
#include <cstdio>
#include <cstdint>
namespace cg = cooperative_groups;

#define LAS __attribute__((address_space(3)))
#define DI __device__ __forceinline__
typedef unsigned short bf16_t;
typedef short bf16x8 __attribute__((ext_vector_type(8)));
typedef short s16x4 __attribute__((ext_vector_type(4)));
typedef float f32x4 __attribute__((ext_vector_type(4)));
typedef float f32x2 __attribute__((ext_vector_type(2)));
typedef unsigned u32x4 __attribute__((ext_vector_type(4)));
typedef unsigned u32x2 __attribute__((ext_vector_type(2)));
typedef __bf16 bf16v2 __attribute__((ext_vector_type(2)));

constexpr int NB = 8, SEQ = 8192, DM = 1024, DEPTH = 4, MTOK = NB * SEQ;
constexpr int ZLD = 3200, NIN_PAD = 3328, DFF = 2816, NUP = 2 * DFF, PLE = 256, DIN = 3224;
constexpr int QA = 0, QB = 384, QC = 640, KA = 1024, KB = 1408, KC = 1536, VA = 1920, VB = 2304, VC = 2432, OC = 2816;
constexpr int ACT_OFF = 384;
constexpr float LOG2E = 1.4426950408889634f;
constexpr float QSCALE = 0.125f * LOG2E;
constexpr float EPS = 1e-6f;
constexpr float NEGBIG = -1e30f;
constexpr int NSEQ = 2 * NB * 6, NCH = SEQ / 64;

constexpr size_t OFF_WIN = 0, OFF_WOUT = OFF_WIN + (size_t)NIN_PAD * DM, OFF_WUP = OFF_WOUT + (size_t)DM * DM, OFF_WDOWN = OFF_WUP + (size_t)NUP * DM,
                 OFF_WP = OFF_WDOWN + (size_t)DM * DFF, OFF_WG = OFF_WP + (size_t)DM * PLE, LAYER_W = OFF_WG + (size_t)DM * DM;
constexpr size_t MiB = 1u << 20;
constexpr size_t WS_W = 1 * MiB, WS_PB = 112 * MiB, WS_GATES = 144 * MiB, WS_RS = 150 * MiB, WS_NB = 151 * MiB, WS_ML = 153 * MiB, WS_BL = WS_ML + 256 * 1024,
                 WS_MP = WS_ML + 512 * 1024, WS_QCONV = 154 * MiB, WS_KCONV = 202 * MiB, WS_XBA = 250 * MiB, WS_XBB = 378 * MiB, WS_Z = 506 * MiB, WS_CT = 906 * MiB,
                 WS_END = 1002 * MiB;
static_assert(WS_W + 4 * LAYER_W * 2 <= WS_PB, "weights");
static_assert(WS_Z + (size_t)MTOK * ZLD * 2 <= WS_CT, "z");
static_assert(WS_CT + (size_t)NSEQ * NCH * 4096 * 2 <= WS_END, "ct");

constexpr int LDS_BYTES = 155648;
constexpr int RING_BYTES = 131072, SSQ_OFF = 131072;

DI unsigned pk2(float lo, float hi) { f32x2 v = {lo, hi}; bf16v2 b = __builtin_convertvector(v, bf16v2); return __builtin_bit_cast(unsigned, b); }
DI float bf2f(unsigned short u) { return __uint_as_float(((unsigned)u) << 16); }
DI float bflo(unsigned u) { return __uint_as_float(u << 16); }
DI float bfhi(unsigned u) { return __uint_as_float(u & 0xffff0000u); }
DI float ex2(float x) { return __builtin_amdgcn_exp2f(x); }
DI float fexp(float x) { return __builtin_amdgcn_exp2f(x * LOG2E); }
DI float frcp(float x) { return __builtin_amdgcn_rcpf(x); }
DI float sigmoidf_(float x) { return frcp(1.f + fexp(-x)); }
DI f32x4 mfma16(bf16x8 a, bf16x8 b, f32x4 c) { return __builtin_amdgcn_mfma_f32_16x16x32_bf16(a, b, c, 0, 0, 0); }
DI f32x4 zero4() { float z; asm volatile("v_mov_b32 %0, 0" : "=v"(z)); return (f32x4){z, z, z, z}; }
DI s16x4 trread(LAS unsigned char* p) { return __builtin_amdgcn_ds_read_tr16_b64_v4i16((LAS s16x4*)p); }
DI bf16x8 cat8(s16x4 a, s16x4 b) { return __builtin_shufflevector(a, b, 0, 1, 2, 3, 4, 5, 6, 7); }
DI float shx(float v, int mask, int lane) { return __builtin_bit_cast(float, __builtin_amdgcn_ds_bpermute((lane ^ mask) << 2, __builtin_bit_cast(int, v))); }
DI float shi(float v, int idx) { return __builtin_bit_cast(float, __builtin_amdgcn_ds_bpermute(idx << 2, __builtin_bit_cast(int, v))); }
#define WAVE_LDS_FENCE() asm volatile("s_waitcnt lgkmcnt(0)" ::: "memory")
#define LOCAL_SEAM() do { asm volatile("s_waitcnt vmcnt(0) lgkmcnt(0)" ::: "memory"); __syncthreads(); __builtin_amdgcn_fence(__ATOMIC_ACQUIRE, "workgroup"); } while (0)

namespace pg8 {
constexpr int BM = 256, BK = 64, HALF = 128, HTB = HALF * BK * 2, STAGE_BYTES = 8 * HTB;
DI int lds_byte(int r, int c) { const int st = (r >> 4) * 2 + (c >> 5), rr = r & 15, cc = c & 31, ob = rr * 64 + cc * 2; return st * 1024 + (ob ^ (((ob >> 9) & 1) << 5)); }
DI void stage_rc(int b, int& R, int& C) { const int st = b / 1024, sb = b % 1024, swz = sb ^ (((sb >> 9) & 1) << 5); R = (st >> 1) * 16 + swz / 64; C = (st & 1) * 32 + (swz % 64) / 2; }
DI int perm32(int rho) { const int n = rho >> 4, i = rho & 15; return 8 * (i >> 2) + 4 * n + (i & 3); }
struct Unit { int pm, pn; };
struct Gemm { const bf16_t* A; const bf16_t* Bt; int lda, K; };
struct RowOrder {
    int pm, nN;
    DI bool next(int i, Unit& u) const { if (i >= nN) return false; u.pm = pm; u.pn = i; return true; }
};

template <class Epi, class Sched>
DI void gemm_phase(LAS unsigned char* lds, const Gemm g, const Sched& S, const Epi& E) {
    int tid = threadIdx.x; asm volatile("" : "+v"(tid));
    const int wid = __builtin_amdgcn_readfirstlane(tid >> 6), lane = tid & 63, wr = wid >> 2, wc = wid & 3, fr = lane & 15, fq = lane >> 4;
    const int K = g.K, nt = K / BK, lda = g.lda;
    unsigned voffA[2], voffB[2];
#pragma unroll
    for (int i = 0; i < 2; ++i) { int R, C; stage_rc(tid * 16 + i * 8192, R, C); const int Rb = Epi::PERM ? ((R & ~31) + perm32(R & 31)) : R;
        voffA[i] = (unsigned)(R * lda + C) * 2u; voffB[i] = (unsigned)(Rb * K + C) * 2u; }
    const size_t kstep = (size_t)(BK * 2);
    const size_t hsA = (size_t)HALF * lda * 2, hsB = (size_t)HALF * K * 2;
    const size_t tsA = 2 * hsA, tsB = 2 * hsB;
    const unsigned ldsw = (unsigned)wid * 1024u;
    const int aoff = lds_byte(wr * 64 + fr, fq * 8), boff = lds_byte(wc * 32 + fr, fq * 8);
#define PG8_SA(b, h) (((b) * 2 + (h)) * HTB)
#define PG8_SB(b, h) ((4 + (b) * 2 + (h)) * HTB)
#define PG8_STAGE(bufoff, gbase, voff) do { _Pragma("unroll") for (int _i = 0; _i < 2; ++_i) \
        __builtin_amdgcn_global_load_lds((const unsigned*)((const char*)(gbase) + (voff)[_i]), (LAS unsigned*)(lds + (bufoff) + ldsw + _i * 8192), 16, 0, 0); } while (0)
#define PG8_LDA(dst, b, h) do { _Pragma("unroll") for (int m = 0; m < 4; ++m) _Pragma("unroll") for (int k = 0; k < 2; ++k) dst[m][k] = *(const LAS bf16x8*)(lds + PG8_SA(b, h) + aoff + m * 2048 + k * 1024); } while (0)
#define PG8_LDB(dst, b, h) do { _Pragma("unroll") for (int n = 0; n < 2; ++n) _Pragma("unroll") for (int k = 0; k < 2; ++k) dst[n][k] = *(const LAS bf16x8*)(lds + PG8_SB(b, h) + boff + n * 2048 + k * 1024); } while (0)
#define PG8_MMA(ai, bj, At, Bt) do { __builtin_amdgcn_s_setprio(1); _Pragma("unroll") for (int m = 0; m < 4; ++m) _Pragma("unroll") for (int n = 0; n < 2; ++n) _Pragma("unroll") for (int k = 0; k < 2; ++k) \
        acc[ai][bj][m][n] = __builtin_amdgcn_mfma_f32_16x16x32_bf16(Bt[n][k], At[m][k], acc[ai][bj][m][n], 0, 0, 0); __builtin_amdgcn_s_setprio(0); } while (0)
#define PG8_WAIT_V(n) asm volatile("s_waitcnt vmcnt(" #n ")" ::: "memory")
#define PG8_WAIT_L(n) asm volatile("s_waitcnt lgkmcnt(" #n ")" ::: "memory")
#define PG8_BAR __builtin_amdgcn_s_barrier()
#define PG8_SCHED __builtin_amdgcn_sched_barrier(0)
    Unit cur, nxt; int ui = 0;
    if (!S.next(0, cur)) return;
    f32x4 acc[2][2][4][2];
    { float z0; asm volatile("v_mov_b32 %0, 0" : "=v"(z0));
#pragma unroll
    for (int a = 0; a < 2; ++a)
#pragma unroll
        for (int b = 0; b < 2; ++b)
#pragma unroll
            for (int m = 0; m < 4; ++m)
#pragma unroll
                for (int n = 0; n < 2; ++n) acc[a][b][m][n] = (f32x4){z0, z0, z0, z0}; }
    bf16x8 At[4][2], B0[2][2], B1[2][2];
    const char* cA = (const char*)g.A + (size_t)cur.pm * tsA; const char* cB = (const char*)g.Bt + (size_t)cur.pn * tsB;
    PG8_STAGE(PG8_SB(0, 0), cB, voffB); PG8_STAGE(PG8_SB(0, 1), cB + hsB, voffB); PG8_STAGE(PG8_SA(0, 0), cA, voffA); PG8_STAGE(PG8_SA(0, 1), cA + hsA, voffA);
    if (wr == 1) PG8_BAR;
    PG8_WAIT_V(2); PG8_BAR;
    PG8_STAGE(PG8_SB(1, 0), cB + kstep, voffB); PG8_STAGE(PG8_SA(1, 0), cA + kstep, voffA); PG8_STAGE(PG8_SB(1, 1), cB + hsB + kstep, voffB);
    PG8_WAIT_V(6); PG8_BAR;
    for (;;) {
        const bool has_next = S.next(ui + 1, nxt);
        const char* nA = has_next ? (const char*)g.A + (size_t)nxt.pm * tsA : cA; const char* nB = has_next ? (const char*)g.Bt + (size_t)nxt.pn * tsB : cB;
        for (int t = 0; t < nt; t += 2) {
            const bool last = (t == nt - 2);
            const char* a1 = cA + (size_t)(t + 1) * kstep;
            const char* a2 = last ? nA : cA + (size_t)(t + 2) * kstep; const char* b2 = last ? nB : cB + (size_t)(t + 2) * kstep;
            const char* a3 = a2 + kstep; const char* b3 = b2 + kstep;
            PG8_LDB(B0, 0, 0); PG8_LDB(B1, 0, 1); PG8_SCHED; PG8_LDA(At, 0, 0); PG8_STAGE(PG8_SA(1, 1), a1 + hsA, voffA);
            PG8_WAIT_V(8); PG8_WAIT_L(0); PG8_BAR; PG8_MMA(0, 0, At, B0); PG8_MMA(0, 1, At, B1); PG8_BAR; PG8_SCHED;
            PG8_LDA(At, 0, 1); PG8_STAGE(PG8_SB(0, 0), b2, voffB); PG8_STAGE(PG8_SB(0, 1), b2 + hsB, voffB); PG8_STAGE(PG8_SA(0, 0), a2, voffA);
            PG8_WAIT_V(8); PG8_WAIT_L(0); PG8_BAR; PG8_MMA(1, 0, At, B0); PG8_MMA(1, 1, At, B1); PG8_BAR; PG8_SCHED;
            PG8_LDB(B0, 1, 0); PG8_LDB(B1, 1, 1); PG8_SCHED; PG8_LDA(At, 1, 0); PG8_STAGE(PG8_SA(0, 1), a2 + hsA, voffA);
            PG8_WAIT_V(8); PG8_WAIT_L(0); PG8_BAR; PG8_MMA(0, 0, At, B0); PG8_MMA(0, 1, At, B1); PG8_BAR; PG8_SCHED;
            PG8_LDA(At, 1, 1); PG8_STAGE(PG8_SB(1, 0), b3, voffB); PG8_STAGE(PG8_SB(1, 1), b3 + hsB, voffB); PG8_STAGE(PG8_SA(1, 0), a3, voffA);
            PG8_WAIT_V(8); PG8_WAIT_L(0); PG8_BAR; PG8_MMA(1, 0, At, B0); PG8_MMA(1, 1, At, B1); PG8_BAR; PG8_SCHED;
        }
        if (wr == 0) PG8_BAR;
        E(acc, cur, wr, wc, fr, fq);
        if (!has_next) break;
        { float z0; asm volatile("v_mov_b32 %0, 0" : "=v"(z0));
#pragma unroll
        for (int a = 0; a < 2; ++a)
#pragma unroll
            for (int b = 0; b < 2; ++b)
#pragma unroll
                for (int m = 0; m < 4; ++m)
#pragma unroll
                    for (int n = 0; n < 2; ++n) acc[a][b][m][n] = (f32x4){z0, z0, z0, z0}; }
        cur = nxt; cA = nA; cB = nB; ++ui;
        if (wr == 1) PG8_BAR;
    }
    PG8_WAIT_V(0);
    PG8_BAR;
#undef PG8_SA
#undef PG8_SB
#undef PG8_STAGE
#undef PG8_LDA
#undef PG8_LDB
#undef PG8_MMA
#undef PG8_WAIT_V
#undef PG8_WAIT_L
#undef PG8_BAR
#undef PG8_SCHED
}

struct EpiZ {
    static constexpr bool PERM = true;
    bf16_t* Z; float* gates; const float* rs;
    DI void operator()(const f32x4 (&acc)[2][2][4][2], const Unit& u, int wr, int wc, int fr, int fq) const {
        asm volatile("" : "+v"(fr), "+v"(fq));
        const int row0 = u.pm * BM + wr * 64 + fr, col0 = u.pn * BM + wc * 32 + 8 * fq;
#pragma unroll
        for (int ai = 0; ai < 2; ++ai)
#pragma unroll
            for (int m = 0; m < 4; ++m) { const int row = row0 + ai * HALF + m * 16; const float sc = rs[row];
#pragma unroll
                for (int bj = 0; bj < 2; ++bj) { const int col = col0 + bj * HALF; const f32x4 v0 = acc[ai][bj][m][0] * sc, v1 = acc[ai][bj][m][1] * sc;
                    if (col < ZLD) { u32x4 w; w.x = pk2(v0[0], v0[1]); w.y = pk2(v0[2], v0[3]); w.z = pk2(v1[0], v1[1]); w.w = pk2(v1[2], v1[3]); *(u32x4*)(Z + (size_t)row * ZLD + col) = w; }
                    else if (col < DIN) { float* gp = gates + (size_t)row * 24 + (col - ZLD); *(f32x4*)gp = v0; *(f32x4*)(gp + 4) = v1; } }
                asm volatile("" ::: "memory"); }
    }
};
struct EpiSwiGLU {
    static constexpr bool PERM = true;
    bf16_t* Z; const float* rs;
    DI void operator()(const f32x4 (&acc)[2][2][4][2], const Unit& u, int wr, int wc, int fr, int fq) const {
        asm volatile("" : "+v"(fr), "+v"(fq));
        const int row0 = u.pm * BM + wr * 64 + fr, col0 = ACT_OFF + u.pn * HALF + wc * 32 + 8 * fq;
#pragma unroll
        for (int ai = 0; ai < 2; ++ai)
#pragma unroll
            for (int m = 0; m < 4; ++m) { const int row = row0 + ai * HALF + m * 16; const float sc = rs[row]; float o[8];
#pragma unroll
                for (int n = 0; n < 2; ++n)
#pragma unroll
                    for (int i = 0; i < 4; ++i) { const float gg = acc[ai][0][m][n][i] * sc, uu = acc[ai][1][m][n][i] * sc; o[4 * n + i] = gg * sigmoidf_(gg) * uu; }
                u32x4 w; w.x = pk2(o[0], o[1]); w.y = pk2(o[2], o[3]); w.z = pk2(o[4], o[5]); w.w = pk2(o[6], o[7]);
                *(u32x4*)(Z + (size_t)row * ZLD + col0) = w;
                asm volatile("" ::: "memory"); }
    }
};
struct EpiSigmoid {
    static constexpr bool PERM = true;
    bf16_t* Z;
    DI void operator()(const f32x4 (&acc)[2][2][4][2], const Unit& u, int wr, int wc, int fr, int fq) const {
        asm volatile("" : "+v"(fr), "+v"(fq));
        const int row0 = u.pm * BM + wr * 64 + fr, col0 = u.pn * BM + wc * 32 + 8 * fq;
#pragma unroll
        for (int ai = 0; ai < 2; ++ai)
#pragma unroll
            for (int m = 0; m < 4; ++m) { const int row = row0 + ai * HALF + m * 16;
#pragma unroll
                for (int bj = 0; bj < 2; ++bj) { const f32x4 v0 = acc[ai][bj][m][0], v1 = acc[ai][bj][m][1]; u32x4 w;
                    w.x = pk2(sigmoidf_(v0[0]), sigmoidf_(v0[1])); w.y = pk2(sigmoidf_(v0[2]), sigmoidf_(v0[3])); w.z = pk2(sigmoidf_(v1[0]), sigmoidf_(v1[1])); w.w = pk2(sigmoidf_(v1[2]), sigmoidf_(v1[3]));
                    *(u32x4*)(Z + (size_t)row * ZLD + col0 + bj * HALF) = w; }
                asm volatile("" ::: "memory"); }
    }
};
template <bool MUL> struct EpiResid {
    static constexpr bool PERM = false;
    const bf16_t* resid; bf16_t* xb; const bf16_t* mul; LAS float* ssq; bool wr_en;
    DI void operator()(const f32x4 (&acc)[2][2][4][2], const Unit& u, int wr, int wc, int fr, int fq) const {
        asm volatile("" : "+v"(fr), "+v"(fq));
        const int col0 = u.pn * BM + wc * 32 + 4 * fq;
#pragma unroll
        for (int ai = 0; ai < 2; ++ai)
#pragma unroll
            for (int m = 0; m < 4; ++m) { const int rl = ai * HALF + wr * 64 + m * 16 + fr; const size_t row = (size_t)(u.pm * BM + rl); float s = 0.f;
#pragma unroll
                for (int bj = 0; bj < 2; ++bj)
#pragma unroll
                    for (int n = 0; n < 2; ++n) { const int col = col0 + bj * HALF + n * 16; f32x4 a = acc[ai][bj][m][n];
                        if (MUL) { const u32x2 mv = *(const u32x2*)(mul + row * ZLD + col); a[0] *= bflo(mv.x); a[1] *= bfhi(mv.x); a[2] *= bflo(mv.y); a[3] *= bfhi(mv.y); }
                        const u32x2 rv = *(const u32x2*)(resid + row * DM + col);
                        const f32x4 x = {bflo(rv.x) + a[0], bfhi(rv.x) + a[1], bflo(rv.y) + a[2], bfhi(rv.y) + a[3]};
                        if (wr_en) { u32x2 w; w.x = pk2(x[0], x[1]); w.y = pk2(x[2], x[3]); *(u32x2*)(xb + row * DM + col) = w; }
                        s += (x[0] * x[0] + x[1] * x[1]) + (x[2] * x[2] + x[3] * x[3]); }
                { const int lid = fr + 16 * fq;
                  s += __builtin_bit_cast(float, __builtin_amdgcn_ds_bpermute((lid ^ 16) << 2, __builtin_bit_cast(int, s)));
                  s += __builtin_bit_cast(float, __builtin_amdgcn_ds_bpermute((lid ^ 32) << 2, __builtin_bit_cast(int, s))); }
                if (fq == 0 && wr_en) ssq[rl * 4 + wc] += s;
                asm volatile("" ::: "memory"); }
    }
};
}

struct KParams {
    const float* x; const float* p; const float* rel_bias; const float* attn_norm; const float* w_in; const float* qk_conv; const float* gate_bias; const float* sink;
    const float* mlstm_norm; const float* w_out; const float* ffn_norm; const float* w_up; const float* w_down; const float* ple_proj; const float* ple_gate; const float* final_norm;
    float* out; unsigned char* ws;
};

DI void transpose_item(const float* __restrict__ W, int K, int Nsrc, int n0, int nvalid, const float* __restrict__ gk, float cs,
                       bf16_t* __restrict__ WT, int dst_row0, int k0, LAS float* scr, int lane) {
    const int c = lane & 31, kh = lane >> 5;
#pragma unroll 8
    for (int i = 0; i < 32; ++i) { const int kk = 2 * i + kh; float v = 0.f;
        if (c < nvalid) { v = W[(size_t)(k0 + kk) * Nsrc + n0 + c] * cs; if (gk) v *= gk[k0 + kk]; }
        scr[kk * 33 + c] = v; }
    WAVE_LDS_FENCE();
    const int c8 = lane & 7;
#pragma unroll
    for (int j = 0; j < 4; ++j) { const int n = (lane >> 3) + 8 * j; const LAS float* s = scr + (8 * c8) * 33 + n;
        u32x4 o; o.x = pk2(s[0 * 33], s[1 * 33]); o.y = pk2(s[2 * 33], s[3 * 33]); o.z = pk2(s[4 * 33], s[5 * 33]); o.w = pk2(s[6 * 33], s[7 * 33]);
        *(u32x4*)(WT + (size_t)(dst_row0 + n) * K + k0 + 8 * c8) = o; }
    WAVE_LDS_FENCE();
}
constexpr int IT_WIN = 16 * 104, IT_WOUT = 16 * 32, IT_WUP = 16 * 176, IT_WDOWN = 44 * 32, IT_WP = 4 * 32, IT_WG = 16 * 32;
constexpr int IT_LAYER = IT_WIN + IT_WOUT + IT_WUP + IT_WDOWN + IT_WP + IT_WG;

DI void prep_weights(const KParams& P, LAS unsigned char* lds, int gw, int NGW, int wave, int lane) {
    LAS float* scr = (LAS float*)(lds + wave * 16384);
    bf16_t* Wall = (bf16_t*)(P.ws + WS_W);
    for (int it = gw; it < DEPTH * IT_LAYER; it += NGW) {
        const int l = it / IT_LAYER; int r = it % IT_LAYER;
        bf16_t* Wl = Wall + (size_t)l * LAYER_W;
        if (r < IT_WIN) { const int kb = r / 104, jb = r % 104, d0 = 32 * jb; int src = d0, nv = 32; float cs = 1.f;
            if (d0 < 384) { src = d0; cs = QSCALE; } else if (d0 < 640) { src = 1152 + d0 - 384; cs = QSCALE; } else if (d0 < 1024) src = 1664 + d0 - 640;
            else if (d0 < 1408) src = 384 + d0 - 1024; else if (d0 < 1536) src = d0; else if (d0 < 1920) src = 2048 + d0 - 1536;
            else if (d0 < 2304) src = 768 + d0 - 1920; else if (d0 < 2432) src = 1536 + d0 - 2304; else if (d0 < 3200) src = d0;
            else if (d0 == 3200) { src = 3200; nv = 24; } else { src = 0; nv = 0; }
            transpose_item(P.w_in + (size_t)l * DM * DIN, DM, DIN, src, nv, P.attn_norm + l * DM, cs, Wl + OFF_WIN, d0, 64 * kb, scr, lane); continue; }
        r -= IT_WIN;
        if (r < IT_WOUT) { const int kb = r / 32, jb = r % 32; transpose_item(P.w_out + (size_t)l * DM * DM, DM, DM, 32 * jb, 32, nullptr, 1.f, Wl + OFF_WOUT, 32 * jb, 64 * kb, scr, lane); continue; }
        r -= IT_WOUT;
        if (r < IT_WUP) { const int kb = r / 176, jb = r % 176, d0 = 32 * jb, pn = d0 >> 8, c0 = d0 & 255; const int src = c0 < 128 ? 128 * pn + c0 : DFF + 128 * pn + (c0 - 128);
            transpose_item(P.w_up + (size_t)l * DM * NUP, DM, NUP, src, 32, P.ffn_norm + l * DM, 1.f, Wl + OFF_WUP, d0, 64 * kb, scr, lane); continue; }
        r -= IT_WUP;
        if (r < IT_WDOWN) { const int kb = r / 32, jb = r % 32; transpose_item(P.w_down + (size_t)l * DFF * DM, DFF, DM, 32 * jb, 32, nullptr, 1.f, Wl + OFF_WDOWN, 32 * jb, 64 * kb, scr, lane); continue; }
        r -= IT_WDOWN;
        if (r < IT_WP) { const int kb = r / 32, jb = r % 32; transpose_item(P.ple_proj + (size_t)l * PLE * DM, PLE, DM, 32 * jb, 32, nullptr, 1.f, Wl + OFF_WP, 32 * jb, 64 * kb, scr, lane); continue; }
        r -= IT_WP;
        { const int kb = r / 32, jb = r % 32; transpose_item(P.ple_gate + (size_t)l * DM * DM, DM, DM, 32 * jb, 32, nullptr, 1.f, Wl + OFF_WG, 32 * jb, 64 * kb, scr, lane); }
    }
}
DI float wave_sum(float v, int lane) {
#pragma unroll
    for (int o = 1; o < 64; o <<= 1) v += shx(v, o, lane);
    return v;
}
DI float wave_max(float v, int lane) {
#pragma unroll
    for (int o = 1; o < 64; o <<= 1) v = fmaxf(v, shx(v, o, lane));
    return v;
}

constexpr int VROW = 144;
constexpr int VBUF = 32 * VROW;
constexpr int LUTN = 640, LUTC = 320;

DI void load_kv(const bf16_t* __restrict__ zb, int kcol, int vcol, int dstr, int rd, int u0, int lane, bf16x8 (&kn)[2][2], u32x4 (&vn)[4]) {
    const int r16 = lane & 15, g = lane >> 4;
#pragma unroll
    for (int T = 0; T < 2; ++T) { int pos = dstr * (u0 + 16 * T + r16) + rd; pos = pos < 0 ? 0 : (pos > SEQ - 1 ? SEQ - 1 : pos);
        const bf16_t* p = zb + (size_t)pos * ZLD + kcol + 8 * g; kn[T][0] = *(const bf16x8*)p; kn[T][1] = *(const bf16x8*)(p + 32); }
#pragma unroll
    for (int k = 0; k < 4; ++k) { const int id = lane + 64 * k, row = id >> 3, c16 = id & 7; int pos = dstr * (u0 + row) + rd; pos = pos < 0 ? 0 : (pos > SEQ - 1 ? SEQ - 1 : pos);
        vn[k] = *(const u32x4*)(zb + (size_t)pos * ZLD + vcol + 8 * c16); }
}

struct DescA {
    int rd0, rd1, ub0, ub1, ub2, uq0, uq1, uq2, tb;
    DI void get(int ci, int g, int& dstr, int& rd, int& u0, int& li) const {
        const int cf = ci < 5 ? 0 : (ci < 11 ? 1 : 2); const int lc = ci - (cf == 0 ? 0 : (cf == 1 ? 5 : 11));
        dstr = cf == 0 ? 16 : (cf == 1 ? 4 : 1); rd = cf == 0 ? rd0 : (cf == 1 ? rd1 : 0);
        u0 = (cf == 0 ? ub0 : (cf == 1 ? ub1 : ub2)) + 32 * lc;
        const int uq = cf == 0 ? uq0 : (cf == 1 ? uq1 : uq2);
        li = u0 - uq + 4 * g + LUTC + tb + cf * 6 * LUTN; }
};
struct DescB {
    int ub, uq, tb;
    DI void get(int ci, int g, int& dstr, int& rd, int& u0, int& li) const { dstr = 1; rd = 0; u0 = ub + 32 * ci; li = u0 - uq + 4 * g + LUTC + tb; }
};

template <int NH, int D, class Desc>
DI void attn_stream(const bf16_t* __restrict__ zb, int kcol, int vcol, int nch, const Desc& ds, const LAS float* lutbase,
                    const bf16x8 (&qf)[NH][2], float (&m)[NH], float (&l)[NH], f32x4 (&o)[NH][4], LAS unsigned char* vbase, int lane) {
    const int r16 = lane & 15, g = lane >> 4, q4 = r16 >> 2, p4 = r16 & 3;
    bf16x8 kn[D][2][2]; u32x4 vn[D][4];
#pragma unroll
    for (int j = 0; j < D; ++j) if (j < nch) { int dstr, rd, u0, li; ds.get(j, g, dstr, rd, u0, li); load_kv(zb, kcol, vcol, dstr, rd, u0, lane, kn[j], vn[j]); }
    for (int c0 = 0; c0 < nch; c0 += D) {
#pragma unroll
        for (int j = 0; j < D; ++j) {
            const int c = c0 + j;
            if (c < nch) {
                int dstr, rd, u0, li; ds.get(c, g, dstr, rd, u0, li);
                LAS unsigned char* vb = vbase + (c & 1) * VBUF;
#pragma unroll
                for (int k = 0; k < 4; ++k) { const int id = lane + 64 * k, row = id >> 3, c16 = id & 7; *(LAS u32x4*)(vb + row * VROW + c16 * 16) = vn[j][k]; }
                f32x4 stt[NH][2];
#pragma unroll
                for (int hh = 0; hh < NH; ++hh)
#pragma unroll
                    for (int T = 0; T < 2; ++T) { f32x4 st = {0.f, 0.f, 0.f, 0.f}; st = mfma16(kn[j][T][0], qf[hh][0], st); st = mfma16(kn[j][T][1], qf[hh][1], st); stt[hh][T] = st; }
                if (c + D < nch) { int d2, r2, u2, l2; ds.get(c + D, g, d2, r2, u2, l2); load_kv(zb, kcol, vcol, d2, r2, u2, lane, kn[j], vn[j]); }
                float rm[2][4];
#pragma unroll
                for (int T = 0; T < 2; ++T)
#pragma unroll
                    for (int i = 0; i < 4; ++i) { const int pos = dstr * (u0 + 16 * T + 4 * g + i) + rd; rm[T][i] = ((unsigned)pos < (unsigned)SEQ) ? 0.f : NEGBIG; }
                bf16x8 vf[4];
#pragma unroll
                for (int c4 = 0; c4 < 4; ++c4) { const s16x4 a0 = trread(vb + (4 * g + q4) * VROW + 32 * c4 + 8 * p4), a1 = trread(vb + (16 + 4 * g + q4) * VROW + 32 * c4 + 8 * p4); vf[c4] = cat8(a0, a1); }
#pragma unroll
                for (int hh = 0; hh < NH; ++hh) {
                    const LAS float* lut = lutbase + hh * LUTN + li;
                    float sv[8];
#pragma unroll
                    for (int T = 0; T < 2; ++T) {
#pragma unroll
                        for (int i = 0; i < 4; ++i) sv[4 * T + i] = stt[hh][T][i] + lut[16 * T + i] + rm[T][i]; }
                    float cm = fmaxf(fmaxf(fmaxf(sv[0], sv[1]), fmaxf(sv[2], sv[3])), fmaxf(fmaxf(sv[4], sv[5]), fmaxf(sv[6], sv[7])));
                    cm = fmaxf(cm, shx(cm, 16, lane)); cm = fmaxf(cm, shx(cm, 32, lane));
                    const float mn = fmaxf(m[hh], cm), alpha = ex2(m[hh] - mn); m[hh] = mn;
                    float pv[8], ps = 0.f;
#pragma unroll
                    for (int k = 0; k < 8; ++k) { pv[k] = ex2(sv[k] - mn); ps += pv[k]; }
                    l[hh] = l[hh] * alpha + ps;
                    u32x4 pw; pw.x = pk2(pv[0], pv[1]); pw.y = pk2(pv[2], pv[3]); pw.z = pk2(pv[4], pv[5]); pw.w = pk2(pv[6], pv[7]);
                    const bf16x8 pf = __builtin_bit_cast(bf16x8, pw);
#pragma unroll
                    for (int c4 = 0; c4 < 4; ++c4) { o[hh][c4] = o[hh][c4] * alpha; o[hh][c4] = mfma16(vf[c4], pf, o[hh][c4]); }
                }
            }
        }
    }
}

DI void build_lut(const KParams& P, LAS unsigned char* lds, int tid) {
    LAS float* lut = (LAS float*)lds;
    for (int idx = tid; idx < 22 * LUTN; idx += 512) {
        const int t = idx / LUTN, rel = idx % LUTN - LUTC; int dil, half, hc;
        if (t < 18) { const int cfg = t / 6; dil = cfg == 0 ? 16 : (cfg == 1 ? 4 : 1); half = 64; hc = t % 6; } else { dil = 1; half = 128; hc = 6 + (t - 18); }
        float v = NEGBIG; const int ar = rel < 0 ? -rel : rel;
        if (ar <= half) { const int n = ar * dil; int bk;
            if (n < 8) bk = n; else { const float nf = (float)n; bk = 8 + (int)(logf(nf / 8.0f) / 4.852030263919617f * 8.0f); bk = bk > 15 ? 15 : bk; }
            if (rel > 0) bk += 16;
            v = P.rel_bias[bk * 10 + hc] * LOG2E; }
        lut[idx] = v;
    }
}

DI void attention_phase(const KParams& P0_, LAS unsigned char* lds, int l, int pm, int wave, int lane, bool wr_en = true) {
    KParams P = P0_; { __attribute__((address_space(1))) unsigned char* w1_ = (__attribute__((address_space(1))) unsigned char*)P.ws; asm volatile("" : "+s"(w1_)); P.ws = (unsigned char*)w1_; }

    bf16_t* Z = (bf16_t*)(P.ws + WS_Z);
    const int r16 = lane & 15, g = lane >> 4;
    const int row0 = pm * 256, b = row0 / SEQ, s0 = row0 % SEQ;
    bf16_t* zb = Z + (size_t)b * SEQ * ZLD;
    const LAS float* lut = (const LAS float*)lds;
    LAS unsigned char* vbase = lds + 22 * LUTN * 4 + wave * (2 * VBUF);
    for (int ua = wave; ua < 96; ua += 8) {
        const int h = ua >> 4, rho = ua & 15;
        const int posq = s0 + rho + 16 * r16;
        bf16x8 qf[1][2];
        { const bf16_t* qp = zb + (size_t)posq * ZLD + QA + 64 * h + 8 * g; qf[0][0] = *(const bf16x8*)qp; qf[0][1] = *(const bf16x8*)(qp + 32); }
        float m[1] = {-1e20f}, lsum[1] = {0.f}; f32x4 o[1][4];
#pragma unroll
        for (int c4 = 0; c4 < 4; ++c4) o[0][c4] = zero4();
        { DescA ds; const int U16 = s0 >> 4, U4 = (s0 >> 2) + (rho >> 2), U1 = s0 + rho;
          ds.rd0 = rho; ds.rd1 = rho & 3; ds.ub0 = U16 - 64; ds.ub1 = U4 - 64; ds.ub2 = U1 - 64; ds.uq0 = U16 + r16; ds.uq1 = U4 + 4 * r16; ds.uq2 = U1 + 16 * r16; ds.tb = h * LUTN;
          attn_stream<1, 2, DescA>(zb, KA + 64 * h, VA + 64 * h, 23, ds, lut, qf, m, lsum, o, vbase, lane); }
        float lt = lsum[0]; lt += shx(lt, 16, lane); lt += shx(lt, 32, lane);
        const float inv = 1.f / lt;
        bf16_t* yp = zb + (size_t)posq * ZLD + QA + 64 * h + 4 * g;
        if (wr_en)
#pragma unroll
        for (int c4 = 0; c4 < 4; ++c4) { const f32x4 v = o[0][c4] * inv; u32x2 w; w.x = pk2(v[0], v[1]); w.y = pk2(v[2], v[3]); *(u32x2*)(yp + 16 * c4) = w; }
    }
    for (int ub = wave; ub < 32; ub += 8) {
        const int kvh = ub >> 4, qg = ub & 15;
        const int posq = s0 + 16 * qg + r16;
        bf16x8 qf[2][2];
#pragma unroll
        for (int hh = 0; hh < 2; ++hh) { const bf16_t* qp = zb + (size_t)posq * ZLD + QB + 64 * (2 * kvh + hh) + 8 * g; qf[hh][0] = *(const bf16x8*)qp; qf[hh][1] = *(const bf16x8*)(qp + 32); }
        float m[2] = {-1e20f, -1e20f}, lsum[2] = {0.f, 0.f}; f32x4 o[2][4];
#pragma unroll
        for (int hh = 0; hh < 2; ++hh)
#pragma unroll
            for (int c4 = 0; c4 < 4; ++c4) o[hh][c4] = zero4();
        const int U0 = s0 + 16 * qg;
        { DescB ds; ds.ub = U0 - 128; ds.uq = U0 + r16; ds.tb = (18 + 2 * kvh) * LUTN;
          attn_stream<2, 2, DescB>(zb, KB + 64 * kvh, VB + 64 * kvh, 9, ds, lut, qf, m, lsum, o, vbase, lane); }
#pragma unroll
        for (int hh = 0; hh < 2; ++hh) { const int hq = 2 * kvh + hh;
            float lt = lsum[hh]; lt += shx(lt, 16, lane); lt += shx(lt, 32, lane);
            const float sk = P.sink[l * 4 + hq] * LOG2E, mf = fmaxf(m[hh], sk), sc = ex2(m[hh] - mf);
            const float den = lt * sc + ex2(sk - mf), f = sc / den;
            bf16_t* yp = zb + (size_t)posq * ZLD + QB + 64 * hq + 4 * g;
            if (wr_en)
#pragma unroll
            for (int c4 = 0; c4 < 4; ++c4) { const f32x4 v = o[hh][c4] * f; u32x2 w; w.x = pk2(v[0], v[1]); w.y = pk2(v[2], v[3]); *(u32x2*)(yp + 16 * c4) = w; } }
    }
}

DI float logsig(float x) { return fminf(x, 0.f) - log1pf(fexp(-fabsf(x))); }
DI float scan_add_up(float v, int lane) {
#pragma unroll
    for (int o = 1; o < 64; o <<= 1) { const float t = shi(v, lane - o); if (lane >= o) v += t; }
    return v;
}
DI float scan_add_down(float v, int lane) {
#pragma unroll
    for (int o = 1; o < 64; o <<= 1) { const float t = shi(v, lane + o); if (lane + o < 64) v += t; }
    return v;
}
DI float scan_max_up(float v, int lane) {
#pragma unroll
    for (int o = 1; o < 64; o <<= 1) { const float t = shi(v, lane - o); if (lane >= o) v = fmaxf(v, t); }
    return v;
}
DI float scan_max_down(float v, int lane) {
#pragma unroll
    for (int o = 1; o < 64; o <<= 1) { const float t = shi(v, lane + o); if (lane + o < 64) v = fmaxf(v, t); }
    return v;
}

DI void conv8(const bf16_t* __restrict__ zb, int s, int col, const float* __restrict__ cw  , int lane, float (&acc)[8][8]) {
    const int r8 = lane >> 3;
    float w[5][8];
#pragma unroll
    for (int j = 0; j < 5; ++j) { const f32x4 a = *(const f32x4*)(cw + j * 768), b = *(const f32x4*)(cw + j * 768 + 4);
        w[j][0] = a[0]; w[j][1] = a[1]; w[j][2] = a[2]; w[j][3] = a[3]; w[j][4] = b[0]; w[j][5] = b[1]; w[j][6] = b[2]; w[j][7] = b[3]; }
#pragma unroll
    for (int k = 0; k < 8; ++k)
#pragma unroll
        for (int e = 0; e < 8; ++e) acc[k][e] = 0.f;
#pragma unroll
    for (int rr = -2; rr < 10; ++rr) {
        const int pos = s + 8 * r8 + rr;
        u32x4 raw = {0u, 0u, 0u, 0u};
        if ((unsigned)pos < (unsigned)SEQ) raw = *(const u32x4*)(zb + (size_t)pos * ZLD + col);
        float x[8] = {bflo(raw.x), bfhi(raw.x), bflo(raw.y), bfhi(raw.y), bflo(raw.z), bfhi(raw.z), bflo(raw.w), bfhi(raw.w)};
#pragma unroll
        for (int k = 0; k < 8; ++k) { const int j = rr - k + 2;
            if (j >= 0 && j <= 4) {
#pragma unroll
                for (int e = 0; e < 8; ++e) acc[k][e] += w[j][e] * x[e]; } }
    }
#pragma unroll
    for (int k = 0; k < 8; ++k)
#pragma unroll
        for (int e = 0; e < 8; ++e) { const float a = acc[k][e]; acc[k][e] = a * sigmoidf_(a); }
}

DI void mlstm_state_phase(const KParams& P0_, LAS unsigned char* lds, int l, int pm, int wave, int lane) {
    KParams P = P0_; { __attribute__((address_space(1))) unsigned char* w1_ = (__attribute__((address_space(1))) unsigned char*)P.ws; asm volatile("" : "+s"(w1_)); P.ws = (unsigned char*)w1_; }

    bf16_t* Z = (bf16_t*)(P.ws + WS_Z);
    const float* gates = (const float*)(P.ws + WS_GATES);
    bf16_t* qconv = (bf16_t*)(P.ws + WS_QCONV); bf16_t* kconv = (bf16_t*)(P.ws + WS_KCONV);
    bf16_t* CT = (bf16_t*)(P.ws + WS_CT); bf16_t* nbuf = (bf16_t*)(P.ws + WS_NB);
    float* mloc = (float*)(P.ws + WS_ML); float* blast = (float*)(P.ws + WS_BL);
    const float* gb = P.gate_bias + l * 24;
    const int r16 = lane & 15, g = lane >> 4, q4 = r16 >> 2, p4 = r16 & 3, r8 = lane >> 3, pc = lane & 7;
    LAS unsigned char* kbuf = lds + wave * (2 * 64 * VROW);
    LAS unsigned char* vbuf = kbuf + 64 * VROW;
    for (int um = wave; um < 24; um += 8) {
        asm volatile("" : "+v"(lane));
        const int cc = um / 6, h = um % 6;
        const int tc = pm * 256 + 64 * cc, b = tc / SEQ, s = tc % SEQ, ci = s >> 6;
        const bf16_t* zb = Z + (size_t)b * SEQ * ZLD;
        const float* G = gates + (size_t)(tc + lane) * 24;
        const float igf = G[h] + gb[h], fgf = G[6 + h] + gb[6 + h], igb = G[12 + h] + gb[12 + h], fgb = G[18 + h] + gb[18 + h];
        const float bfw = scan_add_up(logsig(fgf), lane), bbw = scan_add_down(logsig(fgb), lane);
        const float blf = shi(bfw, 63), blb = shi(bbw, 0);
        const float wf = blf - bfw + igf, wb = blb - bbw + igb;
        const float mlf = wave_max(wf, lane), mlb = wave_max(wb, lane);
        const float ef = fexp(wf - mlf), eb = fexp(wb - mlb);
        const int slot_f = ((0 * NB + b) * 6 + h) * NCH + ci, slot_b = ((1 * NB + b) * 6 + h) * NCH + ci;
        if (lane == 0) { mloc[slot_f] = mlf; blast[slot_f] = blf; mloc[slot_b] = mlb; blast[slot_b] = blb; }
        float acc[8][8];
        conv8(zb, s, QC + 64 * h + 8 * pc, P.qk_conv + (size_t)l * 5 * 768 + 64 * h + 8 * pc, lane, acc);
#pragma unroll
        for (int k = 0; k < 8; ++k) { u32x4 w; w.x = pk2(acc[k][0], acc[k][1]); w.y = pk2(acc[k][2], acc[k][3]); w.z = pk2(acc[k][4], acc[k][5]); w.w = pk2(acc[k][6], acc[k][7]);
            *(u32x4*)(qconv + (size_t)(tc + 8 * r8 + k) * 384 + 64 * h + 8 * pc) = w; }
        conv8(zb, s, KC + 64 * h + 8 * pc, P.qk_conv + (size_t)l * 5 * 768 + 384 + 64 * h + 8 * pc, lane, acc);
        u32x4 kpk[8];
#pragma unroll
        for (int k = 0; k < 8; ++k) {
#pragma unroll
            for (int e = 0; e < 8; ++e) acc[k][e] *= 0.125f;
            u32x4 w; w.x = pk2(acc[k][0], acc[k][1]); w.y = pk2(acc[k][2], acc[k][3]); w.z = pk2(acc[k][4], acc[k][5]); w.w = pk2(acc[k][6], acc[k][7]);
            kpk[k] = w;
            *(u32x4*)(kconv + (size_t)(tc + 8 * r8 + k) * 384 + 64 * h + 8 * pc) = w; }
#pragma unroll
        for (int k = 0; k < 8; ++k) { const int id = lane + 64 * k, row = id >> 3, c16 = id & 7;
            *(LAS u32x4*)(vbuf + row * VROW + 16 * c16) = *(const u32x4*)(zb + (size_t)(s + row) * ZLD + VC + 64 * h + 8 * c16); }
#pragma unroll
        for (int dir = 0; dir < 2; ++dir) {
            const float ed = dir ? eb : ef;
#pragma unroll
            for (int k = 0; k < 8; ++k) { const float e = shi(ed, 8 * r8 + k); const u32x4 kk = kpk[k];
                u32x4 w; w.x = pk2(bflo(kk.x) * e, bfhi(kk.x) * e); w.y = pk2(bflo(kk.y) * e, bfhi(kk.y) * e); w.z = pk2(bflo(kk.z) * e, bfhi(kk.z) * e); w.w = pk2(bflo(kk.w) * e, bfhi(kk.w) * e);
                *(LAS u32x4*)(kbuf + (8 * r8 + k) * VROW + 16 * pc) = w; }
            WAVE_LDS_FENCE();
            f32x4 c[4][5];
#pragma unroll
            for (int dt = 0; dt < 4; ++dt)
#pragma unroll
                for (int et = 0; et < 5; ++et) c[dt][et] = zero4();
#pragma unroll
            for (int ks = 0; ks < 2; ++ks) {
                bf16x8 af[4], bfr[5];
#pragma unroll
                for (int t4 = 0; t4 < 4; ++t4) {
                    af[t4] = cat8(trread(kbuf + (32 * ks + 8 * g + q4) * VROW + 32 * t4 + 8 * p4), trread(kbuf + (32 * ks + 8 * g + 4 + q4) * VROW + 32 * t4 + 8 * p4));
                    bfr[t4] = cat8(trread(vbuf + (32 * ks + 8 * g + q4) * VROW + 32 * t4 + 8 * p4), trread(vbuf + (32 * ks + 8 * g + 4 + q4) * VROW + 32 * t4 + 8 * p4)); }
                { const short one = r16 == 0 ? (short)0x3F80 : (short)0; bfr[4] = (bf16x8){one, one, one, one, one, one, one, one}; }
#pragma unroll
                for (int dt = 0; dt < 4; ++dt)
#pragma unroll
                    for (int et = 0; et < 5; ++et) c[dt][et] = mfma16(af[dt], bfr[et], c[dt][et]);
            }
            const int slot = dir ? slot_b : slot_f;
            bf16_t* ct = CT + ((size_t)(slot / NCH) * 64 * NCH + (slot % NCH)) * 64;
#pragma unroll
            for (int dt = 0; dt < 4; ++dt) {
#pragma unroll
                for (int et = 0; et < 4; ++et) { const f32x4 v = c[dt][et]; u32x2 w; w.x = pk2(v[0], v[1]); w.y = pk2(v[2], v[3]); *(u32x2*)(ct + (size_t)(16 * et + r16) * (NCH * 64) + 16 * dt + 4 * g) = w; }
                if (r16 == 0) { const f32x4 v = c[dt][4]; u32x2 w; w.x = pk2(v[0], v[1]); w.y = pk2(v[2], v[3]); *(u32x2*)(nbuf + (size_t)slot * 64 + 16 * dt + 4 * g) = w; } }
            WAVE_LDS_FENCE();
        }
    }
}

DI void mlstm_scan_phase(const KParams& P0_, LAS unsigned char* lds, int bid, int G, int tid, bool wr_en = true) {
    KParams P = P0_; { __attribute__((address_space(1))) unsigned char* w1_ = (__attribute__((address_space(1))) unsigned char*)P.ws; asm volatile("" : "+s"(w1_)); P.ws = (unsigned char*)w1_; }
    bf16_t* CT = (bf16_t*)(P.ws + WS_CT); bf16_t* nbuf = (bf16_t*)(P.ws + WS_NB);
    const float* mloc = (const float*)(P.ws + WS_ML); const float* blast = (const float*)(P.ws + WS_BL); float* mprev = (float*)(P.ws + WS_MP);
    LAS float* sbl = (LAS float*)lds; LAS float* sml = sbl + 512; LAS float* sa = sml + 512; LAS float* scc = sa + 512;
    const int wave = tid >> 6, lane = tid & 63;
    { const int k = tid >> 7, st = tid & 127; const int sq = k < 3 ? ((bid * 8 + 2048 * k) >> 6) : (bid < NSEQ ? bid : 0); const int c = sq >= NSEQ / 2 ? (NCH - 1 - st) : st;
      sbl[tid] = blast[sq * NCH + c]; sml[tid] = mloc[sq * NCH + c]; }
    __syncthreads();
    if (tid < 4) { const int k = tid; const int sq = k < 3 ? ((bid * 8 + 2048 * k) >> 6) : (bid < NSEQ ? bid : 0); const bool dirb = sq >= NSEQ / 2;
        const bool wm = wr_en && k < 3 && ((bid * 8) & 63) == 0;
        float m = 0.f;
        for (int st = 0; st < NCH; ++st) { const float bl = sbl[k * 128 + st], ml = sml[k * 128 + st]; const float mn = fmaxf(bl + m, ml);
            sa[k * 128 + st] = fexp(bl + m - mn); scc[k * 128 + st] = fexp(ml - mn);
            if (wm) mprev[sq * NCH + (dirb ? (NCH - 1 - st) : st)] = m;
            m = mn; } }
    __syncthreads();
    bf16_t* ptr[4]; bool act[4]; bool dirb[4];
#pragma unroll
    for (int k = 0; k < 3; ++k) { const int row = bid * 8 + wave + 2048 * k; ptr[k] = CT + (size_t)row * (NCH * 64) + lane; act[k] = true; dirb[k] = (row >> 6) >= NSEQ / 2; }
    { ptr[3] = nbuf + (size_t)(bid < NSEQ ? bid : 0) * NCH * 64 + lane; act[3] = bid < NSEQ && wave == 0; dirb[3] = bid >= NSEQ / 2; }
    float C[4] = {0.f, 0.f, 0.f, 0.f};
    for (int st0 = 0; st0 < NCH; st0 += 8) {
        float cl[4][8];
#pragma unroll
        for (int k = 0; k < 4; ++k)
#pragma unroll
            for (int j = 0; j < 8; ++j) { const int c = dirb[k] ? (NCH - 1 - (st0 + j)) : (st0 + j); cl[k][j] = act[k] ? bf2f(ptr[k][c * 64]) : 0.f; }
#pragma unroll
        for (int k = 0; k < 4; ++k)
#pragma unroll
            for (int j = 0; j < 8; ++j) { const int c = dirb[k] ? (NCH - 1 - (st0 + j)) : (st0 + j);
                if (act[k] && wr_en) ptr[k][c * 64] = (bf16_t)(pk2(C[k], 0.f) & 0xffffu);
                C[k] = sa[k * 128 + st0 + j] * C[k] + scc[k * 128 + st0 + j] * cl[k][j]; }
    }
    __syncthreads();
}

DI void mlstm_out_phase(const KParams& P0_, LAS unsigned char* lds, int l, int pm, int wave, int lane) {
    KParams P = P0_; { __attribute__((address_space(1))) unsigned char* w1_ = (__attribute__((address_space(1))) unsigned char*)P.ws; asm volatile("" : "+s"(w1_)); P.ws = (unsigned char*)w1_; }

    bf16_t* Z = (bf16_t*)(P.ws + WS_Z);
    const float* gates = (const float*)(P.ws + WS_GATES);
    const bf16_t* qconv = (const bf16_t*)(P.ws + WS_QCONV); const bf16_t* kconv = (const bf16_t*)(P.ws + WS_KCONV);
    const bf16_t* CT = (const bf16_t*)(P.ws + WS_CT); const bf16_t* nbuf = (const bf16_t*)(P.ws + WS_NB);
    const float* mprev = (const float*)(P.ws + WS_MP);
    const float* gb = P.gate_bias + l * 24;
    const int r16 = lane & 15, g = lane >> 4, q4 = r16 >> 2, p4 = r16 & 3;
    LAS unsigned char* vbuf = lds + wave * (64 * VROW + 2048 + 256);
    LAS float* tab = (LAS float*)(vbuf + 64 * VROW);
    LAS unsigned char* ntab = vbuf + 64 * VROW + 2048;
    for (int um = wave; um < 24; um += 8) {
        asm volatile("" : "+v"(lane));
        const int cc = um / 6, h = um % 6;
        const int tc = pm * 256 + 64 * cc, b = tc / SEQ, s = tc % SEQ, ci = s >> 6;
        bf16_t* zb = Z + (size_t)b * SEQ * ZLD;
        const int slot_f = ((0 * NB + b) * 6 + h) * NCH + ci, slot_b = ((1 * NB + b) * 6 + h) * NCH + ci;
        {
            const float* G = gates + (size_t)(tc + lane) * 24;
            const float igf = G[h] + gb[h], fgf = G[6 + h] + gb[6 + h], igb = G[12 + h] + gb[12 + h], fgb = G[18 + h] + gb[18 + h];
            const float bfw = scan_add_up(logsig(fgf), lane), bbw = scan_add_down(logsig(fgb), lane);
            const float gf = igf - bfw, gbk = igb - bbw;
            const float pmf = scan_max_up(gf, lane), pmb = scan_max_down(gbk, lane);
            const float mpf = mprev[slot_f], mpb = mprev[slot_b];
            const float Mf = fmaxf(pmf, mpf), Mb = fmaxf(pmb, mpb);
            tab[0 * 64 + lane] = gf; tab[1 * 64 + lane] = gbk; tab[2 * 64 + lane] = Mf; tab[3 * 64 + lane] = Mb;
            tab[4 * 64 + lane] = fexp(mpf - Mf); tab[5 * 64 + lane] = fexp(mpb - Mb); tab[6 * 64 + lane] = fexp(-(bfw + Mf)); tab[7 * 64 + lane] = fexp(-(bbw + Mb));
        }
#pragma unroll
        for (int k = 0; k < 8; ++k) { const int id = lane + 64 * k, row = id >> 3, c16 = id & 7;
            *(LAS u32x4*)(vbuf + row * VROW + 16 * c16) = *(const u32x4*)(zb + (size_t)(s + row) * ZLD + VC + 64 * h + 8 * c16); }
        bf16x8 kfr[4][2];
#pragma unroll
        for (int st = 0; st < 4; ++st) { const bf16_t* kp = kconv + (size_t)(tc + 16 * st + r16) * 384 + 64 * h + 8 * g; kfr[st][0] = *(const bf16x8*)kp; kfr[st][1] = *(const bf16x8*)(kp + 32); }
        bf16x8 cfr[2][4][2];
#pragma unroll
        for (int dir = 0; dir < 2; ++dir) { const int slot = dir ? slot_b : slot_f; const bf16_t* ct = CT + ((size_t)(slot / NCH) * 64 * NCH + (slot % NCH)) * 64;
#pragma unroll
            for (int kp = 0; kp < 2; ++kp)
#pragma unroll
                for (int et = 0; et < 4; ++et) cfr[dir][et][kp] = *(const bf16x8*)(ct + (size_t)(16 * et + r16) * (NCH * 64) + 32 * kp + 8 * g); }
        if (lane < 16) { const int dirn = lane >> 3, c8 = lane & 7; *(LAS u32x4*)(ntab + dirn * 128 + c8 * 16) = *(const u32x4*)(nbuf + (size_t)(dirn ? slot_b : slot_f) * 64 + 8 * c8); }
        WAVE_LDS_FENCE();
        for (int tt = 0; tt < 4; ++tt) {
            const int tau = 16 * tt + r16;
            bf16x8 qfr[2];
            { const bf16_t* qp = qconv + (size_t)(tc + tau) * 384 + 64 * h + 8 * g; qfr[0] = *(const bf16x8*)qp; qfr[1] = *(const bf16x8*)(qp + 32); }
            f32x4 S[4];
#pragma unroll
            for (int st = 0; st < 4; ++st) { S[st] = (f32x4){0.f, 0.f, 0.f, 0.f}; S[st] = mfma16(kfr[st][0], qfr[0], S[st]); S[st] = mfma16(kfr[st][1], qfr[1], S[st]); }
            f32x4 hs[4];
#pragma unroll
            for (int et = 0; et < 4; ++et) hs[et] = zero4();
#pragma unroll
            for (int dir = 0; dir < 2; ++dir) {
                const float Mt = tab[(2 + dir) * 64 + tau], at = tab[(4 + dir) * 64 + tau], flt = tab[(6 + dir) * 64 + tau];
                bf16x8 pfr[2];
#pragma unroll
                for (int kp = 0; kp < 2; ++kp) { float pv[8];
#pragma unroll
                    for (int hf = 0; hf < 2; ++hf) { const int st = 2 * kp + hf; const f32x4 gs = *(const LAS f32x4*)(tab + dir * 64 + 16 * st + 4 * g);
#pragma unroll
                        for (int i = 0; i < 4; ++i) { const int sg = 16 * st + 4 * g + i; const bool ok = dir ? (sg >= tau) : (sg <= tau);
                            const float e = fexp(gs[i] - Mt) * S[st][i]; pv[4 * hf + i] = ok ? e : 0.f; } }
                    u32x4 pw; pw.x = pk2(pv[0], pv[1]); pw.y = pk2(pv[2], pv[3]); pw.z = pk2(pv[4], pv[5]); pw.w = pk2(pv[6], pv[7]); pfr[kp] = __builtin_bit_cast(bf16x8, pw); }
                f32x4 nd[5];
#pragma unroll
                for (int et = 0; et < 5; ++et) nd[et] = zero4();
#pragma unroll
                for (int kp = 0; kp < 2; ++kp) {
                    const u32x4 qw = __builtin_bit_cast(u32x4, qfr[kp]); u32x4 qs;
                    qs.x = pk2(bflo(qw.x) * at, bfhi(qw.x) * at); qs.y = pk2(bflo(qw.y) * at, bfhi(qw.y) * at); qs.z = pk2(bflo(qw.z) * at, bfhi(qw.z) * at); qs.w = pk2(bflo(qw.w) * at, bfhi(qw.w) * at);
                    const bf16x8 qsc = __builtin_bit_cast(bf16x8, qs);
#pragma unroll
                    for (int et = 0; et < 4; ++et) { const bf16x8 vf = cat8(trread(vbuf + (32 * kp + 4 * g + q4) * VROW + 32 * et + 8 * p4), trread(vbuf + (32 * kp + 16 + 4 * g + q4) * VROW + 32 * et + 8 * p4));
                        nd[et] = mfma16(vf, pfr[kp], nd[et]); nd[et] = mfma16(cfr[dir][et][kp], qsc, nd[et]); }
                    { const short one = r16 == 0 ? (short)0x3F80 : (short)0; const bf16x8 of = {one, one, one, one, one, one, one, one}; nd[4] = mfma16(of, pfr[kp], nd[4]); }
                    { bf16x8 nf = {0, 0, 0, 0, 0, 0, 0, 0}; if (r16 == 0) nf = *(const LAS bf16x8*)(ntab + dir * 128 + 64 * kp + 16 * g); nd[4] = mfma16(nf, qsc, nd[4]); }
                }
                const float den = shi(nd[4][0], r16);
                const float inv = 1.f / fmaxf(fabsf(den), flt);
#pragma unroll
                for (int et = 0; et < 4; ++et) hs[et] += nd[et] * inv;
            }
            float ss = 0.f;
#pragma unroll
            for (int et = 0; et < 4; ++et) ss += (hs[et][0] * hs[et][0] + hs[et][1] * hs[et][1]) + (hs[et][2] * hs[et][2] + hs[et][3] * hs[et][3]);
            ss += shx(ss, 16, lane); ss += shx(ss, 32, lane);
            const float rn = 1.f / sqrtf(ss * (1.f / 64.f) + EPS);
            bf16_t* zr = zb + (size_t)(s + tau) * ZLD;
#pragma unroll
            for (int et = 0; et < 4; ++et) { const int e0 = 64 * h + 16 * et + 4 * g;
                const u32x2 ov = *(const u32x2*)(zr + OC + e0); const f32x4 ng = *(const f32x4*)(P.mlstm_norm + l * 384 + e0);
                const float y0 = hs[et][0] * rn * ng[0] * sigmoidf_(bflo(ov.x)), y1 = hs[et][1] * rn * ng[1] * sigmoidf_(bfhi(ov.x));
                const float y2 = hs[et][2] * rn * ng[2] * sigmoidf_(bflo(ov.y)), y3 = hs[et][3] * rn * ng[3] * sigmoidf_(bfhi(ov.y));
                u32x2 w; w.x = pk2(y0, y1); w.y = pk2(y2, y3); *(u32x2*)(zr + QC + e0) = w; }
        }
        WAVE_LDS_FENCE();
    }
}

#ifndef PROBE_MODE
#define PROBE_MODE 0
#endif
#ifndef SKIP_ATTN
#define SKIP_ATTN 0
#endif
#ifndef SKIP_MLSTM
#define SKIP_MLSTM 0
#endif

__global__ void __launch_bounds__(512, 2) fwd_kernel(KParams P) {
    extern __shared__ __attribute__((aligned(16))) unsigned char lds_raw[];
    LAS unsigned char* lds = (LAS unsigned char*)lds_raw;
    cg::grid_group grid = cg::this_grid();
#if PROBE_MODE == 4
#define GSYNC() do { grid.sync(); grid.sync(); } while (0)
#else
#define GSYNC() grid.sync()
#endif
    const int G = gridDim.x, bx = blockIdx.x;
    if (G != 256) return;
    const int pm0 = (bx & 7) * 32 + (bx >> 3);
#define FRESH_IDS int tid = threadIdx.x; asm volatile("" : "+v"(tid)); const int lane = tid & 63, wave = __builtin_amdgcn_readfirstlane(tid >> 6); int pm = pm0; asm volatile("" : "+s"(pm)); (void)lane; (void)wave; (void)pm;
#define WSP() ({ __attribute__((address_space(1))) unsigned char* w_ = (__attribute__((address_space(1))) unsigned char*)P.ws; asm volatile("" : "+s"(w_)); (unsigned char*)w_; })
#define Wall ((bf16_t*)(WSP() + WS_W))
#define PB ((bf16_t*)(WSP() + WS_PB))
#define gates ((float*)(WSP() + WS_GATES))
#define rs ((float*)(WSP() + WS_RS))
#define XBA ((bf16_t*)(WSP() + WS_XBA))
#define XBB ((bf16_t*)(WSP() + WS_XBB))
#define Z ((bf16_t*)(WSP() + WS_Z))
    LAS float* ssq = (LAS float*)(lds + SSQ_OFF);
#define ZERO_SSQ() do { FRESH_IDS; if (tid < 256) { *(LAS f32x4*)(ssq + tid * 4) = zero4(); } } while (0)
#define WRITE_RS() do { FRESH_IDS; if (tid < 256) { const float s_ = (ssq[tid * 4] + ssq[tid * 4 + 1]) + (ssq[tid * 4 + 2] + ssq[tid * 4 + 3]); rs[pm * 256 + tid] = 1.f / sqrtf(s_ * (1.f / DM) + EPS); } } while (0)

#if PROBE_MODE == 3
    { FRESH_IDS;
      prep_weights(P, lds, bx * 8 + wave, G * 8, wave, lane);
      for (int rr = wave; rr < 256; rr += 8) { const size_t row = (size_t)pm * 256 + rr;
        const f32x4* xr = (const f32x4*)(P.x + row * DM) + lane; f32x4 v[4]; float s = 0.f;
#pragma unroll
        for (int j = 0; j < 4; ++j) { v[j] = xr[64 * j]; s += (v[j][0] * v[j][0] + v[j][1] * v[j][1]) + (v[j][2] * v[j][2] + v[j][3] * v[j][3]); }
        s = wave_sum(s, lane);
        u32x2* o = (u32x2*)(XBA + row * DM) + lane;
#pragma unroll
        for (int j = 0; j < 4; ++j) { u32x2 w; w.x = pk2(v[j][0], v[j][1]); w.y = pk2(v[j][2], v[j][3]); o[64 * j] = w; }
        if (lane == 0) rs[row] = 1.f / sqrtf(s * (1.f / DM) + EPS); } }
    __syncthreads();
#endif
    { FRESH_IDS;
      prep_weights(P, lds, bx * 8 + wave, G * 8, wave, lane);
      for (int rr = wave; rr < 256; rr += 8) { const size_t row = (size_t)pm * 256 + rr;
        const f32x4* xr = (const f32x4*)(P.x + row * DM) + lane; f32x4 v[4]; float s = 0.f;
#pragma unroll
        for (int j = 0; j < 4; ++j) { v[j] = xr[64 * j]; s += (v[j][0] * v[j][0] + v[j][1] * v[j][1]) + (v[j][2] * v[j][2] + v[j][3] * v[j][3]); }
        s = wave_sum(s, lane);
        u32x2* o = (u32x2*)(XBA + row * DM) + lane;
#pragma unroll
        for (int j = 0; j < 4; ++j) { u32x2 w; w.x = pk2(v[j][0], v[j][1]); w.y = pk2(v[j][2], v[j][3]); o[64 * j] = w; }
        if (lane == 0) rs[row] = 1.f / sqrtf(s * (1.f / DM) + EPS); } }
    GSYNC();

    for (int l = 0; l < DEPTH; ++l) {
        bf16_t* Wl = Wall + (size_t)l * LAYER_W;
        { pg8::Gemm g{XBA, Wl + OFF_WIN, DM, DM}; pg8::RowOrder S{pm0, NIN_PAD / 256}; pg8::EpiZ E{Z, gates, rs};
          pg8::gemm_phase<pg8::EpiZ, pg8::RowOrder>(lds, g, S, E);
#if PROBE_MODE == 2
          pg8::gemm_phase<pg8::EpiZ, pg8::RowOrder>(lds, g, S, E);
#endif
          }
        GSYNC();
#if PROBE_MODE == 1 || PROBE_MODE == 6
        { FRESH_IDS; build_lut(P, lds, tid); __syncthreads(); attention_phase(P, lds, l, pm, wave, lane, P.out == nullptr); __syncthreads(); }
#endif
#if PROBE_MODE == 1 || PROBE_MODE == 7
        { FRESH_IDS; mlstm_state_phase(P, lds, l, pm, wave, lane); __syncthreads(); }
#endif
        if (!SKIP_ATTN) { FRESH_IDS;
            build_lut(P, lds, tid);
            __syncthreads();
            attention_phase(P, lds, l, pm, wave, lane);
        }
        __syncthreads();
        if (!SKIP_MLSTM) { FRESH_IDS; mlstm_state_phase(P, lds, l, pm, wave, lane); }
        GSYNC();
#if PROBE_MODE == 1 || PROBE_MODE == 8
        { FRESH_IDS; mlstm_scan_phase(P, lds, bx, G, tid, P.out == nullptr); }
#endif
        if (!SKIP_MLSTM) { FRESH_IDS; mlstm_scan_phase(P, lds, bx, G, tid); }
        GSYNC();
#if PROBE_MODE == 1 || PROBE_MODE == 9
        { FRESH_IDS; mlstm_out_phase(P, lds, l, pm, wave, lane); __syncthreads(); }
#endif
        if (!SKIP_MLSTM) { FRESH_IDS; mlstm_out_phase(P, lds, l, pm, wave, lane); }
        ZERO_SSQ();
        LOCAL_SEAM();
#if PROBE_MODE == 5
        { pg8::Gemm g{Z, Wl + OFF_WOUT, ZLD, DM}; pg8::RowOrder S{pm0, 4}; pg8::EpiResid<false> E{XBA, XBA, nullptr, ssq, (P.out == nullptr)};
          pg8::gemm_phase<pg8::EpiResid<false>, pg8::RowOrder>(lds, g, S, E); }
        __syncthreads();
#endif
        { pg8::Gemm g{Z, Wl + OFF_WOUT, ZLD, DM}; pg8::RowOrder S{pm0, 4}; pg8::EpiResid<false> E{XBA, XBA, nullptr, ssq, true};
          pg8::gemm_phase<pg8::EpiResid<false>, pg8::RowOrder>(lds, g, S, E); }
        __syncthreads();
        WRITE_RS();
        LOCAL_SEAM();
        { pg8::Gemm g{XBA, Wl + OFF_WUP, DM, DM}; pg8::RowOrder S{pm0, NUP / 256}; pg8::EpiSwiGLU E{Z, rs};
          pg8::gemm_phase<pg8::EpiSwiGLU, pg8::RowOrder>(lds, g, S, E);
#if PROBE_MODE == 2
          pg8::gemm_phase<pg8::EpiSwiGLU, pg8::RowOrder>(lds, g, S, E);
#endif
          }
        ZERO_SSQ();
        LOCAL_SEAM();
#if PROBE_MODE == 5
        { pg8::Gemm g{Z + ACT_OFF, Wl + OFF_WDOWN, ZLD, DFF}; pg8::RowOrder S{pm0, 4}; pg8::EpiResid<false> E{XBA, XBB, nullptr, ssq, (P.out == nullptr)};
          pg8::gemm_phase<pg8::EpiResid<false>, pg8::RowOrder>(lds, g, S, E); }
        __syncthreads();
#endif
        { pg8::Gemm g{Z + ACT_OFF, Wl + OFF_WDOWN, ZLD, DFF}; pg8::RowOrder S{pm0, 4}; pg8::EpiResid<false> E{XBA, XBB, nullptr, ssq, true};
          pg8::gemm_phase<pg8::EpiResid<false>, pg8::RowOrder>(lds, g, S, E); }
        { FRESH_IDS;
          for (int rr = wave; rr < 256; rr += 8) { const size_t row = (size_t)pm * 256 + rr;
            const f32x4 v = *((const f32x4*)(P.p + ((size_t)l * MTOK + row) * PLE) + lane); u32x2 w; w.x = pk2(v[0], v[1]); w.y = pk2(v[2], v[3]); *((u32x2*)(PB + row * PLE) + lane) = w; } }
        LOCAL_SEAM();
        { pg8::Gemm g{XBB, Wl + OFF_WG, DM, DM}; pg8::RowOrder S{pm0, 4}; pg8::EpiSigmoid E{Z};
          pg8::gemm_phase<pg8::EpiSigmoid, pg8::RowOrder>(lds, g, S, E);
#if PROBE_MODE == 2
          pg8::gemm_phase<pg8::EpiSigmoid, pg8::RowOrder>(lds, g, S, E);
#endif
          }
        ZERO_SSQ();
        LOCAL_SEAM();
#if PROBE_MODE == 5
        { pg8::Gemm g{PB, Wl + OFF_WP, PLE, PLE}; pg8::RowOrder S{pm0, 4}; pg8::EpiResid<true> E{XBB, XBA, Z, ssq, (P.out == nullptr)};
          pg8::gemm_phase<pg8::EpiResid<true>, pg8::RowOrder>(lds, g, S, E); }
        __syncthreads();
#endif
        { pg8::Gemm g{PB, Wl + OFF_WP, PLE, PLE}; pg8::RowOrder S{pm0, 4}; pg8::EpiResid<true> E{XBB, XBA, Z, ssq, true};
          pg8::gemm_phase<pg8::EpiResid<true>, pg8::RowOrder>(lds, g, S, E); }
        __syncthreads();
        WRITE_RS();
        LOCAL_SEAM();
    }
    { FRESH_IDS;
      for (int rr = wave; rr < 256; rr += 8) { const size_t row = (size_t)pm * 256 + rr; const float sc = rs[row];
        const u32x2* xr = (const u32x2*)(XBA + row * DM) + lane; f32x4* orow = (f32x4*)(P.out + row * DM) + lane; const f32x4* gr = (const f32x4*)P.final_norm + lane;
#pragma unroll
        for (int j = 0; j < 4; ++j) { const u32x2 v = xr[64 * j]; const f32x4 gg = gr[64 * j]; orow[64 * j] = (f32x4){bflo(v.x) * sc * gg[0], bfhi(v.x) * sc * gg[1], bflo(v.y) * sc * gg[2], bfhi(v.y) * sc * gg[3]}; } } }
}

extern "C" void kernel_launch(void* const* d_in, const int* in_sizes, int n_in, void* d_out, int out_size, void* d_ws, size_t ws_size, hipStream_t stream) {
    static int ready = 0;
    if (ready == 0) {
        if (n_in != 16 || out_size != MTOK * DM || ws_size < WS_END) { fprintf(stderr, "kernel_launch: unexpected sizes (n_in %d, out %d, ws %zu)\n", n_in, out_size, ws_size); ready = -1; return; }
        if (hipFuncSetAttribute((const void*)fwd_kernel, hipFuncAttributeMaxDynamicSharedMemorySize, LDS_BYTES) != hipSuccess) { fprintf(stderr, "kernel_launch: hipFuncSetAttribute failed\n"); ready = -1; return; }
        int dev = 0, cus = 0, per_cu = 0;
        (void)hipGetDevice(&dev); (void)hipDeviceGetAttribute(&cus, hipDeviceAttributeMultiprocessorCount, dev);
        (void)hipOccupancyMaxActiveBlocksPerMultiprocessor(&per_cu, (const void*)fwd_kernel, 512, LDS_BYTES);
        if (cus != 256 || per_cu < 1) fprintf(stderr, "kernel_launch: note: %d CUs, %d blocks/CU (kernel expects 256 x 1)\n", cus, per_cu);
        (void)hipGetLastError();
        ready = 1;
    }
    if (ready < 0) return;
    KParams P{};
    P.x = (const float*)d_in[0]; P.p = (const float*)d_in[1]; P.rel_bias = (const float*)d_in[2]; P.attn_norm = (const float*)d_in[3]; P.w_in = (const float*)d_in[4];
    P.qk_conv = (const float*)d_in[5]; P.gate_bias = (const float*)d_in[6]; P.sink = (const float*)d_in[7]; P.mlstm_norm = (const float*)d_in[8]; P.w_out = (const float*)d_in[9];
    P.ffn_norm = (const float*)d_in[10]; P.w_up = (const float*)d_in[11]; P.w_down = (const float*)d_in[12]; P.ple_proj = (const float*)d_in[13]; P.ple_gate = (const float*)d_in[14];
    P.final_norm = (const float*)d_in[15]; P.out = (float*)d_out; P.ws = (unsigned char*)d_ws;
    void* args[] = {&P};
    hipError_t e = hipLaunchCooperativeKernel((const void*)fwd_kernel, dim3(256), dim3(512), args, LDS_BYTES, stream);
    if (e != hipSuccess) fprintf(stderr, "kernel_launch: cooperative launch failed: %s\n", hipGetErrorString(e));
}
```

```cpp
#include <hip/hip_runtime.h>
#include <hip/hip_cooperative_groups.h>
#include <cstdio>
#include <cstdint>
namespace cg = cooperative_groups;

#define LAS __attribute__((address_space(3)))
#define DI __device__ __forceinline__
typedef unsigned short bf16_t;
typedef short bf16x8 __attribute__((ext_vector_type(8)));
typedef short s16x4 __attribute__((ext_vector_type(4)));
typedef float f32x4 __attribute__((ext_vector_type(4)));
typedef float f32x2 __attribute__((ext_vector_type(2)));
typedef unsigned u32x4 __attribute__((ext_vector_type(4)));
typedef unsigned u32x2 __attribute__((ext_vector_type(2)));
typedef __bf16 bf16v2 __attribute__((ext_vector_type(2)));

constexpr int NB = 8, SEQ = 8192, DM = 1024, DEPTH = 4, MTOK = NB * SEQ;
constexpr int ZLD = 3200, NIN_PAD = 3328, DFF = 2816, NUP = 2 * DFF, PLE = 256, DIN = 3224;
constexpr int QA = 0, QB = 384, QC = 640, KA = 1024, KB = 1408, KC = 1536, VA = 1920, VB = 2304, VC = 2432, OC = 2816;
constexpr int ACT_OFF = 384;
constexpr float LOG2E = 1.4426950408889634f;
constexpr float QSCALE = 0.125f * LOG2E;
constexpr float EPS = 1e-6f;
constexpr float NEGBIG = -1e30f;
constexpr int NSEQ = 2 * NB * 6, NCH = SEQ / 64;

constexpr size_t OFF_WIN = 0, OFF_WOUT = OFF_WIN + (size_t)NIN_PAD * DM, OFF_WUP = OFF_WOUT + (size_t)DM * DM, OFF_WDOWN = OFF_WUP + (size_t)NUP * DM,
                 OFF_WP = OFF_WDOWN + (size_t)DM * DFF, OFF_WG = OFF_WP + (size_t)DM * PLE, LAYER_W = OFF_WG + (size_t)DM * DM;
constexpr size_t MiB = 1u << 20;
constexpr size_t WS_W = 1 * MiB, WS_PB = 112 * MiB, WS_GATES = 144 * MiB, WS_RS = 150 * MiB, WS_NB = 151 * MiB, WS_ML = 153 * MiB, WS_BL = WS_ML + 256 * 1024,
                 WS_MP = WS_ML + 512 * 1024, WS_QCONV = 154 * MiB, WS_KCONV = 202 * MiB, WS_XBA = 250 * MiB, WS_XBB = 378 * MiB, WS_Z = 506 * MiB, WS_CT = 906 * MiB,
                 WS_END = 1002 * MiB;
static_assert(WS_W + 4 * LAYER_W * 2 <= WS_PB, "weights");
static_assert(WS_Z + (size_t)MTOK * ZLD * 2 <= WS_CT, "z");
static_assert(WS_CT + (size_t)NSEQ * NCH * 4096 * 2 <= WS_END, "ct");

constexpr int LDS_BYTES = 155648;
constexpr int RING_BYTES = 131072, SSQ_OFF = 131072, RSL_OFF = 151552;

DI unsigned pk2(float lo, float hi) { f32x2 v = {lo, hi}; bf16v2 b = __builtin_convertvector(v, bf16v2); return __builtin_bit_cast(unsigned, b); }
DI float bf2f(unsigned short u) { return __uint_as_float(((unsigned)u) << 16); }
DI float bflo(unsigned u) { return __uint_as_float(u << 16); }
DI float bfhi(unsigned u) { return __uint_as_float(u & 0xffff0000u); }
DI float ex2(float x) { return __builtin_amdgcn_exp2f(x); }
DI float fexp(float x) { return __builtin_amdgcn_exp2f(x * LOG2E); }
DI float frcp(float x) { return __builtin_amdgcn_rcpf(x); }
DI float sigmoidf_(float x) { return frcp(1.f + fexp(-x)); }
DI f32x4 mfma16(bf16x8 a, bf16x8 b, f32x4 c) { return __builtin_amdgcn_mfma_f32_16x16x32_bf16(a, b, c, 0, 0, 0); }
DI f32x4 zero4() { float z; asm volatile("v_mov_b32 %0, 0" : "=v"(z)); return (f32x4){z, z, z, z}; }
DI s16x4 trread(LAS unsigned char* p) { return __builtin_amdgcn_ds_read_tr16_b64_v4i16((LAS s16x4*)p); }
DI bf16x8 cat8(s16x4 a, s16x4 b) { return __builtin_shufflevector(a, b, 0, 1, 2, 3, 4, 5, 6, 7); }
DI float shx(float v, int mask, int lane) { return __builtin_bit_cast(float, __builtin_amdgcn_ds_bpermute((lane ^ mask) << 2, __builtin_bit_cast(int, v))); }
DI float shi(float v, int idx) { return __builtin_bit_cast(float, __builtin_amdgcn_ds_bpermute(idx << 2, __builtin_bit_cast(int, v))); }
DI float xmax4(float v) {
    const unsigned x = __builtin_bit_cast(unsigned, v);
    const auto r = __builtin_amdgcn_permlane16_swap(x, x, false, false); unsigned r0 = r[0], r1 = r[1]; asm volatile("" : "+v"(r0), "+v"(r1));
    const float a = __builtin_bit_cast(float, r0), b = __builtin_bit_cast(float, r1); const float c = a > b ? a : b;
    const unsigned y = __builtin_bit_cast(unsigned, c);
    const auto q = __builtin_amdgcn_permlane32_swap(y, y, false, false); unsigned q0 = q[0], q1 = q[1]; asm volatile("" : "+v"(q0), "+v"(q1));
    const float d = __builtin_bit_cast(float, q0), e = __builtin_bit_cast(float, q1); return d > e ? d : e;
}
DI float xsum4(float v) {
    const unsigned x = __builtin_bit_cast(unsigned, v);
    const auto r = __builtin_amdgcn_permlane16_swap(x, x, false, false); unsigned r0 = r[0], r1 = r[1]; asm volatile("" : "+v"(r0), "+v"(r1));
    const float c = __builtin_bit_cast(float, r0) + __builtin_bit_cast(float, r1);
    const unsigned y = __builtin_bit_cast(unsigned, c);
    const auto q = __builtin_amdgcn_permlane32_swap(y, y, false, false); unsigned q0 = q[0], q1 = q[1]; asm volatile("" : "+v"(q0), "+v"(q1));
    return __builtin_bit_cast(float, q0) + __builtin_bit_cast(float, q1);
}
DI int lane_id_asm() { int l_; asm volatile("v_mbcnt_lo_u32_b32 %0, -1, 0\n\tv_mbcnt_hi_u32_b32 %0, -1, %0" : "=v"(l_)); return l_; }
#define WAVE_LDS_FENCE() asm volatile("s_waitcnt lgkmcnt(0)" ::: "memory")
#define LOCAL_SEAM() do { asm volatile("s_waitcnt vmcnt(0) lgkmcnt(0)" ::: "memory"); __syncthreads(); __builtin_amdgcn_fence(__ATOMIC_ACQUIRE, "workgroup"); } while (0)

namespace pg8 {
constexpr int BM = 256, BK = 64, HALF = 128, HTB = HALF * BK * 2, STAGE_BYTES = 8 * HTB;
DI int lds_byte(int r, int c) { const int st = (r >> 4) * 2 + (c >> 5), rr = r & 15, cc = c & 31, ob = rr * 64 + cc * 2; return st * 1024 + (ob ^ (((ob >> 9) & 1) << 5)); }
DI void stage_rc(int b, int& R, int& C) { const int st = b / 1024, sb = b % 1024, swz = sb ^ (((sb >> 9) & 1) << 5); R = (st >> 1) * 16 + swz / 64; C = (st & 1) * 32 + (swz % 64) / 2; }
DI int perm32(int rho) { const int n = rho >> 4, i = rho & 15; return 8 * (i >> 2) + 4 * n + (i & 3); }
struct Unit { int pm, pn; };
struct Gemm { const bf16_t* A; const bf16_t* Bt; int lda, K, wave; };
struct RowOrder {
    int pm, nN;
    DI bool next(int i, Unit& u) const { if (i >= nN) return false; u.pm = pm; u.pn = i; return true; }
};

template <class Epi, class Sched>
DI void gemm_phase(LAS unsigned char* lds, const Gemm g, const Sched& S, const Epi& E) {
    int tid = g.wave * 64 + lane_id_asm(); asm volatile("" : "+v"(tid));
    const int wid = __builtin_amdgcn_readfirstlane(tid >> 6), lane = tid & 63, wr = wid >> 2, wc = wid & 3, fr = lane & 15, fq = lane >> 4;
    const int K = g.K, nt = K / BK, lda = g.lda;
    unsigned voffA[2], voffB[2];
#pragma unroll
    for (int i = 0; i < 2; ++i) { int R, C; stage_rc(tid * 16 + i * 8192, R, C); const int Rb = Epi::PERM ? ((R & ~31) + perm32(R & 31)) : R;
        voffA[i] = (unsigned)(R * lda + C) * 2u; voffB[i] = (unsigned)(Rb * K + C) * 2u; }
    const size_t kstep = (size_t)(BK * 2);
    const size_t hsA = (size_t)HALF * lda * 2, hsB = (size_t)HALF * K * 2;
    const size_t tsA = 2 * hsA, tsB = 2 * hsB;
    const unsigned ldsw = (unsigned)wid * 1024u;
    const int aoff = lds_byte(wr * 64 + fr, fq * 8), boff = lds_byte(wc * 32 + fr, fq * 8);
#define PG8_SA(b, h) (((b) * 2 + (h)) * HTB)
#define PG8_SB(b, h) ((4 + (b) * 2 + (h)) * HTB)
#define PG8_STAGE(bufoff, gbase, voff) do { _Pragma("unroll") for (int _i = 0; _i < 2; ++_i) \
        __builtin_amdgcn_global_load_lds((const unsigned*)((const char*)(gbase) + (voff)[_i]), (LAS unsigned*)(lds + (bufoff) + ldsw + _i * 8192), 16, 0, 0); } while (0)
#define PG8_LDA(dst, b, h) do { _Pragma("unroll") for (int m = 0; m < 4; ++m) _Pragma("unroll") for (int k = 0; k < 2; ++k) dst[m][k] = *(const LAS bf16x8*)(lds + PG8_SA(b, h) + aoff + m * 2048 + k * 1024); } while (0)
#define PG8_LDB(dst, b, h) do { _Pragma("unroll") for (int n = 0; n < 2; ++n) _Pragma("unroll") for (int k = 0; k < 2; ++k) dst[n][k] = *(const LAS bf16x8*)(lds + PG8_SB(b, h) + boff + n * 2048 + k * 1024); } while (0)
#define PG8_MMA(ai, bj, At, Bt) do { __builtin_amdgcn_s_setprio(1); _Pragma("unroll") for (int m = 0; m < 4; ++m) _Pragma("unroll") for (int n = 0; n < 2; ++n) _Pragma("unroll") for (int k = 0; k < 2; ++k) \
        acc[ai][bj][m][n] = __builtin_amdgcn_mfma_f32_16x16x32_bf16(Bt[n][k], At[m][k], acc[ai][bj][m][n], 0, 0, 0); __builtin_amdgcn_s_setprio(0); } while (0)
#define PG8_WAIT_V(n) asm volatile("s_waitcnt vmcnt(" #n ")" ::: "memory")
#define PG8_WAIT_L(n) asm volatile("s_waitcnt lgkmcnt(" #n ")" ::: "memory")
#define PG8_WAIT_VSEL(sel) do { if constexpr (Epi::NST == 16) asm volatile("s_cmp_eq_u32 %0, 0\n\ts_cbranch_scc1 .Lws%=\n\ts_waitcnt vmcnt(24)\n\ts_branch .Lwe%=\n.Lws%=:\n\ts_waitcnt vmcnt(8)\n.Lwe%=:" :: "s"(sel) : "scc", "memory"); \
    else asm volatile("s_cmp_eq_u32 %0, 0\n\ts_cbranch_scc1 .Lws%=\n\ts_waitcnt vmcnt(16)\n\ts_branch .Lwe%=\n.Lws%=:\n\ts_waitcnt vmcnt(8)\n.Lwe%=:" :: "s"(sel) : "scc", "memory"); } while (0)
#define PG8_BAR __builtin_amdgcn_s_barrier()
#define PG8_SCHED __builtin_amdgcn_sched_barrier(0)
    Unit cur, nxt; int ui = 0;
    if (!S.next(0, cur)) return;
    f32x4 acc[2][2][4][2];
    { float z0; asm volatile("v_mov_b32 %0, 0" : "=v"(z0));
#pragma unroll
    for (int a = 0; a < 2; ++a)
#pragma unroll
        for (int b = 0; b < 2; ++b)
#pragma unroll
            for (int m = 0; m < 4; ++m)
#pragma unroll
                for (int n = 0; n < 2; ++n) acc[a][b][m][n] = (f32x4){z0, z0, z0, z0}; }
    bf16x8 At[4][2], B0[2][2], B1[2][2];
    const char* cA = (const char*)g.A + (size_t)cur.pm * tsA; const char* cB = (const char*)g.Bt + (size_t)cur.pn * tsB;
    PG8_STAGE(PG8_SB(0, 0), cB, voffB); PG8_STAGE(PG8_SB(0, 1), cB + hsB, voffB); PG8_STAGE(PG8_SA(0, 0), cA, voffA); PG8_STAGE(PG8_SA(0, 1), cA + hsA, voffA);
    if (wr == 1) PG8_BAR;
    PG8_WAIT_V(2); PG8_BAR;
    PG8_STAGE(PG8_SB(1, 0), cB + kstep, voffB); PG8_STAGE(PG8_SA(1, 0), cA + kstep, voffA); PG8_STAGE(PG8_SB(1, 1), cB + hsB + kstep, voffB);
    PG8_WAIT_V(6); PG8_BAR;
    for (;;) {
        const bool has_next = S.next(ui + 1, nxt);
        const char* nA = has_next ? (const char*)g.A + (size_t)nxt.pm * tsA : cA; const char* nB = has_next ? (const char*)g.Bt + (size_t)nxt.pn * tsB : cB;
        for (int t = 0; t < nt; t += 2) {
            const bool last = (t == nt - 2);
            const int relax = ((t == 0) && (ui > 0)) ? 1 : 0;
            const char* a1 = cA + (size_t)(t + 1) * kstep;
            const char* a2 = last ? nA : cA + (size_t)(t + 2) * kstep; const char* b2 = last ? nB : cB + (size_t)(t + 2) * kstep;
            const char* a3 = a2 + kstep; const char* b3 = b2 + kstep;
            PG8_LDB(B0, 0, 0); PG8_LDB(B1, 0, 1); PG8_SCHED; PG8_LDA(At, 0, 0); PG8_STAGE(PG8_SA(1, 1), a1 + hsA, voffA);
            PG8_WAIT_VSEL(__builtin_amdgcn_readfirstlane(relax)); PG8_WAIT_L(0); PG8_BAR; PG8_MMA(0, 0, At, B0); PG8_MMA(0, 1, At, B1); PG8_BAR; PG8_SCHED;
            PG8_LDA(At, 0, 1); PG8_STAGE(PG8_SB(0, 0), b2, voffB); PG8_STAGE(PG8_SB(0, 1), b2 + hsB, voffB); PG8_STAGE(PG8_SA(0, 0), a2, voffA);
            PG8_WAIT_VSEL(__builtin_amdgcn_readfirstlane(relax)); PG8_WAIT_L(0); PG8_BAR; PG8_MMA(1, 0, At, B0); PG8_MMA(1, 1, At, B1); PG8_BAR; PG8_SCHED;
            PG8_LDB(B0, 1, 0); PG8_LDB(B1, 1, 1); PG8_SCHED; PG8_LDA(At, 1, 0); PG8_STAGE(PG8_SA(0, 1), a2 + hsA, voffA);
            PG8_WAIT_V(8); PG8_WAIT_L(0); PG8_BAR; PG8_MMA(0, 0, At, B0); PG8_MMA(0, 1, At, B1); PG8_BAR; PG8_SCHED;
            PG8_LDA(At, 1, 1); PG8_STAGE(PG8_SB(1, 0), b3, voffB); PG8_STAGE(PG8_SB(1, 1), b3 + hsB, voffB); PG8_STAGE(PG8_SA(1, 0), a3, voffA);
            PG8_WAIT_V(8); PG8_WAIT_L(0); PG8_BAR; PG8_MMA(1, 0, At, B0); PG8_MMA(1, 1, At, B1); PG8_BAR; PG8_SCHED;
        }
        if (wr == 0) PG8_BAR;
        E(acc, cur, wr, wc, fr, fq);
        if (!has_next) break;
        { float z0; asm volatile("v_mov_b32 %0, 0" : "=v"(z0));
#pragma unroll
        for (int a = 0; a < 2; ++a)
#pragma unroll
            for (int b = 0; b < 2; ++b)
#pragma unroll
                for (int m = 0; m < 4; ++m)
#pragma unroll
                    for (int n = 0; n < 2; ++n) acc[a][b][m][n] = (f32x4){z0, z0, z0, z0}; }
        cur = nxt; cA = nA; cB = nB; ++ui;
        if (wr == 1) PG8_BAR;
    }
    PG8_WAIT_V(0);
    PG8_BAR;
#undef PG8_SA
#undef PG8_SB
#undef PG8_STAGE
#undef PG8_LDA
#undef PG8_LDB
#undef PG8_MMA
#undef PG8_WAIT_V
#undef PG8_WAIT_L
#undef PG8_WAIT_VSEL
#undef PG8_BAR
#undef PG8_SCHED
}

struct EpiZ {
    static constexpr bool PERM = true; static constexpr int NST = 16;
    bf16_t* Z; float* gates; const LAS float* rs;
    DI void operator()(const f32x4 (&acc)[2][2][4][2], const Unit& u, int wr, int wc, int fr, int fq) const {
        asm volatile("" : "+v"(fr), "+v"(fq));
        const int row0 = u.pm * BM + wr * 64 + fr, col0 = u.pn * BM + wc * 32 + 8 * fq;
#pragma unroll
        for (int ai = 0; ai < 2; ++ai)
#pragma unroll
            for (int m = 0; m < 4; ++m) { const int row = row0 + ai * HALF + m * 16; const float sc = rs[row - u.pm * BM];
#pragma unroll
                for (int bj = 0; bj < 2; ++bj) { const int col = col0 + bj * HALF; const f32x4 v0 = acc[ai][bj][m][0] * sc, v1 = acc[ai][bj][m][1] * sc;
                    if (col < ZLD) { u32x4 w; w.x = pk2(v0[0], v0[1]); w.y = pk2(v0[2], v0[3]); w.z = pk2(v1[0], v1[1]); w.w = pk2(v1[2], v1[3]); __builtin_nontemporal_store(w, (u32x4*)(Z + (size_t)row * ZLD + col)); }
                    else if (col < DIN) { float* gp = gates + (size_t)row * 24 + (col - ZLD); *(f32x4*)gp = v0; *(f32x4*)(gp + 4) = v1; } }
                asm volatile("" ::: "memory"); }
    }
};
struct EpiSwiGLU {
    static constexpr bool PERM = true; static constexpr int NST = 8;
    bf16_t* Z; const LAS float* rs;
    DI void operator()(const f32x4 (&acc)[2][2][4][2], const Unit& u, int wr, int wc, int fr, int fq) const {
        asm volatile("" : "+v"(fr), "+v"(fq));
        const int row0 = u.pm * BM + wr * 64 + fr, col0 = ACT_OFF + u.pn * HALF + wc * 32 + 8 * fq;
#pragma unroll
        for (int ai = 0; ai < 2; ++ai)
#pragma unroll
            for (int m = 0; m < 4; ++m) { const int row = row0 + ai * HALF + m * 16; const float sc = rs[row - u.pm * BM]; float o[8];
#pragma unroll
                for (int n = 0; n < 2; ++n)
#pragma unroll
                    for (int i = 0; i < 4; ++i) { const float gg = acc[ai][0][m][n][i] * sc, uu = acc[ai][1][m][n][i] * sc; o[4 * n + i] = gg * sigmoidf_(gg) * uu; }
                u32x4 w; w.x = pk2(o[0], o[1]); w.y = pk2(o[2], o[3]); w.z = pk2(o[4], o[5]); w.w = pk2(o[6], o[7]);
                __builtin_nontemporal_store(w, (u32x4*)(Z + (size_t)row * ZLD + col0));
                asm volatile("" ::: "memory"); }
    }
};
struct EpiSigmoid {
    static constexpr bool PERM = true; static constexpr int NST = 16;
    bf16_t* Z;
    DI void operator()(const f32x4 (&acc)[2][2][4][2], const Unit& u, int wr, int wc, int fr, int fq) const {
        asm volatile("" : "+v"(fr), "+v"(fq));
        const int row0 = u.pm * BM + wr * 64 + fr, col0 = u.pn * BM + wc * 32 + 8 * fq;
#pragma unroll
        for (int ai = 0; ai < 2; ++ai)
#pragma unroll
            for (int m = 0; m < 4; ++m) { const int row = row0 + ai * HALF + m * 16;
#pragma unroll
                for (int bj = 0; bj < 2; ++bj) { const f32x4 v0 = acc[ai][bj][m][0], v1 = acc[ai][bj][m][1]; u32x4 w;
                    w.x = pk2(sigmoidf_(v0[0]), sigmoidf_(v0[1])); w.y = pk2(sigmoidf_(v0[2]), sigmoidf_(v0[3])); w.z = pk2(sigmoidf_(v1[0]), sigmoidf_(v1[1])); w.w = pk2(sigmoidf_(v1[2]), sigmoidf_(v1[3]));
                    *(u32x4*)(Z + (size_t)row * ZLD + col0 + bj * HALF) = w; }
                asm volatile("" ::: "memory"); }
    }
};
template <bool MUL> struct EpiResid {
    static constexpr bool PERM = true; static constexpr int NST = 16;
    static constexpr int GM = MUL ? 2 : 4;
    const bf16_t* resid; bf16_t* xb; const bf16_t* mul; LAS float* ssq; bool wr_en;
    DI void operator()(const f32x4 (&acc)[2][2][4][2], const Unit& u, int wr, int wc, int fr, int fq) const {
        asm volatile("" : "+v"(fr), "+v"(fq));
        const int col0 = u.pn * BM + wc * 32 + 8 * fq;
#pragma unroll
        for (int ai = 0; ai < 2; ++ai)
#pragma unroll
            for (int mg = 0; mg < 4; mg += GM) {
                u32x4 rv[GM][2], mv[GM][2];
#pragma unroll
                for (int mm = 0; mm < GM; ++mm) { const size_t row = (size_t)(u.pm * BM + ai * HALF + wr * 64 + (mg + mm) * 16 + fr);
#pragma unroll
                    for (int bj = 0; bj < 2; ++bj) { const int col = col0 + bj * HALF; rv[mm][bj] = *(const u32x4*)(resid + row * DM + col);
                        if (MUL) mv[mm][bj] = *(const u32x4*)(mul + row * ZLD + col); } }
#pragma unroll
                for (int mm = 0; mm < GM; ++mm) { const int m = mg + mm; const int rl = ai * HALF + wr * 64 + m * 16 + fr; const size_t row = (size_t)(u.pm * BM + rl); float s = 0.f;
#pragma unroll
                    for (int bj = 0; bj < 2; ++bj) { const int col = col0 + bj * HALF; f32x4 a0 = acc[ai][bj][m][0], a1 = acc[ai][bj][m][1];
                        if (MUL) { const u32x4 q = mv[mm][bj];
                            a0[0] *= bflo(q.x); a0[1] *= bfhi(q.x); a0[2] *= bflo(q.y); a0[3] *= bfhi(q.y); a1[0] *= bflo(q.z); a1[1] *= bfhi(q.z); a1[2] *= bflo(q.w); a1[3] *= bfhi(q.w); }
                        const u32x4 r = rv[mm][bj];
                        const f32x4 x0 = {bflo(r.x) + a0[0], bfhi(r.x) + a0[1], bflo(r.y) + a0[2], bfhi(r.y) + a0[3]};
                        const f32x4 x1 = {bflo(r.z) + a1[0], bfhi(r.z) + a1[1], bflo(r.w) + a1[2], bfhi(r.w) + a1[3]};
                        if (wr_en) { u32x4 w; w.x = pk2(x0[0], x0[1]); w.y = pk2(x0[2], x0[3]); w.z = pk2(x1[0], x1[1]); w.w = pk2(x1[2], x1[3]); *(u32x4*)(xb + row * DM + col) = w; }
                        s += ((x0[0] * x0[0] + x0[1] * x0[1]) + (x0[2] * x0[2] + x0[3] * x0[3])) + ((x1[0] * x1[0] + x1[1] * x1[1]) + (x1[2] * x1[2] + x1[3] * x1[3])); }
                    s = xsum4(s);
                    if (fq == 0 && wr_en) ssq[rl * 4 + wc] += s; }
                asm volatile("" ::: "memory"); }
    }
};
}

struct KParams {
    const float* x; const float* p; const float* rel_bias; const float* attn_norm; const float* w_in; const float* qk_conv; const float* gate_bias; const float* sink;
    const float* mlstm_norm; const float* w_out; const float* ffn_norm; const float* w_up; const float* w_down; const float* ple_proj; const float* ple_gate; const float* final_norm;
    float* out; unsigned char* ws;
};

struct TItem { const float* W; int K, Nsrc, n0, nv; const float* gk; float cs; bf16_t* WT; int dst_row0, k0; };
DI void ti_load(const TItem& t, int lane, f32x4 (&v)[8]) {
    const int n4 = (lane & 7) * 4, kr = lane >> 3;
#pragma unroll
    for (int i = 0; i < 8; ++i) { const int kk = kr + 8 * i; v[i] = (f32x4){0.f, 0.f, 0.f, 0.f};
        if (n4 < t.nv) v[i] = __builtin_nontemporal_load((const f32x4*)(t.W + (size_t)(t.k0 + kk) * t.Nsrc + t.n0 + n4)); }
}
DI void ti_finish(const TItem& t, int lane, const f32x4 (&v)[8], LAS float* scr) {
    const int n4 = (lane & 7) * 4, kr = lane >> 3;
#pragma unroll
    for (int i = 0; i < 8; ++i) { const int kk = kr + 8 * i; const float sc = t.gk ? t.gk[t.k0 + kk] * t.cs : t.cs;
        scr[kk * 33 + n4 + 0] = v[i][0] * sc; scr[kk * 33 + n4 + 1] = v[i][1] * sc; scr[kk * 33 + n4 + 2] = v[i][2] * sc; scr[kk * 33 + n4 + 3] = v[i][3] * sc; }
    WAVE_LDS_FENCE();
    const int c8 = lane & 7;
#pragma unroll
    for (int j = 0; j < 4; ++j) { const int n = (lane >> 3) + 8 * j; const LAS float* q = scr + (8 * c8) * 33 + n;
        u32x4 o; o.x = pk2(q[0 * 33], q[1 * 33]); o.y = pk2(q[2 * 33], q[3 * 33]); o.z = pk2(q[4 * 33], q[5 * 33]); o.w = pk2(q[6 * 33], q[7 * 33]);
        *(u32x4*)(t.WT + (size_t)(t.dst_row0 + n) * t.K + t.k0 + 8 * c8) = o; }
    WAVE_LDS_FENCE();
}
constexpr int IT_WIN = 16 * 104, IT_WOUT = 16 * 32, IT_WUP = 16 * 176, IT_WDOWN = 44 * 32, IT_WP = 4 * 32, IT_WG = 16 * 32;
constexpr int IT_LAYER = IT_WIN + IT_WOUT + IT_WUP + IT_WDOWN + IT_WP + IT_WG;
DI TItem get_item(const KParams& P, int it) {
    bf16_t* Wall = (bf16_t*)(P.ws + WS_W);
    const int l = it / IT_LAYER; int r = it % IT_LAYER;
    bf16_t* Wl = Wall + (size_t)l * LAYER_W;
    TItem t;
    if (r < IT_WIN) { const int kb = r / 104, jb = r % 104, d0 = 32 * jb; int src = d0, nv = 32; float cs = 1.f;
        if (d0 < 384) { src = d0; cs = QSCALE; } else if (d0 < 640) { src = 1152 + d0 - 384; cs = QSCALE; } else if (d0 < 1024) src = 1664 + d0 - 640;
        else if (d0 < 1408) src = 384 + d0 - 1024; else if (d0 < 1536) src = d0; else if (d0 < 1920) src = 2048 + d0 - 1536;
        else if (d0 < 2304) src = 768 + d0 - 1920; else if (d0 < 2432) src = 1536 + d0 - 2304; else if (d0 < 3200) src = d0;
        else if (d0 == 3200) { src = 3200; nv = 24; } else { src = 0; nv = 0; }
        t = TItem{P.w_in + (size_t)l * DM * DIN, DM, DIN, src, nv, P.attn_norm + l * DM, cs, Wl + OFF_WIN, d0, 64 * kb}; return t; }
    r -= IT_WIN;
    if (r < IT_WOUT) { const int kb = r / 32, jb = r % 32; t = TItem{P.w_out + (size_t)l * DM * DM, DM, DM, 32 * jb, 32, nullptr, 1.f, Wl + OFF_WOUT, 32 * jb, 64 * kb}; return t; }
    r -= IT_WOUT;
    if (r < IT_WUP) { const int kb = r / 176, jb = r % 176, d0 = 32 * jb, pn = d0 >> 8, c0 = d0 & 255; const int src = c0 < 128 ? 128 * pn + c0 : DFF + 128 * pn + (c0 - 128);
        t = TItem{P.w_up + (size_t)l * DM * NUP, DM, NUP, src, 32, P.ffn_norm + l * DM, 1.f, Wl + OFF_WUP, d0, 64 * kb}; return t; }
    r -= IT_WUP;
    if (r < IT_WDOWN) { const int kb = r / 32, jb = r % 32; t = TItem{P.w_down + (size_t)l * DFF * DM, DFF, DM, 32 * jb, 32, nullptr, 1.f, Wl + OFF_WDOWN, 32 * jb, 64 * kb}; return t; }
    r -= IT_WDOWN;
    if (r < IT_WP) { const int kb = r / 32, jb = r % 32; t = TItem{P.ple_proj + (size_t)l * PLE * DM, PLE, DM, 32 * jb, 32, nullptr, 1.f, Wl + OFF_WP, 32 * jb, 64 * kb}; return t; }
    r -= IT_WP;
    { const int kb = r / 32, jb = r % 32; t = TItem{P.ple_gate + (size_t)l * DM * DM, DM, DM, 32 * jb, 32, nullptr, 1.f, Wl + OFF_WG, 32 * jb, 64 * kb}; return t; }
}
DI void prep_weights(const KParams& P, LAS unsigned char* lds, int gw, int NGW, int wave, int lane) {
    LAS float* scr = (LAS float*)(lds + wave * 16384);
    constexpr int NIT = DEPTH * IT_LAYER;
    for (int it = gw; it < NIT; it += 2 * NGW) {
        const TItem ta = get_item(P, it); const bool hb = it + NGW < NIT; const TItem tb = get_item(P, hb ? it + NGW : it);
        f32x4 va[8], vb[8];
        ti_load(ta, lane, va); if (hb) ti_load(tb, lane, vb);
        ti_finish(ta, lane, va, scr); if (hb) ti_finish(tb, lane, vb, scr);
    }
}
DI float wave_sum(float v, int lane) {
#pragma unroll
    for (int o = 1; o < 64; o <<= 1) v += shx(v, o, lane);
    return v;
}
DI float wave_max(float v, int lane) {
#pragma unroll
    for (int o = 1; o < 64; o <<= 1) v = fmaxf(v, shx(v, o, lane));
    return v;
}

constexpr int VROW = 144;
constexpr int VBUF = 32 * VROW;
constexpr int LUTA = 256, LUTAC = 128, LUTB = 320, LUTBC = 160;
constexpr int LUT_BYTES = (18 * LUTA + 4 * LUTB) * 4, PBUF_BYTES = 256 * 136;

template <bool EDGE>
DI void load_kv(const bf16_t* __restrict__ zb, int kcol, int vcol, int dstr, int rd, int u0, int lane, bf16x8 (&kn)[2][2], u32x4 (&vn)[4]) {
    const int r16 = lane & 15, g = lane >> 4;
#pragma unroll
    for (int T = 0; T < 2; ++T) { int pos = dstr * (u0 + 16 * T + r16) + rd; if (EDGE) pos = pos < 0 ? 0 : (pos > SEQ - 1 ? SEQ - 1 : pos);
        const unsigned off = (unsigned)pos * (unsigned)ZLD + (unsigned)(kcol + 8 * g); kn[T][0] = *(const bf16x8*)(zb + off); kn[T][1] = *(const bf16x8*)(zb + off + 32u); }
#pragma unroll
    for (int k = 0; k < 4; ++k) { const int id = lane + 64 * k, row = id >> 3, c16 = id & 7; int pos = dstr * (u0 + row) + rd; if (EDGE) pos = pos < 0 ? 0 : (pos > SEQ - 1 ? SEQ - 1 : pos);
        const unsigned off = (unsigned)pos * (unsigned)ZLD + (unsigned)(vcol + 8 * c16); vn[k] = *(const u32x4*)(zb + off); }
}

struct DescA {
    int rd0, rd1, ub0, ub1, uq0, uq1, tb;
    DI void get(int ci, int g, int& dstr, int& rd, int& u0, int& li) const {
        const int t1 = ci >= 5 ? 1 : 0;
        dstr = 16 - 12 * t1; rd = rd0 + t1 * (rd1 - rd0);
        const int lc = ci - 5 * t1;
        u0 = ub0 + t1 * (ub1 - ub0) + 32 * lc;
        const int uq = uq0 + t1 * (uq1 - uq0);
        li = u0 - uq + 4 * g + LUTAC + tb + t1 * 6 * LUTA; }
};
struct DescB {
    int ub, uq, tb, lc;
    DI void get(int ci, int g, int& dstr, int& rd, int& u0, int& li) const { dstr = 1; rd = 0; u0 = ub + 32 * ci; li = u0 - uq + 4 * g + lc + tb; }
};

template <int NH, int D, bool EDGE, class Desc>
DI void attn_stream(const bf16_t* __restrict__ zb, int kcol, int vcol, int nch, const Desc& ds, const LAS float* lutbase, int lstr,
                    const bf16x8 (&qf)[NH][2], float (&m)[NH], float (&l)[NH], f32x4 (&o)[NH][4], LAS unsigned char* vbase, int lane) {
    const int r16 = lane & 15, g = lane >> 4, q4 = r16 >> 2, p4 = r16 & 3;
    bf16x8 kn[D][2][2]; u32x4 vn[D][4];
#pragma unroll
    for (int j = 0; j < D; ++j) if (j < nch) { int dstr, rd, u0, li; ds.get(j, g, dstr, rd, u0, li); load_kv<EDGE>(zb, kcol, vcol, dstr, rd, u0, lane, kn[j], vn[j]); }
#pragma unroll 1
    for (int c0 = 0; c0 < nch; c0 += D) {
#pragma unroll
        for (int j = 0; j < D; ++j) {
            const int c = c0 + j;
            if (c < nch) {
                int dstr, rd, u0, li; ds.get(c, g, dstr, rd, u0, li);
                LAS unsigned char* vb = vbase + (c & 1) * VBUF;
#pragma unroll
                for (int k = 0; k < 4; ++k) { const int id = lane + 64 * k, row = id >> 3, c16 = id & 7; *(LAS u32x4*)(vb + row * VROW + c16 * 16) = vn[j][k]; }
                f32x4 stt[NH][2];
#pragma unroll
                for (int hh = 0; hh < NH; ++hh)
#pragma unroll
                    for (int T = 0; T < 2; ++T) { f32x4 st = {0.f, 0.f, 0.f, 0.f}; st = mfma16(kn[j][T][0], qf[hh][0], st); st = mfma16(kn[j][T][1], qf[hh][1], st); stt[hh][T] = st; }
                if (c + D < nch) { int d2, r2, u2, l2; ds.get(c + D, g, d2, r2, u2, l2); load_kv<EDGE>(zb, kcol, vcol, d2, r2, u2, lane, kn[j], vn[j]); }
                float rm[2][4];
#pragma unroll
                for (int T = 0; T < 2; ++T)
#pragma unroll
                    for (int i = 0; i < 4; ++i) { const int pos = dstr * (u0 + 16 * T + 4 * g + i) + rd; rm[T][i] = (!EDGE || (unsigned)pos < (unsigned)SEQ) ? 0.f : NEGBIG; }
                bf16x8 vf[4];
#pragma unroll
                for (int c4 = 0; c4 < 4; ++c4) { const s16x4 a0 = trread(vb + (4 * g + q4) * VROW + 32 * c4 + 8 * p4), a1 = trread(vb + (16 + 4 * g + q4) * VROW + 32 * c4 + 8 * p4); vf[c4] = cat8(a0, a1); }
#pragma unroll
                for (int hh = 0; hh < NH; ++hh) {
                    const LAS float* lut = lutbase + hh * lstr + li;
                    float sv[8];
#pragma unroll
                    for (int T = 0; T < 2; ++T) {
#pragma unroll
                        for (int i = 0; i < 4; ++i) sv[4 * T + i] = EDGE ? (stt[hh][T][i] + lut[16 * T + i] + rm[T][i]) : (stt[hh][T][i] + lut[16 * T + i]); }
                    float cm = fmaxf(fmaxf(fmaxf(sv[0], sv[1]), fmaxf(sv[2], sv[3])), fmaxf(fmaxf(sv[4], sv[5]), fmaxf(sv[6], sv[7])));
                    cm = xmax4(cm);
                    const float mn = fmaxf(m[hh], cm), alpha = ex2(m[hh] - mn); m[hh] = mn;
                    float pv[8], ps = 0.f;
#pragma unroll
                    for (int k = 0; k < 8; ++k) { pv[k] = ex2(sv[k] - mn); ps += pv[k]; }
                    l[hh] = l[hh] * alpha + ps;
                    u32x4 pw; pw.x = pk2(pv[0], pv[1]); pw.y = pk2(pv[2], pv[3]); pw.z = pk2(pv[4], pv[5]); pw.w = pk2(pv[6], pv[7]);
                    const bf16x8 pf = __builtin_bit_cast(bf16x8, pw);
#pragma unroll
                    for (int c4 = 0; c4 < 4; ++c4) { o[hh][c4] = o[hh][c4] * alpha; o[hh][c4] = mfma16(vf[c4], pf, o[hh][c4]); }
                }
            }
        }
    }
}

DI void build_lut(const KParams& P, LAS unsigned char* lds, int tid) {
    LAS float* lut = (LAS float*)lds;
    for (int idx = tid; idx < 18 * LUTA + 4 * LUTB; idx += 512) {
        int rel, dil, half, hc;
        if (idx < 18 * LUTA) { const int t = idx / LUTA, cfg = t / 6; rel = idx % LUTA - LUTAC; dil = cfg == 0 ? 16 : (cfg == 1 ? 4 : 1); half = 64; hc = t % 6; }
        else { const int j = idx - 18 * LUTA; rel = j % LUTB - LUTBC; dil = 1; half = 128; hc = 6 + j / LUTB; }
        float v = NEGBIG; const int ar = rel < 0 ? -rel : rel;
        if (ar <= half) { const int n = ar * dil; int bk;
            if (n < 8) bk = n; else { const float nf = (float)n; bk = 8 + (int)(logf(nf / 8.0f) / 4.852030263919617f * 8.0f); bk = bk > 15 ? 15 : bk; }
            if (rel > 0) bk += 16;
            v = P.rel_bias[bk * 10 + hc] * LOG2E; }
        lut[idx] = v;
    }
}

DI void attention_phase(const KParams& P0_, LAS unsigned char* lds, int l, int pm, int wave, int lane, bool wr_en = true) {
    KParams P = P0_; { __attribute__((address_space(1))) unsigned char* w1_ = (__attribute__((address_space(1))) unsigned char*)P.ws; asm volatile("" : "+s"(w1_)); P.ws = (unsigned char*)w1_; }
    bf16_t* Z = (bf16_t*)(P.ws + WS_Z);
    const int r16 = lane & 15, g = lane >> 4;
    const int row0 = pm * 256, b = row0 / SEQ, s0 = row0 % SEQ;
    bf16_t* zb = Z + (size_t)b * SEQ * ZLD;
    const LAS float* lut = (const LAS float*)lds;
    LAS unsigned char* pbuf = lds + LUT_BYTES;
    LAS unsigned char* vbase = lds + LUT_BYTES + PBUF_BYTES + wave * (2 * VBUF);
    const bool edge1 = s0 < 64 || s0 + 256 + 96 > SEQ, edge2 = s0 < 1024 || s0 + 1536 > SEQ, edgeb = s0 < 128 || s0 + 256 + 160 > SEQ;
    for (int h = 0; h < 6; ++h) {
        for (int qg = wave; qg < 16; qg += 8) {
            const int posq = s0 + 16 * qg + r16;
            bf16x8 qf[1][2];
            { const bf16_t* qp = zb + (size_t)posq * ZLD + QA + 64 * h + 8 * g; qf[0][0] = *(const bf16x8*)qp; qf[0][1] = *(const bf16x8*)(qp + 32); }
            float m[1] = {-1e20f}, lsum[1] = {0.f}; f32x4 o[1][4];
#pragma unroll
            for (int c4 = 0; c4 < 4; ++c4) o[0][c4] = zero4();
            { DescB ds; const int U1 = s0 + 16 * qg; ds.ub = U1 - 64; ds.uq = U1 + r16; ds.tb = (12 + h) * LUTA; ds.lc = LUTAC;
              if (edge1) attn_stream<1, 2, true, DescB>(zb, KA + 64 * h, VA + 64 * h, 5, ds, lut, 0, qf, m, lsum, o, vbase, lane);
              else attn_stream<1, 2, false, DescB>(zb, KA + 64 * h, VA + 64 * h, 5, ds, lut, 0, qf, m, lsum, o, vbase, lane); }
            const float lt = xsum4(lsum[0]);
            LAS unsigned char* pq = pbuf + (16 * qg + r16) * 136;
#pragma unroll
            for (int c4 = 0; c4 < 4; ++c4) { const f32x4 v = o[0][c4]; u32x2 w; w.x = pk2(v[0], v[1]); w.y = pk2(v[2], v[3]); *(LAS u32x2*)(pq + (16 * c4 + 4 * g) * 2) = w; }
            if (g == 0) { *(LAS float*)(pq + 128) = m[0]; *(LAS float*)(pq + 132) = lt; }
        }
        __syncthreads();
        for (int rho = wave; rho < 16; rho += 8) {
            const int posq = s0 + rho + 16 * r16;
            bf16x8 qf[1][2];
            { const bf16_t* qp = zb + (size_t)posq * ZLD + QA + 64 * h + 8 * g; qf[0][0] = *(const bf16x8*)qp; qf[0][1] = *(const bf16x8*)(qp + 32); }
            float m[1] = {-1e20f}, lsum[1] = {0.f}; f32x4 o[1][4];
#pragma unroll
            for (int c4 = 0; c4 < 4; ++c4) o[0][c4] = zero4();
            { DescA ds; const int U16 = s0 >> 4, U4 = (s0 >> 2) + (rho >> 2);
              ds.rd0 = rho; ds.rd1 = rho & 3; ds.ub0 = U16 - 64; ds.ub1 = U4 - 64; ds.uq0 = U16 + r16; ds.uq1 = U4 + 4 * r16; ds.tb = h * LUTA;
              if (edge2) attn_stream<1, 2, true, DescA>(zb, KA + 64 * h, VA + 64 * h, 11, ds, lut, 0, qf, m, lsum, o, vbase, lane);
              else attn_stream<1, 2, false, DescA>(zb, KA + 64 * h, VA + 64 * h, 11, ds, lut, 0, qf, m, lsum, o, vbase, lane); }
            const float lt = xsum4(lsum[0]);
            const LAS unsigned char* pq = pbuf + (rho + 16 * r16) * 136;
            const float m1 = *(const LAS float*)(pq + 128), l1 = *(const LAS float*)(pq + 132);
            const float mf = fmaxf(m[0], m1), a0 = ex2(m[0] - mf), a1 = ex2(m1 - mf);
            const float inv = 1.f / (lt * a0 + l1 * a1), f0 = a0 * inv, f1 = a1 * inv;
            bf16_t* yp = zb + (size_t)posq * ZLD + QA + 64 * h + 4 * g;
            if (wr_en)
#pragma unroll
            for (int c4 = 0; c4 < 4; ++c4) { const u32x2 pw = *(const LAS u32x2*)(pq + (16 * c4 + 4 * g) * 2); const f32x4 v = o[0][c4];
                u32x2 w; w.x = pk2(v[0] * f0 + bflo(pw.x) * f1, v[1] * f0 + bfhi(pw.x) * f1); w.y = pk2(v[2] * f0 + bflo(pw.y) * f1, v[3] * f0 + bfhi(pw.y) * f1); *(u32x2*)(yp + 16 * c4) = w; }
        }
        __syncthreads();
    }
    for (int ub = wave; ub < 32; ub += 8) {
        const int kvh = ub >> 4, qg = ub & 15;
        const int posq = s0 + 16 * qg + r16;
        bf16x8 qf[2][2];
#pragma unroll
        for (int hh = 0; hh < 2; ++hh) { const bf16_t* qp = zb + (size_t)posq * ZLD + QB + 64 * (2 * kvh + hh) + 8 * g; qf[hh][0] = *(const bf16x8*)qp; qf[hh][1] = *(const bf16x8*)(qp + 32); }
        float m[2] = {-1e20f, -1e20f}, lsum[2] = {0.f, 0.f}; f32x4 o[2][4];
#pragma unroll
        for (int hh = 0; hh < 2; ++hh)
#pragma unroll
            for (int c4 = 0; c4 < 4; ++c4) o[hh][c4] = zero4();
        const int U0 = s0 + 16 * qg;
        { DescB ds; ds.ub = U0 - 128; ds.uq = U0 + r16; ds.tb = 18 * LUTA + (2 * kvh) * LUTB; ds.lc = LUTBC;
          if (edgeb) attn_stream<2, 2, true, DescB>(zb, KB + 64 * kvh, VB + 64 * kvh, 9, ds, lut, LUTB, qf, m, lsum, o, vbase, lane);
          else attn_stream<2, 2, false, DescB>(zb, KB + 64 * kvh, VB + 64 * kvh, 9, ds, lut, LUTB, qf, m, lsum, o, vbase, lane); }
#pragma unroll
        for (int hh = 0; hh < 2; ++hh) { const int hq = 2 * kvh + hh;
            const float lt = xsum4(lsum[hh]);
            const float sk = P.sink[l * 4 + hq] * LOG2E, mf = fmaxf(m[hh], sk), sc = ex2(m[hh] - mf);
            const float den = lt * sc + ex2(sk - mf), f = sc / den;
            bf16_t* yp = zb + (size_t)posq * ZLD + QB + 64 * hq + 4 * g;
            if (wr_en)
#pragma unroll
            for (int c4 = 0; c4 < 4; ++c4) { const f32x4 v = o[hh][c4] * f; u32x2 w; w.x = pk2(v[0], v[1]); w.y = pk2(v[2], v[3]); *(u32x2*)(yp + 16 * c4) = w; } }
    }
}

DI float logsig(float x) { return fminf(x, 0.f) - log1pf(fexp(-fabsf(x))); }
DI float scan_add_up(float v, int lane) {
#pragma unroll
    for (int o = 1; o < 64; o <<= 1) { const float t = shi(v, lane - o); if (lane >= o) v += t; }
    return v;
}
DI float scan_add_down(float v, int lane) {
#pragma unroll
    for (int o = 1; o < 64; o <<= 1) { const float t = shi(v, lane + o); if (lane + o < 64) v += t; }
    return v;
}
DI float scan_max_up(float v, int lane) {
#pragma unroll
    for (int o = 1; o < 64; o <<= 1) { const float t = shi(v, lane - o); if (lane >= o) v = fmaxf(v, t); }
    return v;
}
DI float scan_max_down(float v, int lane) {
#pragma unroll
    for (int o = 1; o < 64; o <<= 1) { const float t = shi(v, lane + o); if (lane + o < 64) v = fmaxf(v, t); }
    return v;
}

DI void conv8(const bf16_t* __restrict__ zb, int s, int col, const float* __restrict__ cw  , int lane, float (&acc)[8][8]) {
    const int r8 = lane >> 3;
    float w[5][8];
#pragma unroll
    for (int j = 0; j < 5; ++j) { const f32x4 a = *(const f32x4*)(cw + j * 768), b = *(const f32x4*)(cw + j * 768 + 4);
        w[j][0] = a[0]; w[j][1] = a[1]; w[j][2] = a[2]; w[j][3] = a[3]; w[j][4] = b[0]; w[j][5] = b[1]; w[j][6] = b[2]; w[j][7] = b[3]; }
#pragma unroll
    for (int k = 0; k < 8; ++k)
#pragma unroll
        for (int e = 0; e < 8; ++e) acc[k][e] = 0.f;
#pragma unroll
    for (int rr = -2; rr < 10; ++rr) {
        const int pos = s + 8 * r8 + rr;
        u32x4 raw = {0u, 0u, 0u, 0u};
        if ((unsigned)pos < (unsigned)SEQ) raw = *(const u32x4*)(zb + (size_t)pos * ZLD + col);
        float x[8] = {bflo(raw.x), bfhi(raw.x), bflo(raw.y), bfhi(raw.y), bflo(raw.z), bfhi(raw.z), bflo(raw.w), bfhi(raw.w)};
#pragma unroll
        for (int k = 0; k < 8; ++k) { const int j = rr - k + 2;
            if (j >= 0 && j <= 4) {
#pragma unroll
                for (int e = 0; e < 8; ++e) acc[k][e] += w[j][e] * x[e]; } }
    }
#pragma unroll
    for (int k = 0; k < 8; ++k)
#pragma unroll
        for (int e = 0; e < 8; ++e) { const float a = acc[k][e]; acc[k][e] = a * sigmoidf_(a); }
}

DI void mlstm_state_phase(const KParams& P0_, LAS unsigned char* lds, int l, int pm, int wave, int lane) {
    KParams P = P0_; { __attribute__((address_space(1))) unsigned char* w1_ = (__attribute__((address_space(1))) unsigned char*)P.ws; asm volatile("" : "+s"(w1_)); P.ws = (unsigned char*)w1_; }

    bf16_t* Z = (bf16_t*)(P.ws + WS_Z);
    const float* gates = (const float*)(P.ws + WS_GATES);
    bf16_t* qconv = (bf16_t*)(P.ws + WS_QCONV); bf16_t* kconv = (bf16_t*)(P.ws + WS_KCONV);
    bf16_t* CT = (bf16_t*)(P.ws + WS_CT); bf16_t* nbuf = (bf16_t*)(P.ws + WS_NB);
    float* mloc = (float*)(P.ws + WS_ML); float* blast = (float*)(P.ws + WS_BL);
    const float* gb = P.gate_bias + l * 24;
    const int r16 = lane & 15, g = lane >> 4, q4 = r16 >> 2, p4 = r16 & 3, r8 = lane >> 3, pc = lane & 7;
    LAS unsigned char* kbuf = lds + wave * (2 * 64 * VROW);
    LAS unsigned char* vbuf = kbuf + 64 * VROW;
    for (int um = wave; um < 24; um += 8) {
        asm volatile("" : "+v"(lane));
        const int cc = um / 6, h = um % 6;
        const int tc = pm * 256 + 64 * cc, b = tc / SEQ, s = tc % SEQ, ci = s >> 6;
        const bf16_t* zb = Z + (size_t)b * SEQ * ZLD;
        const float* G = gates + (size_t)(tc + lane) * 24;
        const float igf = G[h] + gb[h], fgf = G[6 + h] + gb[6 + h], igb = G[12 + h] + gb[12 + h], fgb = G[18 + h] + gb[18 + h];
        const float bfw = scan_add_up(logsig(fgf), lane), bbw = scan_add_down(logsig(fgb), lane);
        const float blf = shi(bfw, 63), blb = shi(bbw, 0);
        const float wf = blf - bfw + igf, wb = blb - bbw + igb;
        const float mlf = wave_max(wf, lane), mlb = wave_max(wb, lane);
        const float ef = fexp(wf - mlf), eb = fexp(wb - mlb);
        const int slot_f = ((0 * NB + b) * 6 + h) * NCH + ci, slot_b = ((1 * NB + b) * 6 + h) * NCH + ci;
        if (lane == 0) { mloc[slot_f] = mlf; blast[slot_f] = blf; mloc[slot_b] = mlb; blast[slot_b] = blb; }
        float acc[8][8];
        conv8(zb, s, QC + 64 * h + 8 * pc, P.qk_conv + (size_t)l * 5 * 768 + 64 * h + 8 * pc, lane, acc);
#pragma unroll
        for (int k = 0; k < 8; ++k) { u32x4 w; w.x = pk2(acc[k][0], acc[k][1]); w.y = pk2(acc[k][2], acc[k][3]); w.z = pk2(acc[k][4], acc[k][5]); w.w = pk2(acc[k][6], acc[k][7]);
            *(u32x4*)(qconv + (size_t)(tc + 8 * r8 + k) * 384 + 64 * h + 8 * pc) = w; }
        conv8(zb, s, KC + 64 * h + 8 * pc, P.qk_conv + (size_t)l * 5 * 768 + 384 + 64 * h + 8 * pc, lane, acc);
        u32x4 kpk[8];
#pragma unroll
        for (int k = 0; k < 8; ++k) {
#pragma unroll
            for (int e = 0; e < 8; ++e) acc[k][e] *= 0.125f;
            u32x4 w; w.x = pk2(acc[k][0], acc[k][1]); w.y = pk2(acc[k][2], acc[k][3]); w.z = pk2(acc[k][4], acc[k][5]); w.w = pk2(acc[k][6], acc[k][7]);
            kpk[k] = w;
            *(u32x4*)(kconv + (size_t)(tc + 8 * r8 + k) * 384 + 64 * h + 8 * pc) = w; }
#pragma unroll
        for (int k = 0; k < 8; ++k) { const int id = lane + 64 * k, row = id >> 3, c16 = id & 7;
            *(LAS u32x4*)(vbuf + row * VROW + 16 * c16) = *(const u32x4*)(zb + (size_t)(s + row) * ZLD + VC + 64 * h + 8 * c16); }
#pragma unroll
        for (int dir = 0; dir < 2; ++dir) {
            const float ed = dir ? eb : ef;
#pragma unroll
            for (int k = 0; k < 8; ++k) { const float e = shi(ed, 8 * r8 + k); const u32x4 kk = kpk[k];
                u32x4 w; w.x = pk2(bflo(kk.x) * e, bfhi(kk.x) * e); w.y = pk2(bflo(kk.y) * e, bfhi(kk.y) * e); w.z = pk2(bflo(kk.z) * e, bfhi(kk.z) * e); w.w = pk2(bflo(kk.w) * e, bfhi(kk.w) * e);
                *(LAS u32x4*)(kbuf + (8 * r8 + k) * VROW + 16 * pc) = w; }
            WAVE_LDS_FENCE();
            f32x4 c[4][5];
#pragma unroll
            for (int dt = 0; dt < 4; ++dt)
#pragma unroll
                for (int et = 0; et < 5; ++et) c[dt][et] = zero4();
#pragma unroll
            for (int ks = 0; ks < 2; ++ks) {
                bf16x8 af[4], bfr[5];
#pragma unroll
                for (int t4 = 0; t4 < 4; ++t4) {
                    af[t4] = cat8(trread(kbuf + (32 * ks + 8 * g + q4) * VROW + 32 * t4 + 8 * p4), trread(kbuf + (32 * ks + 8 * g + 4 + q4) * VROW + 32 * t4 + 8 * p4));
                    bfr[t4] = cat8(trread(vbuf + (32 * ks + 8 * g + q4) * VROW + 32 * t4 + 8 * p4), trread(vbuf + (32 * ks + 8 * g + 4 + q4) * VROW + 32 * t4 + 8 * p4)); }
                { const short one = r16 == 0 ? (short)0x3F80 : (short)0; bfr[4] = (bf16x8){one, one, one, one, one, one, one, one}; }
#pragma unroll
                for (int dt = 0; dt < 4; ++dt)
#pragma unroll
                    for (int et = 0; et < 5; ++et) c[dt][et] = mfma16(af[dt], bfr[et], c[dt][et]);
            }
            const int slot = dir ? slot_b : slot_f;
            bf16_t* ct = CT + ((size_t)(slot / NCH) * 64 * NCH + (slot % NCH)) * 64;
#pragma unroll
            for (int dt = 0; dt < 4; ++dt) {
#pragma unroll
                for (int et = 0; et < 4; ++et) { const f32x4 v = c[dt][et]; u32x2 w; w.x = pk2(v[0], v[1]); w.y = pk2(v[2], v[3]); *(u32x2*)(ct + (size_t)(16 * et + r16) * (NCH * 64) + 16 * dt + 4 * g) = w; }
                if (r16 == 0) { const f32x4 v = c[dt][4]; u32x2 w; w.x = pk2(v[0], v[1]); w.y = pk2(v[2], v[3]); *(u32x2*)(nbuf + (size_t)slot * 64 + 16 * dt + 4 * g) = w; } }
            WAVE_LDS_FENCE();
        }
    }
}

DI void mlstm_scan_phase(const KParams& P0_, LAS unsigned char* lds, int bid, int G, int tid, bool wr_en = true) {
    KParams P = P0_; { __attribute__((address_space(1))) unsigned char* w1_ = (__attribute__((address_space(1))) unsigned char*)P.ws; asm volatile("" : "+s"(w1_)); P.ws = (unsigned char*)w1_; }
    bf16_t* CT = (bf16_t*)(P.ws + WS_CT); bf16_t* nbuf = (bf16_t*)(P.ws + WS_NB);
    const float* mloc = (const float*)(P.ws + WS_ML); const float* blast = (const float*)(P.ws + WS_BL); float* mprev = (float*)(P.ws + WS_MP);
    LAS float* sbl = (LAS float*)lds; LAS float* sml = sbl + 512; LAS float* sa = sml + 512; LAS float* scc = sa + 512;
    const int wave = tid >> 6, lane = tid & 63;
    { const int k = tid >> 7, st = tid & 127; const int sq = k < 3 ? ((bid * 8 + 2048 * k) >> 6) : (bid < NSEQ ? bid : 0); const int c = sq >= NSEQ / 2 ? (NCH - 1 - st) : st;
      sbl[tid] = blast[sq * NCH + c]; sml[tid] = mloc[sq * NCH + c]; }
    __syncthreads();
    if (tid < 4) { const int k = tid; const int sq = k < 3 ? ((bid * 8 + 2048 * k) >> 6) : (bid < NSEQ ? bid : 0); const bool dirb = sq >= NSEQ / 2;
        const bool wm = wr_en && k < 3 && ((bid * 8) & 63) == 0;
        float m = 0.f;
        for (int st = 0; st < NCH; ++st) { const float bl = sbl[k * 128 + st], ml = sml[k * 128 + st]; const float mn = fmaxf(bl + m, ml);
            sa[k * 128 + st] = fexp(bl + m - mn); scc[k * 128 + st] = fexp(ml - mn);
            if (wm) mprev[sq * NCH + (dirb ? (NCH - 1 - st) : st)] = m;
            m = mn; } }
    __syncthreads();
    bf16_t* ptr[4]; bool act[4]; bool dirb[4];
#pragma unroll
    for (int k = 0; k < 3; ++k) { const int row = bid * 8 + wave + 2048 * k; ptr[k] = CT + (size_t)row * (NCH * 64) + lane; act[k] = true; dirb[k] = (row >> 6) >= NSEQ / 2; }
    { ptr[3] = nbuf + (size_t)(bid < NSEQ ? bid : 0) * NCH * 64 + lane; act[3] = bid < NSEQ && wave == 0; dirb[3] = bid >= NSEQ / 2; }
    float C[4] = {0.f, 0.f, 0.f, 0.f};
    for (int st0 = 0; st0 < NCH; st0 += 16) {
        float cl[4][16];
#pragma unroll
        for (int k = 0; k < 4; ++k)
#pragma unroll
            for (int j = 0; j < 16; ++j) { const int c = dirb[k] ? (NCH - 1 - (st0 + j)) : (st0 + j); cl[k][j] = act[k] ? bf2f(ptr[k][c * 64]) : 0.f; }
#pragma unroll
        for (int k = 0; k < 4; ++k)
#pragma unroll
            for (int j = 0; j < 16; ++j) { const int c = dirb[k] ? (NCH - 1 - (st0 + j)) : (st0 + j);
                if (act[k] && wr_en) ptr[k][c * 64] = (bf16_t)(pk2(C[k], 0.f) & 0xffffu);
                C[k] = sa[k * 128 + st0 + j] * C[k] + scc[k * 128 + st0 + j] * cl[k][j]; }
    }
    __syncthreads();
}

DI void mlstm_out_phase(const KParams& P0_, LAS unsigned char* lds, int l, int pm, int wave, int lane) {
    KParams P = P0_; { __attribute__((address_space(1))) unsigned char* w1_ = (__attribute__((address_space(1))) unsigned char*)P.ws; asm volatile("" : "+s"(w1_)); P.ws = (unsigned char*)w1_; }

    bf16_t* Z = (bf16_t*)(P.ws + WS_Z);
    const float* gates = (const float*)(P.ws + WS_GATES);
    const bf16_t* qconv = (const bf16_t*)(P.ws + WS_QCONV); const bf16_t* kconv = (const bf16_t*)(P.ws + WS_KCONV);
    const bf16_t* CT = (const bf16_t*)(P.ws + WS_CT); const bf16_t* nbuf = (const bf16_t*)(P.ws + WS_NB);
    const float* mprev = (const float*)(P.ws + WS_MP);
    const float* gb = P.gate_bias + l * 24;
    const int r16 = lane & 15, g = lane >> 4, q4 = r16 >> 2, p4 = r16 & 3;
    LAS unsigned char* vbuf = lds + wave * (64 * VROW + 2048 + 256);
    LAS float* tab = (LAS float*)(vbuf + 64 * VROW);
    LAS unsigned char* ntab = vbuf + 64 * VROW + 2048;
    for (int um = wave; um < 24; um += 8) {
        asm volatile("" : "+v"(lane));
        const int cc = um / 6, h = um % 6;
        const int tc = pm * 256 + 64 * cc, b = tc / SEQ, s = tc % SEQ, ci = s >> 6;
        bf16_t* zb = Z + (size_t)b * SEQ * ZLD;
        const int slot_f = ((0 * NB + b) * 6 + h) * NCH + ci, slot_b = ((1 * NB + b) * 6 + h) * NCH + ci;
        u32x4 vreg[8];
#pragma unroll
        for (int k = 0; k < 8; ++k) { const int id = lane + 64 * k, row = id >> 3, c16 = id & 7; vreg[k] = *(const u32x4*)(zb + (size_t)(s + row) * ZLD + VC + 64 * h + 8 * c16); }
        bf16x8 kfr[4][2];
#pragma unroll
        for (int st = 0; st < 4; ++st) { const bf16_t* kp = kconv + (size_t)(tc + 16 * st + r16) * 384 + 64 * h + 8 * g; kfr[st][0] = *(const bf16x8*)kp; kfr[st][1] = *(const bf16x8*)(kp + 32); }
        bf16x8 cfr[2][4][2];
#pragma unroll
        for (int dir = 0; dir < 2; ++dir) { const int slot = dir ? slot_b : slot_f; const bf16_t* ct = CT + ((size_t)(slot / NCH) * 64 * NCH + (slot % NCH)) * 64;
#pragma unroll
            for (int kp = 0; kp < 2; ++kp)
#pragma unroll
                for (int et = 0; et < 4; ++et) cfr[dir][et][kp] = *(const bf16x8*)(ct + (size_t)(16 * et + r16) * (NCH * 64) + 32 * kp + 8 * g); }
        {
            const float* G = gates + (size_t)(tc + lane) * 24;
            const float igf = G[h] + gb[h], fgf = G[6 + h] + gb[6 + h], igb = G[12 + h] + gb[12 + h], fgb = G[18 + h] + gb[18 + h];
            const float bfw = scan_add_up(logsig(fgf), lane), bbw = scan_add_down(logsig(fgb), lane);
            const float gf = igf - bfw, gbk = igb - bbw;
            const float pmf = scan_max_up(gf, lane), pmb = scan_max_down(gbk, lane);
            const float mpf = mprev[slot_f], mpb = mprev[slot_b];
            const float Mf = fmaxf(pmf, mpf), Mb = fmaxf(pmb, mpb);
            tab[0 * 64 + lane] = gf; tab[1 * 64 + lane] = gbk; tab[2 * 64 + lane] = Mf; tab[3 * 64 + lane] = Mb;
            tab[4 * 64 + lane] = fexp(mpf - Mf); tab[5 * 64 + lane] = fexp(mpb - Mb); tab[6 * 64 + lane] = fexp(-(bfw + Mf)); tab[7 * 64 + lane] = fexp(-(bbw + Mb));
        }
#pragma unroll
        for (int k = 0; k < 8; ++k) { const int id = lane + 64 * k, row = id >> 3, c16 = id & 7; *(LAS u32x4*)(vbuf + row * VROW + 16 * c16) = vreg[k]; }
        if (lane < 16) { const int dirn = lane >> 3, c8 = lane & 7; *(LAS u32x4*)(ntab + dirn * 128 + c8 * 16) = *(const u32x4*)(nbuf + (size_t)(dirn ? slot_b : slot_f) * 64 + 8 * c8); }
        WAVE_LDS_FENCE();
        for (int tt = 0; tt < 4; ++tt) {
            const int tau = 16 * tt + r16;
            bf16x8 qfr[2];
            { const bf16_t* qp = qconv + (size_t)(tc + tau) * 384 + 64 * h + 8 * g; qfr[0] = *(const bf16x8*)qp; qfr[1] = *(const bf16x8*)(qp + 32); }
            u32x2 ocv[4];
#pragma unroll
            for (int et = 0; et < 4; ++et) ocv[et] = *(const u32x2*)(zb + (size_t)(s + tau) * ZLD + OC + 64 * h + 16 * et + 4 * g);
            f32x4 S[4];
#pragma unroll
            for (int st = 0; st < 4; ++st) { S[st] = (f32x4){0.f, 0.f, 0.f, 0.f}; S[st] = mfma16(kfr[st][0], qfr[0], S[st]); S[st] = mfma16(kfr[st][1], qfr[1], S[st]); }
            f32x4 hs[4];
#pragma unroll
            for (int et = 0; et < 4; ++et) hs[et] = zero4();
#pragma unroll
            for (int dir = 0; dir < 2; ++dir) {
                const float Mt = tab[(2 + dir) * 64 + tau], at = tab[(4 + dir) * 64 + tau], flt = tab[(6 + dir) * 64 + tau];
                bf16x8 pfr[2];
#pragma unroll
                for (int kp = 0; kp < 2; ++kp) { float pv[8];
#pragma unroll
                    for (int hf = 0; hf < 2; ++hf) { const int st = 2 * kp + hf; const f32x4 gs = *(const LAS f32x4*)(tab + dir * 64 + 16 * st + 4 * g);
#pragma unroll
                        for (int i = 0; i < 4; ++i) { const int sg = 16 * st + 4 * g + i; const bool ok = dir ? (sg >= tau) : (sg <= tau);
                            const float e = fexp(gs[i] - Mt) * S[st][i]; pv[4 * hf + i] = ok ? e : 0.f; } }
                    u32x4 pw; pw.x = pk2(pv[0], pv[1]); pw.y = pk2(pv[2], pv[3]); pw.z = pk2(pv[4], pv[5]); pw.w = pk2(pv[6], pv[7]); pfr[kp] = __builtin_bit_cast(bf16x8, pw); }
                f32x4 nd[5];
#pragma unroll
                for (int et = 0; et < 5; ++et) nd[et] = zero4();
#pragma unroll
                for (int kp = 0; kp < 2; ++kp) {
                    const u32x4 qw = __builtin_bit_cast(u32x4, qfr[kp]); u32x4 qs;
                    qs.x = pk2(bflo(qw.x) * at, bfhi(qw.x) * at); qs.y = pk2(bflo(qw.y) * at, bfhi(qw.y) * at); qs.z = pk2(bflo(qw.z) * at, bfhi(qw.z) * at); qs.w = pk2(bflo(qw.w) * at, bfhi(qw.w) * at);
                    const bf16x8 qsc = __builtin_bit_cast(bf16x8, qs);
#pragma unroll
                    for (int et = 0; et < 4; ++et) { const bf16x8 vf = cat8(trread(vbuf + (32 * kp + 4 * g + q4) * VROW + 32 * et + 8 * p4), trread(vbuf + (32 * kp + 16 + 4 * g + q4) * VROW + 32 * et + 8 * p4));
                        nd[et] = mfma16(vf, pfr[kp], nd[et]); nd[et] = mfma16(cfr[dir][et][kp], qsc, nd[et]); }
                    { const short one = r16 == 0 ? (short)0x3F80 : (short)0; const bf16x8 of = {one, one, one, one, one, one, one, one}; nd[4] = mfma16(of, pfr[kp], nd[4]); }
                    { bf16x8 nf = {0, 0, 0, 0, 0, 0, 0, 0}; if (r16 == 0) nf = *(const LAS bf16x8*)(ntab + dir * 128 + 64 * kp + 16 * g); nd[4] = mfma16(nf, qsc, nd[4]); }
                }
                const float den = shi(nd[4][0], r16);
                const float inv = 1.f / fmaxf(fabsf(den), flt);
#pragma unroll
                for (int et = 0; et < 4; ++et) hs[et] += nd[et] * inv;
            }
            float ss = 0.f;
#pragma unroll
            for (int et = 0; et < 4; ++et) ss += (hs[et][0] * hs[et][0] + hs[et][1] * hs[et][1]) + (hs[et][2] * hs[et][2] + hs[et][3] * hs[et][3]);
            ss = xsum4(ss);
            const float rn = 1.f / sqrtf(ss * (1.f / 64.f) + EPS);
            bf16_t* zr = zb + (size_t)(s + tau) * ZLD;
#pragma unroll
            for (int et = 0; et < 4; ++et) { const int e0 = 64 * h + 16 * et + 4 * g;
                const u32x2 ov = ocv[et]; const f32x4 ng = *(const f32x4*)(P.mlstm_norm + l * 384 + e0);
                const float y0 = hs[et][0] * rn * ng[0] * sigmoidf_(bflo(ov.x)), y1 = hs[et][1] * rn * ng[1] * sigmoidf_(bfhi(ov.x));
                const float y2 = hs[et][2] * rn * ng[2] * sigmoidf_(bflo(ov.y)), y3 = hs[et][3] * rn * ng[3] * sigmoidf_(bfhi(ov.y));
                u32x2 w; w.x = pk2(y0, y1); w.y = pk2(y2, y3); *(u32x2*)(zr + QC + e0) = w; }
        }
        WAVE_LDS_FENCE();
    }
}

#ifndef PROBE_MODE
#define PROBE_MODE 0
#endif
#ifndef SKIP_ATTN
#define SKIP_ATTN 0
#endif
#ifndef SKIP_MLSTM
#define SKIP_MLSTM 0
#endif

__global__ void __launch_bounds__(512, 2) fwd_kernel(KParams P) {
    extern __shared__ __attribute__((aligned(16))) unsigned char lds_raw[];
    LAS unsigned char* lds = (LAS unsigned char*)lds_raw;
    cg::grid_group grid = cg::this_grid();
#if PROBE_MODE == 4
#define GSYNC() do { grid.sync(); grid.sync(); } while (0)
#else
#define GSYNC() grid.sync()
#endif
    unsigned* const bar_cnt = (unsigned*)P.ws;
    unsigned bar_target = 0;
#define ABAR() do { asm volatile("s_waitcnt vmcnt(0) lgkmcnt(0)" ::: "memory"); __syncthreads(); bar_target += 256u; \
        if (wave_s == 0 && lane_id_asm() == 0) { __builtin_amdgcn_fence(__ATOMIC_RELEASE, "agent"); __hip_atomic_fetch_add(bar_cnt, 1u, __ATOMIC_RELAXED, __HIP_MEMORY_SCOPE_AGENT); \
            while (__hip_atomic_load(bar_cnt, __ATOMIC_RELAXED, __HIP_MEMORY_SCOPE_AGENT) < bar_target) __builtin_amdgcn_s_sleep(2); \
            __builtin_amdgcn_fence(__ATOMIC_ACQUIRE, "agent"); } \
        __syncthreads(); } while (0)
    const int G = gridDim.x, bx = blockIdx.x;
    if (G != 256) return;
    const int pm0 = (bx & 7) * 32 + (bx >> 3);
const int wave_s = __builtin_amdgcn_readfirstlane((int)threadIdx.x >> 6);
#define FRESH_IDS int tid = wave_s * 64 + lane_id_asm(); asm volatile("" : "+v"(tid)); const int lane = tid & 63, wave = __builtin_amdgcn_readfirstlane(tid >> 6); int pm = pm0; asm volatile("" : "+s"(pm)); (void)lane; (void)wave; (void)pm;
#define WSP() ({ __attribute__((address_space(1))) unsigned char* w_ = (__attribute__((address_space(1))) unsigned char*)P.ws; asm volatile("" : "+s"(w_)); (unsigned char*)w_; })
#define Wall ((bf16_t*)(WSP() + WS_W))
#define PB ((bf16_t*)(WSP() + WS_PB))
#define gates ((float*)(WSP() + WS_GATES))
#define rs ((float*)(WSP() + WS_RS))
#define XBA ((bf16_t*)(WSP() + WS_XBA))
#define XBB ((bf16_t*)(WSP() + WS_XBB))
#define Z ((bf16_t*)(WSP() + WS_Z))
    LAS float* ssq = (LAS float*)(lds + SSQ_OFF);
    LAS float* rsl = (LAS float*)(lds + RSL_OFF);
#define ZERO_SSQ() do { FRESH_IDS; if (tid < 256) { *(LAS f32x4*)(ssq + tid * 4) = zero4(); } } while (0)
#define WRITE_RS() do { FRESH_IDS; if (tid < 256) { const float s_ = (ssq[tid * 4] + ssq[tid * 4 + 1]) + (ssq[tid * 4 + 2] + ssq[tid * 4 + 3]); const float r_ = 1.f / sqrtf(s_ * (1.f / DM) + EPS); rs[pm * 256 + tid] = r_; rsl[tid] = r_; } } while (0)

    { FRESH_IDS;
      prep_weights(P, lds, bx * 8 + wave, G * 8, wave, lane);
      for (int r0 = wave; r0 < 256; r0 += 32) {
        f32x4 v[4][4];
#pragma unroll
        for (int q = 0; q < 4; ++q) { const size_t row = (size_t)pm * 256 + r0 + 8 * q; const f32x4* xr = (const f32x4*)(P.x + row * DM) + lane;
#pragma unroll
            for (int j = 0; j < 4; ++j) v[q][j] = __builtin_nontemporal_load(xr + 64 * j); }
#pragma unroll
        for (int q = 0; q < 4; ++q) { const int rr = r0 + 8 * q; const size_t row = (size_t)pm * 256 + rr; float s = 0.f;
#pragma unroll
            for (int j = 0; j < 4; ++j) s += (v[q][j][0] * v[q][j][0] + v[q][j][1] * v[q][j][1]) + (v[q][j][2] * v[q][j][2] + v[q][j][3] * v[q][j][3]);
            s = wave_sum(s, lane);
            u32x2* o = (u32x2*)(XBA + row * DM) + lane;
#pragma unroll
            for (int j = 0; j < 4; ++j) { u32x2 w; w.x = pk2(v[q][j][0], v[q][j][1]); w.y = pk2(v[q][j][2], v[q][j][3]); o[64 * j] = w; }
            if (lane == 0) { const float r_ = 1.f / sqrtf(s * (1.f / DM) + EPS); rs[row] = r_; rsl[rr] = r_; } } } }
    GSYNC();

    for (int l = 0; l < DEPTH; ++l) {
        bf16_t* Wl = Wall + (size_t)l * LAYER_W;
        { pg8::Gemm g{XBA, Wl + OFF_WIN, DM, DM, wave_s}; pg8::RowOrder S{pm0, NIN_PAD / 256}; pg8::EpiZ E{Z, gates, rsl};
          pg8::gemm_phase<pg8::EpiZ, pg8::RowOrder>(lds, g, S, E);
#if PROBE_MODE == 2
          pg8::gemm_phase<pg8::EpiZ, pg8::RowOrder>(lds, g, S, E);
#endif
          }
        ABAR();
#if PROBE_MODE == 1 || PROBE_MODE == 6
        { FRESH_IDS; build_lut(P, lds, tid); __syncthreads(); attention_phase(P, lds, l, pm, wave, lane, P.out == nullptr); __syncthreads(); }
#endif
#if PROBE_MODE == 1 || PROBE_MODE == 7
        { FRESH_IDS; mlstm_state_phase(P, lds, l, pm, wave, lane); __syncthreads(); }
#endif
        if (!SKIP_ATTN) { FRESH_IDS;
            build_lut(P, lds, tid);
            __syncthreads();
            attention_phase(P, lds, l, pm, wave, lane);
        }
        __syncthreads();
        if (!SKIP_MLSTM) { FRESH_IDS; mlstm_state_phase(P, lds, l, pm, wave, lane); }
        ABAR();
#if PROBE_MODE == 1 || PROBE_MODE == 8
        { FRESH_IDS; mlstm_scan_phase(P, lds, bx, G, tid, P.out == nullptr); }
#endif
        if (!SKIP_MLSTM) { FRESH_IDS; mlstm_scan_phase(P, lds, bx, G, tid); }
        ABAR();
#if PROBE_MODE == 1 || PROBE_MODE == 9
        { FRESH_IDS; mlstm_out_phase(P, lds, l, pm, wave, lane); __syncthreads(); }
#endif
        if (!SKIP_MLSTM) { FRESH_IDS; mlstm_out_phase(P, lds, l, pm, wave, lane); }
        ZERO_SSQ();
        LOCAL_SEAM();
#if PROBE_MODE == 5
        { pg8::Gemm g{Z, Wl + OFF_WOUT, ZLD, DM, wave_s}; pg8::RowOrder S{pm0, 4}; pg8::EpiResid<false> E{XBA, XBA, nullptr, ssq, (P.out == nullptr)};
          pg8::gemm_phase<pg8::EpiResid<false>, pg8::RowOrder>(lds, g, S, E); }
        __syncthreads();
#endif
        { pg8::Gemm g{Z, Wl + OFF_WOUT, ZLD, DM, wave_s}; pg8::RowOrder S{pm0, 4}; pg8::EpiResid<false> E{XBA, XBA, nullptr, ssq, true};
          pg8::gemm_phase<pg8::EpiResid<false>, pg8::RowOrder>(lds, g, S, E); }
        __syncthreads();
        WRITE_RS();
        LOCAL_SEAM();
        { pg8::Gemm g{XBA, Wl + OFF_WUP, DM, DM, wave_s}; pg8::RowOrder S{pm0, NUP / 256}; pg8::EpiSwiGLU E{Z, rsl};
          pg8::gemm_phase<pg8::EpiSwiGLU, pg8::RowOrder>(lds, g, S, E);
#if PROBE_MODE == 2
          pg8::gemm_phase<pg8::EpiSwiGLU, pg8::RowOrder>(lds, g, S, E);
#endif
          }
        ZERO_SSQ();
        LOCAL_SEAM();
#if PROBE_MODE == 5
        { pg8::Gemm g{Z + ACT_OFF, Wl + OFF_WDOWN, ZLD, DFF, wave_s}; pg8::RowOrder S{pm0, 4}; pg8::EpiResid<false> E{XBA, XBB, nullptr, ssq, (P.out == nullptr)};
          pg8::gemm_phase<pg8::EpiResid<false>, pg8::RowOrder>(lds, g, S, E); }
        __syncthreads();
#endif
        { pg8::Gemm g{Z + ACT_OFF, Wl + OFF_WDOWN, ZLD, DFF, wave_s}; pg8::RowOrder S{pm0, 4}; pg8::EpiResid<false> E{XBA, XBB, nullptr, ssq, true};
          pg8::gemm_phase<pg8::EpiResid<false>, pg8::RowOrder>(lds, g, S, E); }
        { FRESH_IDS;
          for (int r0 = wave; r0 < 256; r0 += 64) {
            f32x4 v[8];
#pragma unroll
            for (int j = 0; j < 8; ++j) { const size_t row = (size_t)pm * 256 + r0 + 8 * j; v[j] = __builtin_nontemporal_load((const f32x4*)(P.p + ((size_t)l * MTOK + row) * PLE) + lane); }
#pragma unroll
            for (int j = 0; j < 8; ++j) { const size_t row = (size_t)pm * 256 + r0 + 8 * j; u32x2 w; w.x = pk2(v[j][0], v[j][1]); w.y = pk2(v[j][2], v[j][3]); *((u32x2*)(PB + row * PLE) + lane) = w; } } }
        LOCAL_SEAM();
        { pg8::Gemm g{XBB, Wl + OFF_WG, DM, DM, wave_s}; pg8::RowOrder S{pm0, 4}; pg8::EpiSigmoid E{Z};
          pg8::gemm_phase<pg8::EpiSigmoid, pg8::RowOrder>(lds, g, S, E);
#if PROBE_MODE == 2
          pg8::gemm_phase<pg8::EpiSigmoid, pg8::RowOrder>(lds, g, S, E);
#endif
          }
        ZERO_SSQ();
        LOCAL_SEAM();
#if PROBE_MODE == 5
        { pg8::Gemm g{PB, Wl + OFF_WP, PLE, PLE, wave_s}; pg8::RowOrder S{pm0, 4}; pg8::EpiResid<true> E{XBB, XBA, Z, ssq, (P.out == nullptr)};
          pg8::gemm_phase<pg8::EpiResid<true>, pg8::RowOrder>(lds, g, S, E); }
        __syncthreads();
#endif
        { pg8::Gemm g{PB, Wl + OFF_WP, PLE, PLE, wave_s}; pg8::RowOrder S{pm0, 4}; pg8::EpiResid<true> E{XBB, XBA, Z, ssq, true};
          pg8::gemm_phase<pg8::EpiResid<true>, pg8::RowOrder>(lds, g, S, E); }
        __syncthreads();
        WRITE_RS();
        LOCAL_SEAM();
    }
    { FRESH_IDS;
      for (int r0 = wave; r0 < 256; r0 += 32) {
        u32x2 v[4][4]; float sc[4];
#pragma unroll
        for (int q = 0; q < 4; ++q) { const size_t row = (size_t)pm * 256 + r0 + 8 * q; sc[q] = rs[row]; const u32x2* xr = (const u32x2*)(XBA + row * DM) + lane;
#pragma unroll
            for (int j = 0; j < 4; ++j) v[q][j] = xr[64 * j]; }
        const f32x4* gr = (const f32x4*)P.final_norm + lane;
#pragma unroll
        for (int q = 0; q < 4; ++q) { const size_t row = (size_t)pm * 256 + r0 + 8 * q; f32x4* orow = (f32x4*)(P.out + row * DM) + lane;
#pragma unroll
            for (int j = 0; j < 4; ++j) { const f32x4 gg = gr[64 * j]; const u32x2 w = v[q][j];
                __builtin_nontemporal_store((f32x4){bflo(w.x) * sc[q] * gg[0], bfhi(w.x) * sc[q] * gg[1], bflo(w.y) * sc[q] * gg[2], bfhi(w.y) * sc[q] * gg[3]}, orow + 64 * j); } } } }
}

extern "C" void kernel_launch(void* const* d_in, const int* in_sizes, int n_in, void* d_out, int out_size, void* d_ws, size_t ws_size, hipStream_t stream) {
    static int ready = 0;
    if (ready == 0) {
        if (n_in != 16 || out_size != MTOK * DM || ws_size < WS_END) { fprintf(stderr, "kernel_launch: unexpected sizes (n_in %d, out %d, ws %zu)\n", n_in, out_size, ws_size); ready = -1; return; }
        if (hipFuncSetAttribute((const void*)fwd_kernel, hipFuncAttributeMaxDynamicSharedMemorySize, LDS_BYTES) != hipSuccess) { fprintf(stderr, "kernel_launch: hipFuncSetAttribute failed\n"); ready = -1; return; }
        int dev = 0, cus = 0, per_cu = 0;
        (void)hipGetDevice(&dev); (void)hipDeviceGetAttribute(&cus, hipDeviceAttributeMultiprocessorCount, dev);
        (void)hipOccupancyMaxActiveBlocksPerMultiprocessor(&per_cu, (const void*)fwd_kernel, 512, LDS_BYTES);
        if (cus != 256 || per_cu < 1) fprintf(stderr, "kernel_launch: note: %d CUs, %d blocks/CU (kernel expects 256 x 1)\n", cus, per_cu);
        (void)hipGetLastError();
        ready = 1;
    }
    if (ready < 0) return;
    KParams P{};
    P.x = (const float*)d_in[0]; P.p = (const float*)d_in[1]; P.rel_bias = (const float*)d_in[2]; P.attn_norm = (const float*)d_in[3]; P.w_in = (const float*)d_in[4];
    P.qk_conv = (const float*)d_in[5]; P.gate_bias = (const float*)d_in[6]; P.sink = (const float*)d_in[7]; P.mlstm_norm = (const float*)d_in[8]; P.w_out = (const float*)d_in[9];
    P.ffn_norm = (const float*)d_in[10]; P.w_up = (const float*)d_in[11]; P.w_down = (const float*)d_in[12]; P.ple_proj = (const float*)d_in[13]; P.ple_gate = (const float*)d_in[14];
    P.final_norm = (const float*)d_in[15]; P.out = (float*)d_out; P.ws = (unsigned char*)d_ws;
    (void)hipMemsetAsync(d_ws, 0, 256, stream);
    void* args[] = {&P};
    hipError_t e = hipLaunchCooperativeKernel((const void*)fwd_kernel, dim3(256), dim3(512), args, LDS_BYTES, stream);
    if (e != hipSuccess) fprintf(stderr, "kernel_launch: cooperative launch failed: %s\n", hipGetErrorString(e));
}
```

```cpp
#include <hip/hip_runtime.h>
#include <hip/hip_cooperative_groups.h>
#include <cstdio>
#include <cstdint>
namespace cg = cooperative_groups;

#define LAS __attribute__((address_space(3)))
#define DI __device__ __forceinline__
typedef unsigned short bf16_t;
typedef short bf16x8 __attribute__((ext_vector_type(8)));
typedef short s16x4 __attribute__((ext_vector_type(4)));
typedef float f32x4 __attribute__((ext_vector_type(4)));
typedef float f32x2 __attribute__((ext_vector_type(2)));
typedef unsigned u32x4 __attribute__((ext_vector_type(4)));
typedef unsigned u32x2 __attribute__((ext_vector_type(2)));
typedef __bf16 bf16v2 __attribute__((ext_vector_type(2)));

constexpr int NB = 8, SEQ = 8192, DM = 1024, DEPTH = 4, MTOK = NB * SEQ;
constexpr int ZLD = 3200, NIN_PAD = 3328, DFF = 2816, NUP = 2 * DFF, PLE = 256, DIN = 3224;
constexpr int QA = 0, QB = 384, QC = 640, KA = 1024, KB = 1408, KC = 1536, VA = 1920, VB = 2304, VC = 2432, OC = 2816;
constexpr int ACT_OFF = 384;
constexpr float LOG2E = 1.4426950408889634f;
constexpr float QSCALE = 0.125f * LOG2E;
constexpr float EPS = 1e-6f;
constexpr float NEGBIG = -1e30f;
constexpr int NSEQ = 2 * NB * 6, NCH = SEQ / 64;

constexpr size_t OFF_WIN = 0, OFF_WOUT = OFF_WIN + (size_t)NIN_PAD * DM, OFF_WUP = OFF_WOUT + (size_t)DM * DM, OFF_WDOWN = OFF_WUP + (size_t)NUP * DM,
                 OFF_WP = OFF_WDOWN + (size_t)DM * DFF, OFF_WG = OFF_WP + (size_t)DM * PLE, LAYER_W = OFF_WG + (size_t)DM * DM;
constexpr size_t MiB = 1u << 20;
constexpr size_t WS_W = 1 * MiB, WS_PB = 112 * MiB, WS_GATES = 144 * MiB, WS_RS = 150 * MiB, WS_NB = 151 * MiB, WS_ML = 153 * MiB, WS_BL = WS_ML + 256 * 1024,
                 WS_MP = WS_ML + 512 * 1024, WS_QCONV = 154 * MiB, WS_KCONV = 202 * MiB, WS_XBA = 250 * MiB, WS_XBB = 378 * MiB, WS_Z = 506 * MiB, WS_CT = 906 * MiB,
                 WS_END = 1002 * MiB;
static_assert(WS_W + 4 * LAYER_W * 2 <= WS_PB, "weights");
static_assert(WS_Z + (size_t)MTOK * ZLD * 2 <= WS_CT, "z");
static_assert(WS_CT + (size_t)NSEQ * NCH * 4096 * 2 <= WS_END, "ct");

constexpr int LDS_BYTES = 155648;
constexpr int RING_BYTES = 131072, SSQ_OFF = 131072, RSL_OFF = 151552;

DI unsigned pk2(float lo, float hi) { f32x2 v = {lo, hi}; bf16v2 b = __builtin_convertvector(v, bf16v2); return __builtin_bit_cast(unsigned, b); }
DI float bf2f(unsigned short u) { return __uint_as_float(((unsigned)u) << 16); }
DI float bflo(unsigned u) { return __uint_as_float(u << 16); }
DI float bfhi(unsigned u) { return __uint_as_float(u & 0xffff0000u); }
DI float ex2(float x) { return __builtin_amdgcn_exp2f(x); }
DI float fexp(float x) { return __builtin_amdgcn_exp2f(x * LOG2E); }
DI float frcp(float x) { return __builtin_amdgcn_rcpf(x); }
DI float sigmoidf_(float x) { return frcp(1.f + fexp(-x)); }
DI f32x4 mfma16(bf16x8 a, bf16x8 b, f32x4 c) { return __builtin_amdgcn_mfma_f32_16x16x32_bf16(a, b, c, 0, 0, 0); }
DI f32x4 zero4() { float z; asm volatile("v_mov_b32 %0, 0" : "=v"(z)); return (f32x4){z, z, z, z}; }
DI s16x4 trread(LAS unsigned char* p) { return __builtin_amdgcn_ds_read_tr16_b64_v4i16((LAS s16x4*)p); }
DI bf16x8 cat8(s16x4 a, s16x4 b) { return __builtin_shufflevector(a, b, 0, 1, 2, 3, 4, 5, 6, 7); }
DI float shx(float v, int mask, int lane) { return __builtin_bit_cast(float, __builtin_amdgcn_ds_bpermute((lane ^ mask) << 2, __builtin_bit_cast(int, v))); }
DI float shi(float v, int idx) { return __builtin_bit_cast(float, __builtin_amdgcn_ds_bpermute(idx << 2, __builtin_bit_cast(int, v))); }
DI float xmax4(float v) {
    const unsigned x = __builtin_bit_cast(unsigned, v);
    const auto r = __builtin_amdgcn_permlane16_swap(x, x, false, false); unsigned r0 = r[0], r1 = r[1]; asm volatile("" : "+v"(r0), "+v"(r1));
    const float a = __builtin_bit_cast(float, r0), b = __builtin_bit_cast(float, r1); const float c = a > b ? a : b;
    const unsigned y = __builtin_bit_cast(unsigned, c);
    const auto q = __builtin_amdgcn_permlane32_swap(y, y, false, false); unsigned q0 = q[0], q1 = q[1]; asm volatile("" : "+v"(q0), "+v"(q1));
    const float d = __builtin_bit_cast(float, q0), e = __builtin_bit_cast(float, q1); return d > e ? d : e;
}
DI float xsum4(float v) {
    const unsigned x = __builtin_bit_cast(unsigned, v);
    const auto r = __builtin_amdgcn_permlane16_swap(x, x, false, false); unsigned r0 = r[0], r1 = r[1]; asm volatile("" : "+v"(r0), "+v"(r1));
    const float c = __builtin_bit_cast(float, r0) + __builtin_bit_cast(float, r1);
    const unsigned y = __builtin_bit_cast(unsigned, c);
    const auto q = __builtin_amdgcn_permlane32_swap(y, y, false, false); unsigned q0 = q[0], q1 = q[1]; asm volatile("" : "+v"(q0), "+v"(q1));
    return __builtin_bit_cast(float, q0) + __builtin_bit_cast(float, q1);
}
DI int lane_id_asm() { int l_; asm volatile("v_mbcnt_lo_u32_b32 %0, -1, 0\n\tv_mbcnt_hi_u32_b32 %0, -1, %0" : "=v"(l_)); return l_; }
#define WAVE_LDS_FENCE() asm volatile("s_waitcnt lgkmcnt(0)" ::: "memory")
#define LOCAL_SEAM() do { asm volatile("s_waitcnt vmcnt(0) lgkmcnt(0)" ::: "memory"); __syncthreads(); __builtin_amdgcn_fence(__ATOMIC_ACQUIRE, "workgroup"); } while (0)

namespace pg8 {
constexpr int BM = 256, BK = 64, HALF = 128, HTB = HALF * BK * 2, STAGE_BYTES = 8 * HTB;
DI int lds_byte(int r, int c) { const int st = (r >> 4) * 2 + (c >> 5), rr = r & 15, cc = c & 31, ob = rr * 64 + cc * 2; return st * 1024 + (ob ^ (((ob >> 9) & 1) << 5)); }
DI void stage_rc(int b, int& R, int& C) { const int st = b / 1024, sb = b % 1024, swz = sb ^ (((sb >> 9) & 1) << 5); R = (st >> 1) * 16 + swz / 64; C = (st & 1) * 32 + (swz % 64) / 2; }
DI int perm32(int rho) { const int n = rho >> 4, i = rho & 15; return 8 * (i >> 2) + 4 * n + (i & 3); }
struct Unit { int pm, pn; };
struct Gemm { const bf16_t* A; const bf16_t* Bt; int lda, K, wave; };
struct RowOrder {
    int pm, nN;
    DI bool next(int i, Unit& u) const { if (i >= nN) return false; u.pm = pm; u.pn = i; return true; }
};

template <class Epi, class Sched>
DI void gemm_phase(LAS unsigned char* lds, const Gemm g, const Sched& S, const Epi& E) {
    int tid = g.wave * 64 + lane_id_asm(); asm volatile("" : "+v"(tid));
    const int wid = __builtin_amdgcn_readfirstlane(tid >> 6), lane = tid & 63, wr = wid >> 2, wc = wid & 3, fr = lane & 15, fq = lane >> 4;
    const int K = g.K, nt = K / BK, lda = g.lda;
    unsigned voffA[2], voffB[2];
#pragma unroll
    for (int i = 0; i < 2; ++i) { int R, C; stage_rc(tid * 16 + i * 8192, R, C); const int Rb = Epi::PERM ? ((R & ~31) + perm32(R & 31)) : R;
        voffA[i] = (unsigned)(R * lda + C) * 2u; voffB[i] = (unsigned)(Rb * K + C) * 2u; }
    const size_t kstep = (size_t)(BK * 2);
    const size_t hsA = (size_t)HALF * lda * 2, hsB = (size_t)HALF * K * 2;
    const size_t tsA = 2 * hsA, tsB = 2 * hsB;
    const unsigned ldsw = (unsigned)wid * 1024u;
    const int aoff = lds_byte(wr * 64 + fr, fq * 8), boff = lds_byte(wc * 32 + fr, fq * 8);
#define PG8_SA(b, h) (((b) * 2 + (h)) * HTB)
#define PG8_SB(b, h) ((4 + (b) * 2 + (h)) * HTB)
#define PG8_STAGE(bufoff, gbase, voff) do { _Pragma("unroll") for (int _i = 0; _i < 2; ++_i) \
        __builtin_amdgcn_global_load_lds((const unsigned*)((const char*)(gbase) + (voff)[_i]), (LAS unsigned*)(lds + (bufoff) + ldsw + _i * 8192), 16, 0, 0); } while (0)
#define PG8_LDA(dst, b, h) do { _Pragma("unroll") for (int m = 0; m < 4; ++m) _Pragma("unroll") for (int k = 0; k < 2; ++k) dst[m][k] = *(const LAS bf16x8*)(lds + PG8_SA(b, h) + aoff + m * 2048 + k * 1024); } while (0)
#define PG8_LDB(dst, b, h) do { _Pragma("unroll") for (int n = 0; n < 2; ++n) _Pragma("unroll") for (int k = 0; k < 2; ++k) dst[n][k] = *(const LAS bf16x8*)(lds + PG8_SB(b, h) + boff + n * 2048 + k * 1024); } while (0)
#define PG8_MMA(ai, bj, At, Bt) do { __builtin_amdgcn_s_setprio(1); _Pragma("unroll") for (int m = 0; m < 4; ++m) _Pragma("unroll") for (int n = 0; n < 2; ++n) _Pragma("unroll") for (int k = 0; k < 2; ++k) \
        acc[ai][bj][m][n] = __builtin_amdgcn_mfma_f32_16x16x32_bf16(Bt[n][k], At[m][k], acc[ai][bj][m][n], 0, 0, 0); __builtin_amdgcn_s_setprio(0); } while (0)
#define PG8_WAIT_V(n) asm volatile("s_waitcnt vmcnt(" #n ")" ::: "memory")
#define PG8_WAIT_L(n) asm volatile("s_waitcnt lgkmcnt(" #n ")" ::: "memory")
#define PG8_WAIT_VSEL(sel) do { if constexpr (Epi::NST == 16) asm volatile("s_cmp_eq_u32 %0, 0\n\ts_cbranch_scc1 .Lws%=\n\ts_waitcnt vmcnt(24)\n\ts_branch .Lwe%=\n.Lws%=:\n\ts_waitcnt vmcnt(8)\n.Lwe%=:" :: "s"(sel) : "scc", "memory"); \
    else asm volatile("s_cmp_eq_u32 %0, 0\n\ts_cbranch_scc1 .Lws%=\n\ts_waitcnt vmcnt(16)\n\ts_branch .Lwe%=\n.Lws%=:\n\ts_waitcnt vmcnt(8)\n.Lwe%=:" :: "s"(sel) : "scc", "memory"); } while (0)
#define PG8_BAR __builtin_amdgcn_s_barrier()
#define PG8_SCHED __builtin_amdgcn_sched_barrier(0)
    Unit cur, nxt; int ui = 0;
    if (!S.next(0, cur)) return;
    f32x4 acc[2][2][4][2];
    { float z0; asm volatile("v_mov_b32 %0, 0" : "=v"(z0));
#pragma unroll
    for (int a = 0; a < 2; ++a)
#pragma unroll
        for (int b = 0; b < 2; ++b)
#pragma unroll
            for (int m = 0; m < 4; ++m)
#pragma unroll
                for (int n = 0; n < 2; ++n) acc[a][b][m][n] = (f32x4){z0, z0, z0, z0}; }
    bf16x8 At[4][2], B0[2][2], B1[2][2];
    const char* cA = (const char*)g.A + (size_t)cur.pm * tsA; const char* cB = (const char*)g.Bt + (size_t)cur.pn * tsB;
    PG8_STAGE(PG8_SB(0, 0), cB, voffB); PG8_STAGE(PG8_SB(0, 1), cB + hsB, voffB); PG8_STAGE(PG8_SA(0, 0), cA, voffA); PG8_STAGE(PG8_SA(0, 1), cA + hsA, voffA);
    if (wr == 1) PG8_BAR;
    PG8_WAIT_V(2); PG8_BAR;
    PG8_STAGE(PG8_SB(1, 0), cB + kstep, voffB); PG8_STAGE(PG8_SA(1, 0), cA + kstep, voffA); PG8_STAGE(PG8_SB(1, 1), cB + hsB + kstep, voffB);
    PG8_WAIT_V(6); PG8_BAR;
    for (;;) {
        const bool has_next = S.next(ui + 1, nxt);
        const char* nA = has_next ? (const char*)g.A + (size_t)nxt.pm * tsA : cA; const char* nB = has_next ? (const char*)g.Bt + (size_t)nxt.pn * tsB : cB;
        for (int t = 0; t < nt; t += 2) {
            const bool last = (t == nt - 2);
            const int relax = ((t == 0) && (ui > 0)) ? 1 : 0;
            const char* a1 = cA + (size_t)(t + 1) * kstep;
            const char* a2 = last ? nA : cA + (size_t)(t + 2) * kstep; const char* b2 = last ? nB : cB + (size_t)(t + 2) * kstep;
            const char* a3 = a2 + kstep; const char* b3 = b2 + kstep;
            PG8_LDB(B0, 0, 0); PG8_LDB(B1, 0, 1); PG8_SCHED; PG8_LDA(At, 0, 0); PG8_STAGE(PG8_SA(1, 1), a1 + hsA, voffA);
            PG8_WAIT_VSEL(__builtin_amdgcn_readfirstlane(relax)); PG8_WAIT_L(0); PG8_BAR; PG8_MMA(0, 0, At, B0); PG8_MMA(0, 1, At, B1); PG8_BAR; PG8_SCHED;
            PG8_LDA(At, 0, 1); PG8_STAGE(PG8_SB(0, 0), b2, voffB); PG8_STAGE(PG8_SB(0, 1), b2 + hsB, voffB); PG8_STAGE(PG8_SA(0, 0), a2, voffA);
            PG8_WAIT_VSEL(__builtin_amdgcn_readfirstlane(relax)); PG8_WAIT_L(0); PG8_BAR; PG8_MMA(1, 0, At, B0); PG8_MMA(1, 1, At, B1); PG8_BAR; PG8_SCHED;
            PG8_LDB(B0, 1, 0); PG8_LDB(B1, 1, 1); PG8_SCHED; PG8_LDA(At, 1, 0); PG8_STAGE(PG8_SA(0, 1), a2 + hsA, voffA);
            PG8_WAIT_V(8); PG8_WAIT_L(0); PG8_BAR; PG8_MMA(0, 0, At, B0); PG8_MMA(0, 1, At, B1); PG8_BAR; PG8_SCHED;
            PG8_LDA(At, 1, 1); PG8_STAGE(PG8_SB(1, 0), b3, voffB); PG8_STAGE(PG8_SB(1, 1), b3 + hsB, voffB); PG8_STAGE(PG8_SA(1, 0), a3, voffA);
            PG8_WAIT_V(8); PG8_WAIT_L(0); PG8_BAR; PG8_MMA(1, 0, At, B0); PG8_MMA(1, 1, At, B1); PG8_BAR; PG8_SCHED;
        }
        if (wr == 0) PG8_BAR;
        E(acc, cur, wr, wc, fr, fq);
        if (!has_next) break;
        { float z0; asm volatile("v_mov_b32 %0, 0" : "=v"(z0));
#pragma unroll
        for (int a = 0; a < 2; ++a)
#pragma unroll
            for (int b = 0; b < 2; ++b)
#pragma unroll
                for (int m = 0; m < 4; ++m)
#pragma unroll
                    for (int n = 0; n < 2; ++n) acc[a][b][m][n] = (f32x4){z0, z0, z0, z0}; }
        cur = nxt; cA = nA; cB = nB; ++ui;
        if (wr == 1) PG8_BAR;
    }
    PG8_WAIT_V(0);
    PG8_BAR;
#undef PG8_SA
#undef PG8_SB
#undef PG8_STAGE
#undef PG8_LDA
#undef PG8_LDB
#undef PG8_MMA
#undef PG8_WAIT_V
#undef PG8_WAIT_L
#undef PG8_WAIT_VSEL
#undef PG8_BAR
#undef PG8_SCHED
}

struct EpiZ {
    static constexpr bool PERM = true; static constexpr int NST = 16;
    bf16_t* Z; float* gates; const LAS float* rs;
    DI void operator()(const f32x4 (&acc)[2][2][4][2], const Unit& u, int wr, int wc, int fr, int fq) const {
        asm volatile("" : "+v"(fr), "+v"(fq));
        const int row0 = u.pm * BM + wr * 64 + fr, col0 = u.pn * BM + wc * 32 + 8 * fq;
#pragma unroll
        for (int ai = 0; ai < 2; ++ai)
#pragma unroll
            for (int m = 0; m < 4; ++m) { const int row = row0 + ai * HALF + m * 16; const float sc = rs[row - u.pm * BM];
#pragma unroll
                for (int bj = 0; bj < 2; ++bj) { const int col = col0 + bj * HALF; const f32x4 v0 = acc[ai][bj][m][0] * sc, v1 = acc[ai][bj][m][1] * sc;
                    if (col < ZLD) { u32x4 w; w.x = pk2(v0[0], v0[1]); w.y = pk2(v0[2], v0[3]); w.z = pk2(v1[0], v1[1]); w.w = pk2(v1[2], v1[3]); __builtin_nontemporal_store(w, (u32x4*)(Z + (size_t)row * ZLD + col)); }
                    else if (col < DIN) { float* gp = gates + (size_t)row * 24 + (col - ZLD); *(f32x4*)gp = v0; *(f32x4*)(gp + 4) = v1; } }
                asm volatile("" ::: "memory"); }
    }
};
struct EpiSwiGLU {
    static constexpr bool PERM = true; static constexpr int NST = 8;
    bf16_t* Z; const LAS float* rs;
    DI void operator()(const f32x4 (&acc)[2][2][4][2], const Unit& u, int wr, int wc, int fr, int fq) const {
        asm volatile("" : "+v"(fr), "+v"(fq));
        const int row0 = u.pm * BM + wr * 64 + fr, col0 = ACT_OFF + u.pn * HALF + wc * 32 + 8 * fq;
#pragma unroll
        for (int ai = 0; ai < 2; ++ai)
#pragma unroll
            for (int m = 0; m < 4; ++m) { const int row = row0 + ai * HALF + m * 16; const float sc = rs[row - u.pm * BM]; float o[8];
#pragma unroll
                for (int n = 0; n < 2; ++n)
#pragma unroll
                    for (int i = 0; i < 4; ++i) { const float gg = acc[ai][0][m][n][i] * sc, uu = acc[ai][1][m][n][i] * sc; o[4 * n + i] = gg * sigmoidf_(gg) * uu; }
                u32x4 w; w.x = pk2(o[0], o[1]); w.y = pk2(o[2], o[3]); w.z = pk2(o[4], o[5]); w.w = pk2(o[6], o[7]);
                __builtin_nontemporal_store(w, (u32x4*)(Z + (size_t)row * ZLD + col0));
                asm volatile("" ::: "memory"); }
    }
};
struct EpiSigmoid {
    static constexpr bool PERM = true; static constexpr int NST = 16;
    bf16_t* Z;
    DI void operator()(const f32x4 (&acc)[2][2][4][2], const Unit& u, int wr, int wc, int fr, int fq) const {
        asm volatile("" : "+v"(fr), "+v"(fq));
        const int row0 = u.pm * BM + wr * 64 + fr, col0 = u.pn * BM + wc * 32 + 8 * fq;
#pragma unroll
        for (int ai = 0; ai < 2; ++ai)
#pragma unroll
            for (int m = 0; m < 4; ++m) { const int row = row0 + ai * HALF + m * 16;
#pragma unroll
                for (int bj = 0; bj < 2; ++bj) { const f32x4 v0 = acc[ai][bj][m][0], v1 = acc[ai][bj][m][1]; u32x4 w;
                    w.x = pk2(sigmoidf_(v0[0]), sigmoidf_(v0[1])); w.y = pk2(sigmoidf_(v0[2]), sigmoidf_(v0[3])); w.z = pk2(sigmoidf_(v1[0]), sigmoidf_(v1[1])); w.w = pk2(sigmoidf_(v1[2]), sigmoidf_(v1[3]));
                    *(u32x4*)(Z + (size_t)row * ZLD + col0 + bj * HALF) = w; }
                asm volatile("" ::: "memory"); }
    }
};
template <bool MUL> struct EpiResid {
    static constexpr bool PERM = true; static constexpr int NST = 16;
    static constexpr int GM = MUL ? 2 : 4;
    const bf16_t* resid; bf16_t* xb; const bf16_t* mul; LAS float* ssq; bool wr_en;
    DI void operator()(const f32x4 (&acc)[2][2][4][2], const Unit& u, int wr, int wc, int fr, int fq) const {
        asm volatile("" : "+v"(fr), "+v"(fq));
        const int col0 = u.pn * BM + wc * 32 + 8 * fq;
#pragma unroll
        for (int ai = 0; ai < 2; ++ai)
#pragma unroll
            for (int mg = 0; mg < 4; mg += GM) {
                u32x4 rv[GM][2], mv[GM][2];
#pragma unroll
                for (int mm = 0; mm < GM; ++mm) { const size_t row = (size_t)(u.pm * BM + ai * HALF + wr * 64 + (mg + mm) * 16 + fr);
#pragma unroll
                    for (int bj = 0; bj < 2; ++bj) { const int col = col0 + bj * HALF; rv[mm][bj] = *(const u32x4*)(resid + row * DM + col);
                        if (MUL) mv[mm][bj] = *(const u32x4*)(mul + row * ZLD + col); } }
#pragma unroll
                for (int mm = 0; mm < GM; ++mm) { const int m = mg + mm; const int rl = ai * HALF + wr * 64 + m * 16 + fr; const size_t row = (size_t)(u.pm * BM + rl); float s = 0.f;
#pragma unroll
                    for (int bj = 0; bj < 2; ++bj) { const int col = col0 + bj * HALF; f32x4 a0 = acc[ai][bj][m][0], a1 = acc[ai][bj][m][1];
                        if (MUL) { const u32x4 q = mv[mm][bj];
                            a0[0] *= bflo(q.x); a0[1] *= bfhi(q.x); a0[2] *= bflo(q.y); a0[3] *= bfhi(q.y); a1[0] *= bflo(q.z); a1[1] *= bfhi(q.z); a1[2] *= bflo(q.w); a1[3] *= bfhi(q.w); }
                        const u32x4 r = rv[mm][bj];
                        const f32x4 x0 = {bflo(r.x) + a0[0], bfhi(r.x) + a0[1], bflo(r.y) + a0[2], bfhi(r.y) + a0[3]};
                        const f32x4 x1 = {bflo(r.z) + a1[0], bfhi(r.z) + a1[1], bflo(r.w) + a1[2], bfhi(r.w) + a1[3]};
                        if (wr_en) { u32x4 w; w.x = pk2(x0[0], x0[1]); w.y = pk2(x0[2], x0[3]); w.z = pk2(x1[0], x1[1]); w.w = pk2(x1[2], x1[3]); *(u32x4*)(xb + row * DM + col) = w; }
                        s += ((x0[0] * x0[0] + x0[1] * x0[1]) + (x0[2] * x0[2] + x0[3] * x0[3])) + ((x1[0] * x1[0] + x1[1] * x1[1]) + (x1[2] * x1[2] + x1[3] * x1[3])); }
                    s = xsum4(s);
                    if (fq == 0 && wr_en) ssq[rl * 4 + wc] += s; }
                asm volatile("" ::: "memory"); }
    }
};
}

struct KParams {
    const float* x; const float* p; const float* rel_bias; const float* attn_norm; const float* w_in; const float* qk_conv; const float* gate_bias; const float* sink;
    const float* mlstm_norm; const float* w_out; const float* ffn_norm; const float* w_up; const float* w_down; const float* ple_proj; const float* ple_gate; const float* final_norm;
    float* out; unsigned char* ws;
};

DI void transpose_item(const float* __restrict__ W, int K, int Nsrc, int n0, int nvalid, const float* __restrict__ gk, float cs,
                       bf16_t* __restrict__ WT, int dst_row0, int k0, LAS float* scr, int lane) {
    const int n4 = (lane & 7) * 4, kr = lane >> 3;
    f32x4 v[8];
#pragma unroll
    for (int i = 0; i < 8; ++i) { const int kk = kr + 8 * i; v[i] = (f32x4){0.f, 0.f, 0.f, 0.f};
        if (n4 < nvalid) v[i] = __builtin_nontemporal_load((const f32x4*)(W + (size_t)(k0 + kk) * Nsrc + n0 + n4)); }
#pragma unroll
    for (int i = 0; i < 8; ++i) { const int kk = kr + 8 * i; const float sc = gk ? gk[k0 + kk] * cs : cs;
        scr[kk * 33 + n4 + 0] = v[i][0] * sc; scr[kk * 33 + n4 + 1] = v[i][1] * sc; scr[kk * 33 + n4 + 2] = v[i][2] * sc; scr[kk * 33 + n4 + 3] = v[i][3] * sc; }
    WAVE_LDS_FENCE();
    const int c8 = lane & 7;
#pragma unroll
    for (int j = 0; j < 4; ++j) { const int n = (lane >> 3) + 8 * j; const LAS float* s = scr + (8 * c8) * 33 + n;
        u32x4 o; o.x = pk2(s[0 * 33], s[1 * 33]); o.y = pk2(s[2 * 33], s[3 * 33]); o.z = pk2(s[4 * 33], s[5 * 33]); o.w = pk2(s[6 * 33], s[7 * 33]);
        *(u32x4*)(WT + (size_t)(dst_row0 + n) * K + k0 + 8 * c8) = o; }
    WAVE_LDS_FENCE();
}
constexpr int IT_WIN = 16 * 104, IT_WOUT = 16 * 32, IT_WUP = 16 * 176, IT_WDOWN = 44 * 32, IT_WP = 4 * 32, IT_WG = 16 * 32;
constexpr int IT_LAYER = IT_WIN + IT_WOUT + IT_WUP + IT_WDOWN + IT_WP + IT_WG;

DI void prep_weights(const KParams& P, LAS unsigned char* lds, int gw, int NGW, int wave, int lane) {
    LAS float* scr = (LAS float*)(lds + wave * 16384);
    bf16_t* Wall = (bf16_t*)(P.ws + WS_W);
    for (int it = gw; it < DEPTH * IT_LAYER; it += NGW) {
        const int l = it / IT_LAYER; int r = it % IT_LAYER;
        bf16_t* Wl = Wall + (size_t)l * LAYER_W;
        if (r < IT_WIN) { const int kb = r / 104, jb = r % 104, d0 = 32 * jb; int src = d0, nv = 32; float cs = 1.f;
            if (d0 < 384) { src = d0; cs = QSCALE; } else if (d0 < 640) { src = 1152 + d0 - 384; cs = QSCALE; } else if (d0 < 1024) src = 1664 + d0 - 640;
            else if (d0 < 1408) src = 384 + d0 - 1024; else if (d0 < 1536) src = d0; else if (d0 < 1920) src = 2048 + d0 - 1536;
            else if (d0 < 2304) src = 768 + d0 - 1920; else if (d0 < 2432) src = 1536 + d0 - 2304; else if (d0 < 3200) src = d0;
            else if (d0 == 3200) { src = 3200; nv = 24; } else { src = 0; nv = 0; }
            transpose_item(P.w_in + (size_t)l * DM * DIN, DM, DIN, src, nv, P.attn_norm + l * DM, cs, Wl + OFF_WIN, d0, 64 * kb, scr, lane); continue; }
        r -= IT_WIN;
        if (r < IT_WOUT) { const int kb = r / 32, jb = r % 32; transpose_item(P.w_out + (size_t)l * DM * DM, DM, DM, 32 * jb, 32, nullptr, 1.f, Wl + OFF_WOUT, 32 * jb, 64 * kb, scr, lane); continue; }
        r -= IT_WOUT;
        if (r < IT_WUP) { const int kb = r / 176, jb = r % 176, d0 = 32 * jb, pn = d0 >> 8, c0 = d0 & 255; const int src = c0 < 128 ? 128 * pn + c0 : DFF + 128 * pn + (c0 - 128);
            transpose_item(P.w_up + (size_t)l * DM * NUP, DM, NUP, src, 32, P.ffn_norm + l * DM, 1.f, Wl + OFF_WUP, d0, 64 * kb, scr, lane); continue; }
        r -= IT_WUP;
        if (r < IT_WDOWN) { const int kb = r / 32, jb = r % 32; transpose_item(P.w_down + (size_t)l * DFF * DM, DFF, DM, 32 * jb, 32, nullptr, 1.f, Wl + OFF_WDOWN, 32 * jb, 64 * kb, scr, lane); continue; }
        r -= IT_WDOWN;
        if (r < IT_WP) { const int kb = r / 32, jb = r % 32; transpose_item(P.ple_proj + (size_t)l * PLE * DM, PLE, DM, 32 * jb, 32, nullptr, 1.f, Wl + OFF_WP, 32 * jb, 64 * kb, scr, lane); continue; }
        r -= IT_WP;
        { const int kb = r / 32, jb = r % 32; transpose_item(P.ple_gate + (size_t)l * DM * DM, DM, DM, 32 * jb, 32, nullptr, 1.f, Wl + OFF_WG, 32 * jb, 64 * kb, scr, lane); }
    }
}
DI float wave_sum(float v, int lane) {
#pragma unroll
    for (int o = 1; o < 64; o <<= 1) v += shx(v, o, lane);
    return v;
}
DI float wave_max(float v, int lane) {
#pragma unroll
    for (int o = 1; o < 64; o <<= 1) v = fmaxf(v, shx(v, o, lane));
    return v;
}

constexpr int VROW = 144;
constexpr int VBUF = 32 * VROW;
constexpr int LUTA = 256, LUTAC = 128, LUTB = 320, LUTBC = 160;
constexpr int LUT_BYTES = (18 * LUTA + 4 * LUTB) * 4, PBUF_BYTES = 256 * 136;

template <bool EDGE>
DI void load_kv(const bf16_t* __restrict__ zb, int kcol, int vcol, int dstr, int rd, int u0, int lane, bf16x8 (&kn)[2][2], u32x4 (&vn)[4]) {
    const int r16 = lane & 15, g = lane >> 4;
#pragma unroll
    for (int T = 0; T < 2; ++T) { int pos = dstr * (u0 + 16 * T + r16) + rd; if (EDGE) pos = pos < 0 ? 0 : (pos > SEQ - 1 ? SEQ - 1 : pos);
        const unsigned off = (unsigned)pos * (unsigned)ZLD + (unsigned)(kcol + 8 * g); kn[T][0] = *(const bf16x8*)(zb + off); kn[T][1] = *(const bf16x8*)(zb + off + 32u); }
#pragma unroll
    for (int k = 0; k < 4; ++k) { const int id = lane + 64 * k, row = id >> 3, c16 = id & 7; int pos = dstr * (u0 + row) + rd; if (EDGE) pos = pos < 0 ? 0 : (pos > SEQ - 1 ? SEQ - 1 : pos);
        const unsigned off = (unsigned)pos * (unsigned)ZLD + (unsigned)(vcol + 8 * c16); vn[k] = *(const u32x4*)(zb + off); }
}

struct DescA {
    int rd0, rd1, ub0, ub1, uq0, uq1, tb;
    DI void get(int ci, int g, int& dstr, int& rd, int& u0, int& li) const {
        const int t1 = ci >= 5 ? 1 : 0;
        dstr = 16 - 12 * t1; rd = rd0 + t1 * (rd1 - rd0);
        const int lc = ci - 5 * t1;
        u0 = ub0 + t1 * (ub1 - ub0) + 32 * lc;
        const int uq = uq0 + t1 * (uq1 - uq0);
        li = u0 - uq + 4 * g + LUTAC + tb + t1 * 6 * LUTA; }
};
struct DescB {
    int ub, uq, tb, lc;
    DI void get(int ci, int g, int& dstr, int& rd, int& u0, int& li) const { dstr = 1; rd = 0; u0 = ub + 32 * ci; li = u0 - uq + 4 * g + lc + tb; }
};

template <int NH, int D, bool EDGE, class Desc>
DI void attn_stream(const bf16_t* __restrict__ zb, int kcol, int vcol, int nch, const Desc& ds, const LAS float* lutbase, int lstr,
                    const bf16x8 (&qf)[NH][2], float (&m)[NH], float (&l)[NH], f32x4 (&o)[NH][4], LAS unsigned char* vbase, int lane) {
    const int r16 = lane & 15, g = lane >> 4, q4 = r16 >> 2, p4 = r16 & 3;
    bf16x8 kn[D][2][2]; u32x4 vn[D][4];
#pragma unroll
    for (int j = 0; j < D; ++j) if (j < nch) { int dstr, rd, u0, li; ds.get(j, g, dstr, rd, u0, li); load_kv<EDGE>(zb, kcol, vcol, dstr, rd, u0, lane, kn[j], vn[j]); }
#pragma unroll 1
    for (int c0 = 0; c0 < nch; c0 += D) {
#pragma unroll
        for (int j = 0; j < D; ++j) {
            const int c = c0 + j;
            if (c < nch) {
                int dstr, rd, u0, li; ds.get(c, g, dstr, rd, u0, li);
                LAS unsigned char* vb = vbase + (c & 1) * VBUF;
#pragma unroll
                for (int k = 0; k < 4; ++k) { const int id = lane + 64 * k, row = id >> 3, c16 = id & 7; *(LAS u32x4*)(vb + row * VROW + c16 * 16) = vn[j][k]; }
                f32x4 stt[NH][2];
#pragma unroll
                for (int hh = 0; hh < NH; ++hh)
#pragma unroll
                    for (int T = 0; T < 2; ++T) { f32x4 st = {0.f, 0.f, 0.f, 0.f}; st = mfma16(kn[j][T][0], qf[hh][0], st); st = mfma16(kn[j][T][1], qf[hh][1], st); stt[hh][T] = st; }
                if (c + D < nch) { int d2, r2, u2, l2; ds.get(c + D, g, d2, r2, u2, l2); load_kv<EDGE>(zb, kcol, vcol, d2, r2, u2, lane, kn[j], vn[j]); }
                float rm[2][4];
#pragma unroll
                for (int T = 0; T < 2; ++T)
#pragma unroll
                    for (int i = 0; i < 4; ++i) { const int pos = dstr * (u0 + 16 * T + 4 * g + i) + rd; rm[T][i] = (!EDGE || (unsigned)pos < (unsigned)SEQ) ? 0.f : NEGBIG; }
                bf16x8 vf[4];
#pragma unroll
                for (int c4 = 0; c4 < 4; ++c4) { const s16x4 a0 = trread(vb + (4 * g + q4) * VROW + 32 * c4 + 8 * p4), a1 = trread(vb + (16 + 4 * g + q4) * VROW + 32 * c4 + 8 * p4); vf[c4] = cat8(a0, a1); }
#pragma unroll
                for (int hh = 0; hh < NH; ++hh) {
                    const LAS float* lut = lutbase + hh * lstr + li;
                    float sv[8];
#pragma unroll
                    for (int T = 0; T < 2; ++T) {
#pragma unroll
                        for (int i = 0; i < 4; ++i) sv[4 * T + i] = EDGE ? (stt[hh][T][i] + lut[16 * T + i] + rm[T][i]) : (stt[hh][T][i] + lut[16 * T + i]); }
                    float cm = fmaxf(fmaxf(fmaxf(sv[0], sv[1]), fmaxf(sv[2], sv[3])), fmaxf(fmaxf(sv[4], sv[5]), fmaxf(sv[6], sv[7])));
                    cm = xmax4(cm);
                    const float mn = fmaxf(m[hh], cm), alpha = ex2(m[hh] - mn); m[hh] = mn;
                    float pv[8], ps = 0.f;
#pragma unroll
                    for (int k = 0; k < 8; ++k) { pv[k] = ex2(sv[k] - mn); ps += pv[k]; }
                    l[hh] = l[hh] * alpha + ps;
                    u32x4 pw; pw.x = pk2(pv[0], pv[1]); pw.y = pk2(pv[2], pv[3]); pw.z = pk2(pv[4], pv[5]); pw.w = pk2(pv[6], pv[7]);
                    const bf16x8 pf = __builtin_bit_cast(bf16x8, pw);
#pragma unroll
                    for (int c4 = 0; c4 < 4; ++c4) { o[hh][c4] = o[hh][c4] * alpha; o[hh][c4] = mfma16(vf[c4], pf, o[hh][c4]); }
                }
            }
        }
    }
}

DI void build_lut(const KParams& P, LAS unsigned char* lds, int tid) {
    LAS float* lut = (LAS float*)lds;
    for (int idx = tid; idx < 18 * LUTA + 4 * LUTB; idx += 512) {
        int rel, dil, half, hc;
        if (idx < 18 * LUTA) { const int t = idx / LUTA, cfg = t / 6; rel = idx % LUTA - LUTAC; dil = cfg == 0 ? 16 : (cfg == 1 ? 4 : 1); half = 64; hc = t % 6; }
        else { const int j = idx - 18 * LUTA; rel = j % LUTB - LUTBC; dil = 1; half = 128; hc = 6 + j / LUTB; }
        float v = NEGBIG; const int ar = rel < 0 ? -rel : rel;
        if (ar <= half) { const int n = ar * dil; int bk;
            if (n < 8) bk = n; else { const float nf = (float)n; bk = 8 + (int)(logf(nf / 8.0f) / 4.852030263919617f * 8.0f); bk = bk > 15 ? 15 : bk; }
            if (rel > 0) bk += 16;
            v = P.rel_bias[bk * 10 + hc] * LOG2E; }
        lut[idx] = v;
    }
}

DI void attention_phase(const KParams& P0_, LAS unsigned char* lds, int l, int pm, int wave, int lane, bool wr_en = true) {
    KParams P = P0_; { __attribute__((address_space(1))) unsigned char* w1_ = (__attribute__((address_space(1))) unsigned char*)P.ws; asm volatile("" : "+s"(w1_)); P.ws = (unsigned char*)w1_; }
    bf16_t* Z = (bf16_t*)(P.ws + WS_Z);
    const int r16 = lane & 15, g = lane >> 4;
    const int row0 = pm * 256, b = row0 / SEQ, s0 = row0 % SEQ;
    bf16_t* zb = Z + (size_t)b * SEQ * ZLD;
    const LAS float* lut = (const LAS float*)lds;
    LAS unsigned char* pbuf = lds + LUT_BYTES;
    LAS unsigned char* vbase = lds + LUT_BYTES + PBUF_BYTES + wave * (2 * VBUF);
    const bool edge1 = s0 < 64 || s0 + 256 + 96 > SEQ, edge2 = s0 < 1024 || s0 + 1536 > SEQ, edgeb = s0 < 128 || s0 + 256 + 160 > SEQ;
    for (int h = 0; h < 6; ++h) {
        for (int qg = wave; qg < 16; qg += 8) {
            const int posq = s0 + 16 * qg + r16;
            bf16x8 qf[1][2];
            { const bf16_t* qp = zb + (size_t)posq * ZLD + QA + 64 * h + 8 * g; qf[0][0] = *(const bf16x8*)qp; qf[0][1] = *(const bf16x8*)(qp + 32); }
            float m[1] = {-1e20f}, lsum[1] = {0.f}; f32x4 o[1][4];
#pragma unroll
            for (int c4 = 0; c4 < 4; ++c4) o[0][c4] = zero4();
            { DescB ds; const int U1 = s0 + 16 * qg; ds.ub = U1 - 64; ds.uq = U1 + r16; ds.tb = (12 + h) * LUTA; ds.lc = LUTAC;
              if (edge1) attn_stream<1, 2, true, DescB>(zb, KA + 64 * h, VA + 64 * h, 5, ds, lut, 0, qf, m, lsum, o, vbase, lane);
              else attn_stream<1, 2, false, DescB>(zb, KA + 64 * h, VA + 64 * h, 5, ds, lut, 0, qf, m, lsum, o, vbase, lane); }
            const float lt = xsum4(lsum[0]);
            LAS unsigned char* pq = pbuf + (16 * qg + r16) * 136;
#pragma unroll
            for (int c4 = 0; c4 < 4; ++c4) { const f32x4 v = o[0][c4]; u32x2 w; w.x = pk2(v[0], v[1]); w.y = pk2(v[2], v[3]); *(LAS u32x2*)(pq + (16 * c4 + 4 * g) * 2) = w; }
            if (g == 0) { *(LAS float*)(pq + 128) = m[0]; *(LAS float*)(pq + 132) = lt; }
        }
        __syncthreads();
        for (int rho = wave; rho < 16; rho += 8) {
            const int posq = s0 + rho + 16 * r16;
            bf16x8 qf[1][2];
            { const bf16_t* qp = zb + (size_t)posq * ZLD + QA + 64 * h + 8 * g; qf[0][0] = *(const bf16x8*)qp; qf[0][1] = *(const bf16x8*)(qp + 32); }
            float m[1] = {-1e20f}, lsum[1] = {0.f}; f32x4 o[1][4];
#pragma unroll
            for (int c4 = 0; c4 < 4; ++c4) o[0][c4] = zero4();
            { DescA ds; const int U16 = s0 >> 4, U4 = (s0 >> 2) + (rho >> 2);
              ds.rd0 = rho; ds.rd1 = rho & 3; ds.ub0 = U16 - 64; ds.ub1 = U4 - 64; ds.uq0 = U16 + r16; ds.uq1 = U4 + 4 * r16; ds.tb = h * LUTA;
              if (edge2) attn_stream<1, 2, true, DescA>(zb, KA + 64 * h, VA + 64 * h, 11, ds, lut, 0, qf, m, lsum, o, vbase, lane);
              else attn_stream<1, 2, false, DescA>(zb, KA + 64 * h, VA + 64 * h, 11, ds, lut, 0, qf, m, lsum, o, vbase, lane); }
            const float lt = xsum4(lsum[0]);
            const LAS unsigned char* pq = pbuf + (rho + 16 * r16) * 136;
            const float m1 = *(const LAS float*)(pq + 128), l1 = *(const LAS float*)(pq + 132);
            const float mf = fmaxf(m[0], m1), a0 = ex2(m[0] - mf), a1 = ex2(m1 - mf);
            const float inv = 1.f / (lt * a0 + l1 * a1), f0 = a0 * inv, f1 = a1 * inv;
            bf16_t* yp = zb + (size_t)posq * ZLD + QA + 64 * h + 4 * g;
            if (wr_en)
#pragma unroll
            for (int c4 = 0; c4 < 4; ++c4) { const u32x2 pw = *(const LAS u32x2*)(pq + (16 * c4 + 4 * g) * 2); const f32x4 v = o[0][c4];
                u32x2 w; w.x = pk2(v[0] * f0 + bflo(pw.x) * f1, v[1] * f0 + bfhi(pw.x) * f1); w.y = pk2(v[2] * f0 + bflo(pw.y) * f1, v[3] * f0 + bfhi(pw.y) * f1); *(u32x2*)(yp + 16 * c4) = w; }
        }
        __syncthreads();
    }
    for (int ub = wave; ub < 32; ub += 8) {
        const int kvh = ub >> 4, qg = ub & 15;
        const int posq = s0 + 16 * qg + r16;
        bf16x8 qf[2][2];
#pragma unroll
        for (int hh = 0; hh < 2; ++hh) { const bf16_t* qp = zb + (size_t)posq * ZLD + QB + 64 * (2 * kvh + hh) + 8 * g; qf[hh][0] = *(const bf16x8*)qp; qf[hh][1] = *(const bf16x8*)(qp + 32); }
        float m[2] = {-1e20f, -1e20f}, lsum[2] = {0.f, 0.f}; f32x4 o[2][4];
#pragma unroll
        for (int hh = 0; hh < 2; ++hh)
#pragma unroll
            for (int c4 = 0; c4 < 4; ++c4) o[hh][c4] = zero4();
        const int U0 = s0 + 16 * qg;
        { DescB ds; ds.ub = U0 - 128; ds.uq = U0 + r16; ds.tb = 18 * LUTA + (2 * kvh) * LUTB; ds.lc = LUTBC;
          if (edgeb) attn_stream<2, 2, true, DescB>(zb, KB + 64 * kvh, VB + 64 * kvh, 9, ds, lut, LUTB, qf, m, lsum, o, vbase, lane);
          else attn_stream<2, 2, false, DescB>(zb, KB + 64 * kvh, VB + 64 * kvh, 9, ds, lut, LUTB, qf, m, lsum, o, vbase, lane); }
#pragma unroll
        for (int hh = 0; hh < 2; ++hh) { const int hq = 2 * kvh + hh;
            const float lt = xsum4(lsum[hh]);
            const float sk = P.sink[l * 4 + hq] * LOG2E, mf = fmaxf(m[hh], sk), sc = ex2(m[hh] - mf);
            const float den = lt * sc + ex2(sk - mf), f = sc / den;
            bf16_t* yp = zb + (size_t)posq * ZLD + QB + 64 * hq + 4 * g;
            if (wr_en)
#pragma unroll
            for (int c4 = 0; c4 < 4; ++c4) { const f32x4 v = o[hh][c4] * f; u32x2 w; w.x = pk2(v[0], v[1]); w.y = pk2(v[2], v[3]); *(u32x2*)(yp + 16 * c4) = w; } }
    }
}

DI float logsig(float x) { return fminf(x, 0.f) - log1pf(fexp(-fabsf(x))); }
DI float scan_add_up(float v, int lane) {
#pragma unroll
    for (int o = 1; o < 64; o <<= 1) { const float t = shi(v, lane - o); if (lane >= o) v += t; }
    return v;
}
DI float scan_add_down(float v, int lane) {
#pragma unroll
    for (int o = 1; o < 64; o <<= 1) { const float t = shi(v, lane + o); if (lane + o < 64) v += t; }
    return v;
}
DI float scan_max_up(float v, int lane) {
#pragma unroll
    for (int o = 1; o < 64; o <<= 1) { const float t = shi(v, lane - o); if (lane >= o) v = fmaxf(v, t); }
    return v;
}
DI float scan_max_down(float v, int lane) {
#pragma unroll
    for (int o = 1; o < 64; o <<= 1) { const float t = shi(v, lane + o); if (lane + o < 64) v = fmaxf(v, t); }
    return v;
}

DI void conv8(const bf16_t* __restrict__ zb, int s, int col, const float* __restrict__ cw  , int lane, float (&acc)[8][8]) {
    const int r8 = lane >> 3;
    float w[5][8];
#pragma unroll
    for (int j = 0; j < 5; ++j) { const f32x4 a = *(const f32x4*)(cw + j * 768), b = *(const f32x4*)(cw + j * 768 + 4);
        w[j][0] = a[0]; w[j][1] = a[1]; w[j][2] = a[2]; w[j][3] = a[3]; w[j][4] = b[0]; w[j][5] = b[1]; w[j][6] = b[2]; w[j][7] = b[3]; }
#pragma unroll
    for (int k = 0; k < 8; ++k)
#pragma unroll
        for (int e = 0; e < 8; ++e) acc[k][e] = 0.f;
#pragma unroll
    for (int rr = -2; rr < 10; ++rr) {
        const int pos = s + 8 * r8 + rr;
        u32x4 raw = {0u, 0u, 0u, 0u};
        if ((unsigned)pos < (unsigned)SEQ) raw = *(const u32x4*)(zb + (size_t)pos * ZLD + col);
        float x[8] = {bflo(raw.x), bfhi(raw.x), bflo(raw.y), bfhi(raw.y), bflo(raw.z), bfhi(raw.z), bflo(raw.w), bfhi(raw.w)};
#pragma unroll
        for (int k = 0; k < 8; ++k) { const int j = rr - k + 2;
            if (j >= 0 && j <= 4) {
#pragma unroll
                for (int e = 0; e < 8; ++e) acc[k][e] += w[j][e] * x[e]; } }
    }
#pragma unroll
    for (int k = 0; k < 8; ++k)
#pragma unroll
        for (int e = 0; e < 8; ++e) { const float a = acc[k][e]; acc[k][e] = a * sigmoidf_(a); }
}

DI void mlstm_state_phase(const KParams& P0_, LAS unsigned char* lds, int l, int pm, int wave, int lane) {
    KParams P = P0_; { __attribute__((address_space(1))) unsigned char* w1_ = (__attribute__((address_space(1))) unsigned char*)P.ws; asm volatile("" : "+s"(w1_)); P.ws = (unsigned char*)w1_; }

    bf16_t* Z = (bf16_t*)(P.ws + WS_Z);
    const float* gates = (const float*)(P.ws + WS_GATES);
    bf16_t* qconv = (bf16_t*)(P.ws + WS_QCONV); bf16_t* kconv = (bf16_t*)(P.ws + WS_KCONV);
    bf16_t* CT = (bf16_t*)(P.ws + WS_CT); bf16_t* nbuf = (bf16_t*)(P.ws + WS_NB);
    float* mloc = (float*)(P.ws + WS_ML); float* blast = (float*)(P.ws + WS_BL);
    const float* gb = P.gate_bias + l * 24;
    const int r16 = lane & 15, g = lane >> 4, q4 = r16 >> 2, p4 = r16 & 3, r8 = lane >> 3, pc = lane & 7;
    LAS unsigned char* kbuf = lds + wave * (2 * 64 * VROW);
    LAS unsigned char* vbuf = kbuf + 64 * VROW;
    for (int um = wave; um < 24; um += 8) {
        asm volatile("" : "+v"(lane));
        const int cc = um / 6, h = um % 6;
        const int tc = pm * 256 + 64 * cc, b = tc / SEQ, s = tc % SEQ, ci = s >> 6;
        const bf16_t* zb = Z + (size_t)b * SEQ * ZLD;
        const float* G = gates + (size_t)(tc + lane) * 24;
        const float igf = G[h] + gb[h], fgf = G[6 + h] + gb[6 + h], igb = G[12 + h] + gb[12 + h], fgb = G[18 + h] + gb[18 + h];
        const float bfw = scan_add_up(logsig(fgf), lane), bbw = scan_add_down(logsig(fgb), lane);
        const float blf = shi(bfw, 63), blb = shi(bbw, 0);
        const float wf = blf - bfw + igf, wb = blb - bbw + igb;
        const float mlf = wave_max(wf, lane), mlb = wave_max(wb, lane);
        const float ef = fexp(wf - mlf), eb = fexp(wb - mlb);
        const int slot_f = ((0 * NB + b) * 6 + h) * NCH + ci, slot_b = ((1 * NB + b) * 6 + h) * NCH + ci;
        if (lane == 0) { mloc[slot_f] = mlf; blast[slot_f] = blf; mloc[slot_b] = mlb; blast[slot_b] = blb; }
        float acc[8][8];
        conv8(zb, s, QC + 64 * h + 8 * pc, P.qk_conv + (size_t)l * 5 * 768 + 64 * h + 8 * pc, lane, acc);
#pragma unroll
        for (int k = 0; k < 8; ++k) { u32x4 w; w.x = pk2(acc[k][0], acc[k][1]); w.y = pk2(acc[k][2], acc[k][3]); w.z = pk2(acc[k][4], acc[k][5]); w.w = pk2(acc[k][6], acc[k][7]);
            *(u32x4*)(qconv + (size_t)(tc + 8 * r8 + k) * 384 + 64 * h + 8 * pc) = w; }
        conv8(zb, s, KC + 64 * h + 8 * pc, P.qk_conv + (size_t)l * 5 * 768 + 384 + 64 * h + 8 * pc, lane, acc);
        u32x4 kpk[8];
#pragma unroll
        for (int k = 0; k < 8; ++k) {
#pragma unroll
            for (int e = 0; e < 8; ++e) acc[k][e] *= 0.125f;
            u32x4 w; w.x = pk2(acc[k][0], acc[k][1]); w.y = pk2(acc[k][2], acc[k][3]); w.z = pk2(acc[k][4], acc[k][5]); w.w = pk2(acc[k][6], acc[k][7]);
            kpk[k] = w;
            *(u32x4*)(kconv + (size_t)(tc + 8 * r8 + k) * 384 + 64 * h + 8 * pc) = w; }
#pragma unroll
        for (int k = 0; k < 8; ++k) { const int id = lane + 64 * k, row = id >> 3, c16 = id & 7;
            *(LAS u32x4*)(vbuf + row * VROW + 16 * c16) = *(const u32x4*)(zb + (size_t)(s + row) * ZLD + VC + 64 * h + 8 * c16); }
#pragma unroll
        for (int dir = 0; dir < 2; ++dir) {
            const float ed = dir ? eb : ef;
#pragma unroll
            for (int k = 0; k < 8; ++k) { const float e = shi(ed, 8 * r8 + k); const u32x4 kk = kpk[k];
                u32x4 w; w.x = pk2(bflo(kk.x) * e, bfhi(kk.x) * e); w.y = pk2(bflo(kk.y) * e, bfhi(kk.y) * e); w.z = pk2(bflo(kk.z) * e, bfhi(kk.z) * e); w.w = pk2(bflo(kk.w) * e, bfhi(kk.w) * e);
                *(LAS u32x4*)(kbuf + (8 * r8 + k) * VROW + 16 * pc) = w; }
            WAVE_LDS_FENCE();
            f32x4 c[4][5];
#pragma unroll
            for (int dt = 0; dt < 4; ++dt)
#pragma unroll
                for (int et = 0; et < 5; ++et) c[dt][et] = zero4();
#pragma unroll
            for (int ks = 0; ks < 2; ++ks) {
                bf16x8 af[4], bfr[5];
#pragma unroll
                for (int t4 = 0; t4 < 4; ++t4) {
                    af[t4] = cat8(trread(kbuf + (32 * ks + 8 * g + q4) * VROW + 32 * t4 + 8 * p4), trread(kbuf + (32 * ks + 8 * g + 4 + q4) * VROW + 32 * t4 + 8 * p4));
                    bfr[t4] = cat8(trread(vbuf + (32 * ks + 8 * g + q4) * VROW + 32 * t4 + 8 * p4), trread(vbuf + (32 * ks + 8 * g + 4 + q4) * VROW + 32 * t4 + 8 * p4)); }
                { const short one = r16 == 0 ? (short)0x3F80 : (short)0; bfr[4] = (bf16x8){one, one, one, one, one, one, one, one}; }
#pragma unroll
                for (int dt = 0; dt < 4; ++dt)
#pragma unroll
                    for (int et = 0; et < 5; ++et) c[dt][et] = mfma16(af[dt], bfr[et], c[dt][et]);
            }
            const int slot = dir ? slot_b : slot_f;
            bf16_t* ct = CT + ((size_t)(slot / NCH) * 64 * NCH + (slot % NCH)) * 64;
#pragma unroll
            for (int dt = 0; dt < 4; ++dt) {
#pragma unroll
                for (int et = 0; et < 4; ++et) { const f32x4 v = c[dt][et]; u32x2 w; w.x = pk2(v[0], v[1]); w.y = pk2(v[2], v[3]); *(u32x2*)(ct + (size_t)(16 * et + r16) * (NCH * 64) + 16 * dt + 4 * g) = w; }
                if (r16 == 0) { const f32x4 v = c[dt][4]; u32x2 w; w.x = pk2(v[0], v[1]); w.y = pk2(v[2], v[3]); *(u32x2*)(nbuf + (size_t)slot * 64 + 16 * dt + 4 * g) = w; } }
            WAVE_LDS_FENCE();
        }
    }
}

DI void mlstm_scan_phase(const KParams& P0_, LAS unsigned char* lds, int bid, int G, int tid, bool wr_en = true) {
    KParams P = P0_; { __attribute__((address_space(1))) unsigned char* w1_ = (__attribute__((address_space(1))) unsigned char*)P.ws; asm volatile("" : "+s"(w1_)); P.ws = (unsigned char*)w1_; }
    bf16_t* CT = (bf16_t*)(P.ws + WS_CT); bf16_t* nbuf = (bf16_t*)(P.ws + WS_NB);
    const float* mloc = (const float*)(P.ws + WS_ML); const float* blast = (const float*)(P.ws + WS_BL); float* mprev = (float*)(P.ws + WS_MP);
    LAS float* sbl = (LAS float*)lds; LAS float* sml = sbl + 512; LAS float* sa = sml + 512; LAS float* scc = sa + 512;
    const int wave = tid >> 6, lane = tid & 63;
    { const int k = tid >> 7, st = tid & 127; const int sq = k < 3 ? ((bid * 8 + 2048 * k) >> 6) : (bid < NSEQ ? bid : 0); const int c = sq >= NSEQ / 2 ? (NCH - 1 - st) : st;
      sbl[tid] = blast[sq * NCH + c]; sml[tid] = mloc[sq * NCH + c]; }
    __syncthreads();
    if (tid < 4) { const int k = tid; const int sq = k < 3 ? ((bid * 8 + 2048 * k) >> 6) : (bid < NSEQ ? bid : 0); const bool dirb = sq >= NSEQ / 2;
        const bool wm = wr_en && k < 3 && ((bid * 8) & 63) == 0;
        float m = 0.f;
        for (int st = 0; st < NCH; ++st) { const float bl = sbl[k * 128 + st], ml = sml[k * 128 + st]; const float mn = fmaxf(bl + m, ml);
            sa[k * 128 + st] = fexp(bl + m - mn); scc[k * 128 + st] = fexp(ml - mn);
            if (wm) mprev[sq * NCH + (dirb ? (NCH - 1 - st) : st)] = m;
            m = mn; } }
    __syncthreads();
    bf16_t* ptr[4]; bool act[4]; bool dirb[4];
#pragma unroll
    for (int k = 0; k < 3; ++k) { const int row = bid * 8 + wave + 2048 * k; ptr[k] = CT + (size_t)row * (NCH * 64) + lane; act[k] = true; dirb[k] = (row >> 6) >= NSEQ / 2; }
    { ptr[3] = nbuf + (size_t)(bid < NSEQ ? bid : 0) * NCH * 64 + lane; act[3] = bid < NSEQ && wave == 0; dirb[3] = bid >= NSEQ / 2; }
    float C[4] = {0.f, 0.f, 0.f, 0.f};
    for (int st0 = 0; st0 < NCH; st0 += 16) {
        float cl[4][16];
#pragma unroll
        for (int k = 0; k < 4; ++k)
#pragma unroll
            for (int j = 0; j < 16; ++j) { const int c = dirb[k] ? (NCH - 1 - (st0 + j)) : (st0 + j); cl[k][j] = act[k] ? bf2f(ptr[k][c * 64]) : 0.f; }
#pragma unroll
        for (int k = 0; k < 4; ++k)
#pragma unroll
            for (int j = 0; j < 16; ++j) { const int c = dirb[k] ? (NCH - 1 - (st0 + j)) : (st0 + j);
                if (act[k] && wr_en) ptr[k][c * 64] = (bf16_t)(pk2(C[k], 0.f) & 0xffffu);
                C[k] = sa[k * 128 + st0 + j] * C[k] + scc[k * 128 + st0 + j] * cl[k][j]; }
    }
    __syncthreads();
}

DI void mlstm_out_phase(const KParams& P0_, LAS unsigned char* lds, int l, int pm, int wave, int lane) {
    KParams P = P0_; { __attribute__((address_space(1))) unsigned char* w1_ = (__attribute__((address_space(1))) unsigned char*)P.ws; asm volatile("" : "+s"(w1_)); P.ws = (unsigned char*)w1_; }

    bf16_t* Z = (bf16_t*)(P.ws + WS_Z);
    const float* gates = (const float*)(P.ws + WS_GATES);
    const bf16_t* qconv = (const bf16_t*)(P.ws + WS_QCONV); const bf16_t* kconv = (const bf16_t*)(P.ws + WS_KCONV);
    const bf16_t* CT = (const bf16_t*)(P.ws + WS_CT); const bf16_t* nbuf = (const bf16_t*)(P.ws + WS_NB);
    const float* mprev = (const float*)(P.ws + WS_MP);
    const float* gb = P.gate_bias + l * 24;
    const int r16 = lane & 15, g = lane >> 4, q4 = r16 >> 2, p4 = r16 & 3;
    LAS unsigned char* vbuf = lds + wave * (64 * VROW + 2048 + 256);
    LAS float* tab = (LAS float*)(vbuf + 64 * VROW);
    LAS unsigned char* ntab = vbuf + 64 * VROW + 2048;
    for (int um = wave; um < 24; um += 8) {
        asm volatile("" : "+v"(lane));
        const int cc = um / 6, h = um % 6;
        const int tc = pm * 256 + 64 * cc, b = tc / SEQ, s = tc % SEQ, ci = s >> 6;
        bf16_t* zb = Z + (size_t)b * SEQ * ZLD;
        const int slot_f = ((0 * NB + b) * 6 + h) * NCH + ci, slot_b = ((1 * NB + b) * 6 + h) * NCH + ci;
        u32x4 vreg[8];
#pragma unroll
        for (int k = 0; k < 8; ++k) { const int id = lane + 64 * k, row = id >> 3, c16 = id & 7; vreg[k] = *(const u32x4*)(zb + (size_t)(s + row) * ZLD + VC + 64 * h + 8 * c16); }
        bf16x8 kfr[4][2];
#pragma unroll
        for (int st = 0; st < 4; ++st) { const bf16_t* kp = kconv + (size_t)(tc + 16 * st + r16) * 384 + 64 * h + 8 * g; kfr[st][0] = *(const bf16x8*)kp; kfr[st][1] = *(const bf16x8*)(kp + 32); }
        bf16x8 cfr[2][4][2];
#pragma unroll
        for (int dir = 0; dir < 2; ++dir) { const int slot = dir ? slot_b : slot_f; const bf16_t* ct = CT + ((size_t)(slot / NCH) * 64 * NCH + (slot % NCH)) * 64;
#pragma unroll
            for (int kp = 0; kp < 2; ++kp)
#pragma unroll
                for (int et = 0; et < 4; ++et) cfr[dir][et][kp] = *(const bf16x8*)(ct + (size_t)(16 * et + r16) * (NCH * 64) + 32 * kp + 8 * g); }
        {
            const float* G = gates + (size_t)(tc + lane) * 24;
            const float igf = G[h] + gb[h], fgf = G[6 + h] + gb[6 + h], igb = G[12 + h] + gb[12 + h], fgb = G[18 + h] + gb[18 + h];
            const float bfw = scan_add_up(logsig(fgf), lane), bbw = scan_add_down(logsig(fgb), lane);
            const float gf = igf - bfw, gbk = igb - bbw;
            const float pmf = scan_max_up(gf, lane), pmb = scan_max_down(gbk, lane);
            const float mpf = mprev[slot_f], mpb = mprev[slot_b];
            const float Mf = fmaxf(pmf, mpf), Mb = fmaxf(pmb, mpb);
            tab[0 * 64 + lane] = gf; tab[1 * 64 + lane] = gbk; tab[2 * 64 + lane] = Mf; tab[3 * 64 + lane] = Mb;
            tab[4 * 64 + lane] = fexp(mpf - Mf); tab[5 * 64 + lane] = fexp(mpb - Mb); tab[6 * 64 + lane] = fexp(-(bfw + Mf)); tab[7 * 64 + lane] = fexp(-(bbw + Mb));
        }
#pragma unroll
        for (int k = 0; k < 8; ++k) { const int id = lane + 64 * k, row = id >> 3, c16 = id & 7; *(LAS u32x4*)(vbuf + row * VROW + 16 * c16) = vreg[k]; }
        if (lane < 16) { const int dirn = lane >> 3, c8 = lane & 7; *(LAS u32x4*)(ntab + dirn * 128 + c8 * 16) = *(const u32x4*)(nbuf + (size_t)(dirn ? slot_b : slot_f) * 64 + 8 * c8); }
        WAVE_LDS_FENCE();
        for (int tt = 0; tt < 4; ++tt) {
            const int tau = 16 * tt + r16;
            bf16x8 qfr[2];
            { const bf16_t* qp = qconv + (size_t)(tc + tau) * 384 + 64 * h + 8 * g; qfr[0] = *(const bf16x8*)qp; qfr[1] = *(const bf16x8*)(qp + 32); }
            u32x2 ocv[4];
#pragma unroll
            for (int et = 0; et < 4; ++et) ocv[et] = *(const u32x2*)(zb + (size_t)(s + tau) * ZLD + OC + 64 * h + 16 * et + 4 * g);
            f32x4 S[4];
#pragma unroll
            for (int st = 0; st < 4; ++st) { S[st] = (f32x4){0.f, 0.f, 0.f, 0.f}; S[st] = mfma16(kfr[st][0], qfr[0], S[st]); S[st] = mfma16(kfr[st][1], qfr[1], S[st]); }
            f32x4 hs[4];
#pragma unroll
            for (int et = 0; et < 4; ++et) hs[et] = zero4();
#pragma unroll
            for (int dir = 0; dir < 2; ++dir) {
                const float Mt = tab[(2 + dir) * 64 + tau], at = tab[(4 + dir) * 64 + tau], flt = tab[(6 + dir) * 64 + tau];
                bf16x8 pfr[2];
#pragma unroll
                for (int kp = 0; kp < 2; ++kp) { float pv[8];
#pragma unroll
                    for (int hf = 0; hf < 2; ++hf) { const int st = 2 * kp + hf; const f32x4 gs = *(const LAS f32x4*)(tab + dir * 64 + 16 * st + 4 * g);
#pragma unroll
                        for (int i = 0; i < 4; ++i) { const int sg = 16 * st + 4 * g + i; const bool ok = dir ? (sg >= tau) : (sg <= tau);
                            const float e = fexp(gs[i] - Mt) * S[st][i]; pv[4 * hf + i] = ok ? e : 0.f; } }
                    u32x4 pw; pw.x = pk2(pv[0], pv[1]); pw.y = pk2(pv[2], pv[3]); pw.z = pk2(pv[4], pv[5]); pw.w = pk2(pv[6], pv[7]); pfr[kp] = __builtin_bit_cast(bf16x8, pw); }
                f32x4 nd[5];
#pragma unroll
                for (int et = 0; et < 5; ++et) nd[et] = zero4();
#pragma unroll
                for (int kp = 0; kp < 2; ++kp) {
                    const u32x4 qw = __builtin_bit_cast(u32x4, qfr[kp]); u32x4 qs;
                    qs.x = pk2(bflo(qw.x) * at, bfhi(qw.x) * at); qs.y = pk2(bflo(qw.y) * at, bfhi(qw.y) * at); qs.z = pk2(bflo(qw.z) * at, bfhi(qw.z) * at); qs.w = pk2(bflo(qw.w) * at, bfhi(qw.w) * at);
                    const bf16x8 qsc = __builtin_bit_cast(bf16x8, qs);
#pragma unroll
                    for (int et = 0; et < 4; ++et) { const bf16x8 vf = cat8(trread(vbuf + (32 * kp + 4 * g + q4) * VROW + 32 * et + 8 * p4), trread(vbuf + (32 * kp + 16 + 4 * g + q4) * VROW + 32 * et + 8 * p4));
                        nd[et] = mfma16(vf, pfr[kp], nd[et]); nd[et] = mfma16(cfr[dir][et][kp], qsc, nd[et]); }
                    { const short one = r16 == 0 ? (short)0x3F80 : (short)0; const bf16x8 of = {one, one, one, one, one, one, one, one}; nd[4] = mfma16(of, pfr[kp], nd[4]); }
                    { bf16x8 nf = {0, 0, 0, 0, 0, 0, 0, 0}; if (r16 == 0) nf = *(const LAS bf16x8*)(ntab + dir * 128 + 64 * kp + 16 * g); nd[4] = mfma16(nf, qsc, nd[4]); }
                }
                const float den = shi(nd[4][0], r16);
                const float inv = 1.f / fmaxf(fabsf(den), flt);
#pragma unroll
                for (int et = 0; et < 4; ++et) hs[et] += nd[et] * inv;
            }
            float ss = 0.f;
#pragma unroll
            for (int et = 0; et < 4; ++et) ss += (hs[et][0] * hs[et][0] + hs[et][1] * hs[et][1]) + (hs[et][2] * hs[et][2] + hs[et][3] * hs[et][3]);
            ss = xsum4(ss);
            const float rn = 1.f / sqrtf(ss * (1.f / 64.f) + EPS);
            bf16_t* zr = zb + (size_t)(s + tau) * ZLD;
#pragma unroll
            for (int et = 0; et < 4; ++et) { const int e0 = 64 * h + 16 * et + 4 * g;
                const u32x2 ov = ocv[et]; const f32x4 ng = *(const f32x4*)(P.mlstm_norm + l * 384 + e0);
                const float y0 = hs[et][0] * rn * ng[0] * sigmoidf_(bflo(ov.x)), y1 = hs[et][1] * rn * ng[1] * sigmoidf_(bfhi(ov.x));
                const float y2 = hs[et][2] * rn * ng[2] * sigmoidf_(bflo(ov.y)), y3 = hs[et][3] * rn * ng[3] * sigmoidf_(bfhi(ov.y));
                u32x2 w; w.x = pk2(y0, y1); w.y = pk2(y2, y3); *(u32x2*)(zr + QC + e0) = w; }
        }
        WAVE_LDS_FENCE();
    }
}

#ifndef PROBE_MODE
#define PROBE_MODE 0
#endif
#ifndef SKIP_ATTN
#define SKIP_ATTN 0
#endif
#ifndef SKIP_MLSTM
#define SKIP_MLSTM 0
#endif

__global__ void __launch_bounds__(512, 2) fwd_kernel(KParams P) {
    extern __shared__ __attribute__((aligned(16))) unsigned char lds_raw[];
    LAS unsigned char* lds = (LAS unsigned char*)lds_raw;
    cg::grid_group grid = cg::this_grid();
#if PROBE_MODE == 4
#define GSYNC() do { grid.sync(); grid.sync(); } while (0)
#else
#define GSYNC() grid.sync()
#endif
    unsigned* const bar_w = (unsigned*)P.ws;
    const unsigned xcd_ = (unsigned)__builtin_amdgcn_s_getreg((3 << 11) | 20) & 0xFu;
    unsigned bar_round = 0, bar_nloc = 1, bar_nx = 1;
#define ABAR() do { asm volatile("s_waitcnt vmcnt(0) lgkmcnt(0)" ::: "memory"); __syncthreads(); bar_round += 1u; \
        if (wave_s == 0 && lane_id_asm() == 0) { \
            const unsigned old_ = __hip_atomic_fetch_add(bar_w + 32 + xcd_, 1u, __ATOMIC_RELAXED, __HIP_MEMORY_SCOPE_AGENT); \
            if (old_ + 1u == bar_nloc * bar_round) { __builtin_amdgcn_fence(__ATOMIC_RELEASE, "agent"); asm volatile("s_waitcnt vmcnt(0)" ::: "memory"); \
                __hip_atomic_fetch_add(bar_w, 1u, __ATOMIC_RELAXED, __HIP_MEMORY_SCOPE_AGENT); } \
            unsigned sp_ = 0; while (__hip_atomic_load(bar_w, __ATOMIC_RELAXED, __HIP_MEMORY_SCOPE_AGENT) < bar_nx * bar_round && ++sp_ < (1u << 22)) __builtin_amdgcn_s_sleep(2); \
            __builtin_amdgcn_fence(__ATOMIC_ACQUIRE, "agent"); } \
        __syncthreads(); } while (0)
    const int G = gridDim.x, bx = blockIdx.x;
    if (G != 256) return;
    const int pm0 = (bx & 7) * 32 + (bx >> 3);
const int wave_s = __builtin_amdgcn_readfirstlane((int)threadIdx.x >> 6);
#define FRESH_IDS int tid = wave_s * 64 + lane_id_asm(); asm volatile("" : "+v"(tid)); const int lane = tid & 63, wave = __builtin_amdgcn_readfirstlane(tid >> 6); int pm = pm0; asm volatile("" : "+s"(pm)); (void)lane; (void)wave; (void)pm;
#define WSP() ({ __attribute__((address_space(1))) unsigned char* w_ = (__attribute__((address_space(1))) unsigned char*)P.ws; asm volatile("" : "+s"(w_)); (unsigned char*)w_; })
#define Wall ((bf16_t*)(WSP() + WS_W))
#define PB ((bf16_t*)(WSP() + WS_PB))
#define gates ((float*)(WSP() + WS_GATES))
#define rs ((float*)(WSP() + WS_RS))
#define XBA ((bf16_t*)(WSP() + WS_XBA))
#define XBB ((bf16_t*)(WSP() + WS_XBB))
#define Z ((bf16_t*)(WSP() + WS_Z))
    LAS float* ssq = (LAS float*)(lds + SSQ_OFF);
    LAS float* rsl = (LAS float*)(lds + RSL_OFF);
#define ZERO_SSQ() do { FRESH_IDS; if (tid < 256) { *(LAS f32x4*)(ssq + tid * 4) = zero4(); } } while (0)
#define WRITE_RS() do { FRESH_IDS; if (tid < 256) { const float s_ = (ssq[tid * 4] + ssq[tid * 4 + 1]) + (ssq[tid * 4 + 2] + ssq[tid * 4 + 3]); const float r_ = 1.f / sqrtf(s_ * (1.f / DM) + EPS); rs[pm * 256 + tid] = r_; rsl[tid] = r_; } } while (0)

#if PROBE_MODE == 3
    { FRESH_IDS;
      prep_weights(P, lds, bx * 8 + wave, G * 8, wave, lane);
      for (int rr = wave; rr < 256; rr += 8) { const size_t row = (size_t)pm * 256 + rr;
        const f32x4* xr = (const f32x4*)(P.x + row * DM) + lane; f32x4 v[4]; float s = 0.f;
#pragma unroll
        for (int j = 0; j < 4; ++j) { v[j] = __builtin_nontemporal_load(xr + 64 * j); s += (v[j][0] * v[j][0] + v[j][1] * v[j][1]) + (v[j][2] * v[j][2] + v[j][3] * v[j][3]); }
        s = wave_sum(s, lane);
        u32x2* o = (u32x2*)(XBA + row * DM) + lane;
#pragma unroll
        for (int j = 0; j < 4; ++j) { u32x2 w; w.x = pk2(v[j][0], v[j][1]); w.y = pk2(v[j][2], v[j][3]); o[64 * j] = w; }
        if (lane == 0) rs[row] = 1.f / sqrtf(s * (1.f / DM) + EPS); } }
    __syncthreads();
#endif
    { FRESH_IDS;
      prep_weights(P, lds, bx * 8 + wave, G * 8, wave, lane);
      for (int rr = wave; rr < 256; rr += 8) { const size_t row = (size_t)pm * 256 + rr;
        const f32x4* xr = (const f32x4*)(P.x + row * DM) + lane; f32x4 v[4]; float s = 0.f;
#pragma unroll
        for (int j = 0; j < 4; ++j) { v[j] = __builtin_nontemporal_load(xr + 64 * j); s += (v[j][0] * v[j][0] + v[j][1] * v[j][1]) + (v[j][2] * v[j][2] + v[j][3] * v[j][3]); }
        s = wave_sum(s, lane);
        u32x2* o = (u32x2*)(XBA + row * DM) + lane;
#pragma unroll
        for (int j = 0; j < 4; ++j) { u32x2 w; w.x = pk2(v[j][0], v[j][1]); w.y = pk2(v[j][2], v[j][3]); o[64 * j] = w; }
        if (lane == 0) { const float r_ = 1.f / sqrtf(s * (1.f / DM) + EPS); rs[row] = r_; rsl[rr] = r_; } } }
    if (wave_s == 0 && lane_id_asm() == 0) __hip_atomic_fetch_add(bar_w + 16 + xcd_, 1u, __ATOMIC_RELAXED, __HIP_MEMORY_SCOPE_AGENT);
    GSYNC();
    { unsigned nl = 0, nx = 0;
#pragma unroll
      for (unsigned j = 0; j < 16; ++j) { const unsigned c_ = __hip_atomic_load(bar_w + 16 + j, __ATOMIC_RELAXED, __HIP_MEMORY_SCOPE_AGENT); nx += c_ > 0u ? 1u : 0u; nl = j == xcd_ ? c_ : nl; }
      bar_nloc = (unsigned)__builtin_amdgcn_readfirstlane((int)(nl > 0u ? nl : 1u)); bar_nx = (unsigned)__builtin_amdgcn_readfirstlane((int)(nx > 0u ? nx : 1u)); }

    for (int l = 0; l < DEPTH; ++l) {
        bf16_t* Wl = Wall + (size_t)l * LAYER_W;
        { pg8::Gemm g{XBA, Wl + OFF_WIN, DM, DM, wave_s}; pg8::RowOrder S{pm0, NIN_PAD / 256}; pg8::EpiZ E{Z, gates, rsl};
          pg8::gemm_phase<pg8::EpiZ, pg8::RowOrder>(lds, g, S, E);
#if PROBE_MODE == 2
          pg8::gemm_phase<pg8::EpiZ, pg8::RowOrder>(lds, g, S, E);
#endif
          }
        ABAR();
#if PROBE_MODE == 1 || PROBE_MODE == 6
        { FRESH_IDS; build_lut(P, lds, tid); __syncthreads(); attention_phase(P, lds, l, pm, wave, lane, P.out == nullptr); __syncthreads(); }
#endif
#if PROBE_MODE == 1 || PROBE_MODE == 7
        { FRESH_IDS; mlstm_state_phase(P, lds, l, pm, wave, lane); __syncthreads(); }
#endif
        if (!SKIP_ATTN) { FRESH_IDS;
            build_lut(P, lds, tid);
            __syncthreads();
            attention_phase(P, lds, l, pm, wave, lane);
        }
        __syncthreads();
        if (!SKIP_MLSTM) { FRESH_IDS; mlstm_state_phase(P, lds, l, pm, wave, lane); }
        ABAR();
#if PROBE_MODE == 1 || PROBE_MODE == 8
        { FRESH_IDS; mlstm_scan_phase(P, lds, bx, G, tid, P.out == nullptr); }
#endif
        if (!SKIP_MLSTM) { FRESH_IDS; mlstm_scan_phase(P, lds, bx, G, tid); }
        ABAR();
#if PROBE_MODE == 1 || PROBE_MODE == 9
        { FRESH_IDS; mlstm_out_phase(P, lds, l, pm, wave, lane); __syncthreads(); }
#endif
        if (!SKIP_MLSTM) { FRESH_IDS; mlstm_out_phase(P, lds, l, pm, wave, lane); }
        ZERO_SSQ();
        LOCAL_SEAM();
#if PROBE_MODE == 5
        { pg8::Gemm g{Z, Wl + OFF_WOUT, ZLD, DM, wave_s}; pg8::RowOrder S{pm0, 4}; pg8::EpiResid<false> E{XBA, XBA, nullptr, ssq, (P.out == nullptr)};
          pg8::gemm_phase<pg8::EpiResid<false>, pg8::RowOrder>(lds, g, S, E); }
        __syncthreads();
#endif
        { pg8::Gemm g{Z, Wl + OFF_WOUT, ZLD, DM, wave_s}; pg8::RowOrder S{pm0, 4}; pg8::EpiResid<false> E{XBA, XBA, nullptr, ssq, true};
          pg8::gemm_phase<pg8::EpiResid<false>, pg8::RowOrder>(lds, g, S, E); }
        __syncthreads();
        WRITE_RS();
        LOCAL_SEAM();
        { pg8::Gemm g{XBA, Wl + OFF_WUP, DM, DM, wave_s}; pg8::RowOrder S{pm0, NUP / 256}; pg8::EpiSwiGLU E{Z, rsl};
          pg8::gemm_phase<pg8::EpiSwiGLU, pg8::RowOrder>(lds, g, S, E);
#if PROBE_MODE == 2
          pg8::gemm_phase<pg8::EpiSwiGLU, pg8::RowOrder>(lds, g, S, E);
#endif
          }
        ZERO_SSQ();
        LOCAL_SEAM();
#if PROBE_MODE == 5
        { pg8::Gemm g{Z + ACT_OFF, Wl + OFF_WDOWN, ZLD, DFF, wave_s}; pg8::RowOrder S{pm0, 4}; pg8::EpiResid<false> E{XBA, XBB, nullptr, ssq, (P.out == nullptr)};
          pg8::gemm_phase<pg8::EpiResid<false>, pg8::RowOrder>(lds, g, S, E); }
        __syncthreads();
#endif
        { pg8::Gemm g{Z + ACT_OFF, Wl + OFF_WDOWN, ZLD, DFF, wave_s}; pg8::RowOrder S{pm0, 4}; pg8::EpiResid<false> E{XBA, XBB, nullptr, ssq, true};
          pg8::gemm_phase<pg8::EpiResid<false>, pg8::RowOrder>(lds, g, S, E); }
        { FRESH_IDS;
          for (int r0 = wave; r0 < 256; r0 += 64) {
            f32x4 v[8];
#pragma unroll
            for (int j = 0; j < 8; ++j) { const size_t row = (size_t)pm * 256 + r0 + 8 * j; v[j] = __builtin_nontemporal_load((const f32x4*)(P.p + ((size_t)l * MTOK + row) * PLE) + lane); }
#pragma unroll
            for (int j = 0; j < 8; ++j) { const size_t row = (size_t)pm * 256 + r0 + 8 * j; u32x2 w; w.x = pk2(v[j][0], v[j][1]); w.y = pk2(v[j][2], v[j][3]); *((u32x2*)(PB + row * PLE) + lane) = w; } } }
        LOCAL_SEAM();
        { pg8::Gemm g{XBB, Wl + OFF_WG, DM, DM, wave_s}; pg8::RowOrder S{pm0, 4}; pg8::EpiSigmoid E{Z};
          pg8::gemm_phase<pg8::EpiSigmoid, pg8::RowOrder>(lds, g, S, E);
#if PROBE_MODE == 2
          pg8::gemm_phase<pg8::EpiSigmoid, pg8::RowOrder>(lds, g, S, E);
#endif
          }
        ZERO_SSQ();
        LOCAL_SEAM();
#if PROBE_MODE == 5
        { pg8::Gemm g{PB, Wl + OFF_WP, PLE, PLE, wave_s}; pg8::RowOrder S{pm0, 4}; pg8::EpiResid<true> E{XBB, XBA, Z, ssq, (P.out == nullptr)};
          pg8::gemm_phase<pg8::EpiResid<true>, pg8::RowOrder>(lds, g, S, E); }
        __syncthreads();
#endif
        { pg8::Gemm g{PB, Wl + OFF_WP, PLE, PLE, wave_s}; pg8::RowOrder S{pm0, 4}; pg8::EpiResid<true> E{XBB, XBA, Z, ssq, true};
          pg8::gemm_phase<pg8::EpiResid<true>, pg8::RowOrder>(lds, g, S, E); }
        __syncthreads();
        WRITE_RS();
        LOCAL_SEAM();
    }
    { FRESH_IDS;
      for (int r0 = wave; r0 < 256; r0 += 32) {
        u32x2 v[4][4]; float sc[4];
#pragma unroll
        for (int q = 0; q < 4; ++q) { const size_t row = (size_t)pm * 256 + r0 + 8 * q; sc[q] = rs[row]; const u32x2* xr = (const u32x2*)(XBA + row * DM) + lane;
#pragma unroll
            for (int j = 0; j < 4; ++j) v[q][j] = xr[64 * j]; }
        const f32x4* gr = (const f32x4*)P.final_norm + lane;
#pragma unroll
        for (int q = 0; q < 4; ++q) { const size_t row = (size_t)pm * 256 + r0 + 8 * q; f32x4* orow = (f32x4*)(P.out + row * DM) + lane;
#pragma unroll
            for (int j = 0; j < 4; ++j) { const f32x4 gg = gr[64 * j]; const u32x2 w = v[q][j];
                __builtin_nontemporal_store((f32x4){bflo(w.x) * sc[q] * gg[0], bfhi(w.x) * sc[q] * gg[1], bflo(w.y) * sc[q] * gg[2], bfhi(w.y) * sc[q] * gg[3]}, orow + 64 * j); } } } }
}

extern "C" void kernel_launch(void* const* d_in, const int* in_sizes, int n_in, void* d_out, int out_size, void* d_ws, size_t ws_size, hipStream_t stream) {
    static int ready = 0;
    if (ready == 0) {
        if (n_in != 16 || out_size != MTOK * DM || ws_size < WS_END) { fprintf(stderr, "kernel_launch: unexpected sizes (n_in %d, out %d, ws %zu)\n", n_in, out_size, ws_size); ready = -1; return; }
        if (hipFuncSetAttribute((const void*)fwd_kernel, hipFuncAttributeMaxDynamicSharedMemorySize, LDS_BYTES) != hipSuccess) { fprintf(stderr, "kernel_launch: hipFuncSetAttribute failed\n"); ready = -1; return; }
        int dev = 0, cus = 0, per_cu = 0;
        (void)hipGetDevice(&dev); (void)hipDeviceGetAttribute(&cus, hipDeviceAttributeMultiprocessorCount, dev);
        (void)hipOccupancyMaxActiveBlocksPerMultiprocessor(&per_cu, (const void*)fwd_kernel, 512, LDS_BYTES);
        if (cus != 256 || per_cu < 1) fprintf(stderr, "kernel_launch: note: %d CUs, %d blocks/CU (kernel expects 256 x 1)\n", cus, per_cu);
        (void)hipGetLastError();
        ready = 1;
    }
    if (ready < 0) return;
    KParams P{};
    P.x = (const float*)d_in[0]; P.p = (const float*)d_in[1]; P.rel_bias = (const float*)d_in[2]; P.attn_norm = (const float*)d_in[3]; P.w_in = (const float*)d_in[4];
    P.qk_conv = (const float*)d_in[5]; P.gate_bias = (const float*)d_in[6]; P.sink = (const float*)d_in[7]; P.mlstm_norm = (const float*)d_in[8]; P.w_out = (const float*)d_in[9];
    P.ffn_norm = (const float*)d_in[10]; P.w_up = (const float*)d_in[11]; P.w_down = (const float*)d_in[12]; P.ple_proj = (const float*)d_in[13]; P.ple_gate = (const float*)d_in[14];
    P.final_norm = (const float*)d_in[15]; P.out = (float*)d_out; P.ws = (unsigned char*)d_ws;
    (void)hipMemsetAsync(d_ws, 0, 256, stream);
    void* args[] = {&P};
    hipError_t e = hipLaunchCooperativeKernel((const void*)fwd_kernel, dim3(256), dim3(512), args, LDS_BYTES, stream);
    if (e != hipSuccess) fprintf(stderr, "kernel_launch: cooperative launch failed: %s\n", hipGetErrorString(e));
}
```

```cpp
#include <hip/hip_runtime.h>
#include <hip/hip_cooperative_groups.h>
#include <cstdio>
#include <cstdint>
namespace cg = cooperative_groups;

#define LAS __attribute__((address_space(3)))
#define DI __device__ __forceinline__
typedef unsigned short bf16_t;
typedef short bf16x8 __attribute__((ext_vector_type(8)));
typedef short s16x4 __attribute__((ext_vector_type(4)));
typedef float f32x4 __attribute__((ext_vector_type(4)));
typedef float f32x2 __attribute__((ext_vector_type(2)));
typedef unsigned u32x4 __attribute__((ext_vector_type(4)));
typedef unsigned u32x2 __attribute__((ext_vector_type(2)));
typedef __bf16 bf16v2 __attribute__((ext_vector_type(2)));

constexpr int NB = 8, SEQ = 8192, DM = 1024, DEPTH = 4, MTOK = NB * SEQ;
constexpr int ZLD = 3200, NIN_PAD = 3328, DFF = 2816, NUP = 2 * DFF, PLE = 256, DIN = 3224;
constexpr int QA = 0, QB = 384, QC = 640, KA = 1024, KB = 1408, KC = 1536, VA = 1920, VB = 2304, VC = 2432, OC = 2816;
constexpr int ACT_OFF = 384;
constexpr float LOG2E = 1.4426950408889634f;
constexpr float QSCALE = 0.125f * LOG2E;
constexpr float EPS = 1e-6f;
constexpr float NEGBIG = -1e30f;
constexpr int NSEQ = 2 * NB * 6, NCH = SEQ / 64;

constexpr size_t OFF_WIN = 0, OFF_WOUT = OFF_WIN + (size_t)NIN_PAD * DM, OFF_WUP = OFF_WOUT + (size_t)DM * DM, OFF_WDOWN = OFF_WUP + (size_t)NUP * DM,
                 OFF_WP = OFF_WDOWN + (size_t)DM * DFF, OFF_WG = OFF_WP + (size_t)DM * PLE, LAYER_W = OFF_WG + (size_t)DM * DM;
constexpr size_t MiB = 1u << 20;
constexpr size_t WS_W = 1 * MiB, WS_PB = 112 * MiB, WS_GATES = 144 * MiB, WS_RS = 150 * MiB, WS_NB = 151 * MiB, WS_ML = 153 * MiB, WS_BL = WS_ML + 256 * 1024,
                 WS_MP = WS_ML + 512 * 1024, WS_QCONV = 154 * MiB, WS_KCONV = 202 * MiB, WS_XBA = 250 * MiB, WS_XBB = 378 * MiB, WS_Z = 506 * MiB, WS_CT = 906 * MiB,
                 WS_END = 1002 * MiB;
static_assert(WS_W + 4 * LAYER_W * 2 <= WS_PB, "weights");
static_assert(WS_Z + (size_t)MTOK * ZLD * 2 <= WS_CT, "z");
static_assert(WS_CT + (size_t)NSEQ * NCH * 4096 * 2 <= WS_END, "ct");

constexpr int LDS_BYTES = 155648;
constexpr int RING_BYTES = 131072, SSQ_OFF = 131072, RSL_OFF = 151552;

DI unsigned pk2(float lo, float hi) { f32x2 v = {lo, hi}; bf16v2 b = __builtin_convertvector(v, bf16v2); return __builtin_bit_cast(unsigned, b); }
DI float bf2f(unsigned short u) { return __uint_as_float(((unsigned)u) << 16); }
DI float bflo(unsigned u) { return __uint_as_float(u << 16); }
DI float bfhi(unsigned u) { return __uint_as_float(u & 0xffff0000u); }
DI float ex2(float x) { return __builtin_amdgcn_exp2f(x); }
DI float fexp(float x) { return __builtin_amdgcn_exp2f(x * LOG2E); }
DI float frcp(float x) { return __builtin_amdgcn_rcpf(x); }
DI float sigmoidf_(float x) { return frcp(1.f + fexp(-x)); }
DI f32x4 mfma16(bf16x8 a, bf16x8 b, f32x4 c) { return __builtin_amdgcn_mfma_f32_16x16x32_bf16(a, b, c, 0, 0, 0); }
DI f32x4 zero4() { float z; asm volatile("v_mov_b32 %0, 0" : "=v"(z)); return (f32x4){z, z, z, z}; }
DI s16x4 trread(LAS unsigned char* p) { return __builtin_amdgcn_ds_read_tr16_b64_v4i16((LAS s16x4*)p); }
DI bf16x8 cat8(s16x4 a, s16x4 b) { return __builtin_shufflevector(a, b, 0, 1, 2, 3, 4, 5, 6, 7); }
DI float shx(float v, int mask, int lane) { return __builtin_bit_cast(float, __builtin_amdgcn_ds_bpermute((lane ^ mask) << 2, __builtin_bit_cast(int, v))); }
DI float shi(float v, int idx) { return __builtin_bit_cast(float, __builtin_amdgcn_ds_bpermute(idx << 2, __builtin_bit_cast(int, v))); }
DI float xmax4(float v) {
    const unsigned x = __builtin_bit_cast(unsigned, v);
    const auto r = __builtin_amdgcn_permlane16_swap(x, x, false, false); unsigned r0 = r[0], r1 = r[1]; asm volatile("" : "+v"(r0), "+v"(r1));
    const float a = __builtin_bit_cast(float, r0), b = __builtin_bit_cast(float, r1); const float c = a > b ? a : b;
    const unsigned y = __builtin_bit_cast(unsigned, c);
    const auto q = __builtin_amdgcn_permlane32_swap(y, y, false, false); unsigned q0 = q[0], q1 = q[1]; asm volatile("" : "+v"(q0), "+v"(q1));
    const float d = __builtin_bit_cast(float, q0), e = __builtin_bit_cast(float, q1); return d > e ? d : e;
}
DI float xsum4(float v) {
    const unsigned x = __builtin_bit_cast(unsigned, v);
    const auto r = __builtin_amdgcn_permlane16_swap(x, x, false, false); unsigned r0 = r[0], r1 = r[1]; asm volatile("" : "+v"(r0), "+v"(r1));
    const float c = __builtin_bit_cast(float, r0) + __builtin_bit_cast(float, r1);
    const unsigned y = __builtin_bit_cast(unsigned, c);
    const auto q = __builtin_amdgcn_permlane32_swap(y, y, false, false); unsigned q0 = q[0], q1 = q[1]; asm volatile("" : "+v"(q0), "+v"(q1));
    return __builtin_bit_cast(float, q0) + __builtin_bit_cast(float, q1);
}
DI int lane_id_asm() { int l_; asm volatile("v_mbcnt_lo_u32_b32 %0, -1, 0\n\tv_mbcnt_hi_u32_b32 %0, -1, %0" : "=v"(l_)); return l_; }
#define WAVE_LDS_FENCE() asm volatile("s_waitcnt lgkmcnt(0)" ::: "memory")
#define LOCAL_SEAM() do { asm volatile("s_waitcnt vmcnt(0) lgkmcnt(0)" ::: "memory"); __syncthreads(); __builtin_amdgcn_fence(__ATOMIC_ACQUIRE, "workgroup"); } while (0)

namespace pg8 {
constexpr int BM = 256, BK = 64, HALF = 128, HTB = HALF * BK * 2, STAGE_BYTES = 8 * HTB;
DI int lds_byte(int r, int c) { const int st = (r >> 4) * 2 + (c >> 5), rr = r & 15, cc = c & 31, ob = rr * 64 + cc * 2; return st * 1024 + (ob ^ (((ob >> 9) & 1) << 5)); }
DI void stage_rc(int b, int& R, int& C) { const int st = b / 1024, sb = b % 1024, swz = sb ^ (((sb >> 9) & 1) << 5); R = (st >> 1) * 16 + swz / 64; C = (st & 1) * 32 + (swz % 64) / 2; }
DI int perm32(int rho) { const int n = rho >> 4, i = rho & 15; return 8 * (i >> 2) + 4 * n + (i & 3); }
struct Unit { int pm, pn; };
struct Gemm { const bf16_t* A; const bf16_t* Bt; int lda, K, wave; };
struct RowOrder {
    int pm, nN;
    DI bool next(int i, Unit& u) const { if (i >= nN) return false; u.pm = pm; u.pn = i; return true; }
};

template <class Epi, class Sched>
DI void gemm_phase(LAS unsigned char* lds, const Gemm g, const Sched& S, const Epi& E) {
    int tid = g.wave * 64 + lane_id_asm(); asm volatile("" : "+v"(tid));
    const int wid = __builtin_amdgcn_readfirstlane(tid >> 6), lane = tid & 63, wr = wid >> 2, wc = wid & 3, fr = lane & 15, fq = lane >> 4;
    const int K = g.K, nt = K / BK, lda = g.lda;
    unsigned voffA[2], voffB[2];
#pragma unroll
    for (int i = 0; i < 2; ++i) { int R, C; stage_rc(tid * 16 + i * 8192, R, C); const int Rb = Epi::PERM ? ((R & ~31) + perm32(R & 31)) : R;
        voffA[i] = (unsigned)(R * lda + C) * 2u; voffB[i] = (unsigned)(Rb * K + C) * 2u; }
    const size_t kstep = (size_t)(BK * 2);
    const size_t hsA = (size_t)HALF * lda * 2, hsB = (size_t)HALF * K * 2;
    const size_t tsA = 2 * hsA, tsB = 2 * hsB;
    const unsigned ldsw = (unsigned)wid * 1024u;
    const int aoff = lds_byte(wr * 64 + fr, fq * 8), boff = lds_byte(wc * 32 + fr, fq * 8);
#define PG8_SA(b, h) (((b) * 2 + (h)) * HTB)
#define PG8_SB(b, h) ((4 + (b) * 2 + (h)) * HTB)
#define PG8_STAGE(bufoff, gbase, voff) do { _Pragma("unroll") for (int _i = 0; _i < 2; ++_i) \
        __builtin_amdgcn_global_load_lds((const unsigned*)((const char*)(gbase) + (voff)[_i]), (LAS unsigned*)(lds + (bufoff) + ldsw + _i * 8192), 16, 0, 0); } while (0)
#define PG8_LDA(dst, b, h) do { _Pragma("unroll") for (int m = 0; m < 4; ++m) _Pragma("unroll") for (int k = 0; k < 2; ++k) dst[m][k] = *(const LAS bf16x8*)(lds + PG8_SA(b, h) + aoff + m * 2048 + k * 1024); } while (0)
#define PG8_LDB(dst, b, h) do { _Pragma("unroll") for (int n = 0; n < 2; ++n) _Pragma("unroll") for (int k = 0; k < 2; ++k) dst[n][k] = *(const LAS bf16x8*)(lds + PG8_SB(b, h) + boff + n * 2048 + k * 1024); } while (0)
#define PG8_MMA(ai, bj, At, Bt) do { __builtin_amdgcn_s_setprio(1); _Pragma("unroll") for (int m = 0; m < 4; ++m) _Pragma("unroll") for (int n = 0; n < 2; ++n) _Pragma("unroll") for (int k = 0; k < 2; ++k) \
        acc[ai][bj][m][n] = __builtin_amdgcn_mfma_f32_16x16x32_bf16(Bt[n][k], At[m][k], acc[ai][bj][m][n], 0, 0, 0); __builtin_amdgcn_s_setprio(0); } while (0)
#define PG8_WAIT_V(n) asm volatile("s_waitcnt vmcnt(" #n ")" ::: "memory")
#define PG8_WAIT_L(n) asm volatile("s_waitcnt lgkmcnt(" #n ")" ::: "memory")
#define PG8_WAIT_VSEL(sel) do { if constexpr (Epi::NST == 16) asm volatile("s_cmp_eq_u32 %0, 0\n\ts_cbranch_scc1 .Lws%=\n\ts_waitcnt vmcnt(24)\n\ts_branch .Lwe%=\n.Lws%=:\n\ts_waitcnt vmcnt(8)\n.Lwe%=:" :: "s"(sel) : "scc", "memory"); \
    else asm volatile("s_cmp_eq_u32 %0, 0\n\ts_cbranch_scc1 .Lws%=\n\ts_waitcnt vmcnt(16)\n\ts_branch .Lwe%=\n.Lws%=:\n\ts_waitcnt vmcnt(8)\n.Lwe%=:" :: "s"(sel) : "scc", "memory"); } while (0)
#define PG8_BAR __builtin_amdgcn_s_barrier()
#define PG8_SCHED __builtin_amdgcn_sched_barrier(0)
    Unit cur, nxt; int ui = 0;
    if (!S.next(0, cur)) return;
    f32x4 acc[2][2][4][2];
    { float z0; asm volatile("v_mov_b32 %0, 0" : "=v"(z0));
#pragma unroll
    for (int a = 0; a < 2; ++a)
#pragma unroll
        for (int b = 0; b < 2; ++b)
#pragma unroll
            for (int m = 0; m < 4; ++m)
#pragma unroll
                for (int n = 0; n < 2; ++n) acc[a][b][m][n] = (f32x4){z0, z0, z0, z0}; }
    bf16x8 At[4][2], B0[2][2], B1[2][2];
    const char* cA = (const char*)g.A + (size_t)cur.pm * tsA; const char* cB = (const char*)g.Bt + (size_t)cur.pn * tsB;
    PG8_STAGE(PG8_SB(0, 0), cB, voffB); PG8_STAGE(PG8_SB(0, 1), cB + hsB, voffB); PG8_STAGE(PG8_SA(0, 0), cA, voffA); PG8_STAGE(PG8_SA(0, 1), cA + hsA, voffA);
    if (wr == 1) PG8_BAR;
    PG8_WAIT_V(2); PG8_BAR;
    PG8_STAGE(PG8_SB(1, 0), cB + kstep, voffB); PG8_STAGE(PG8_SA(1, 0), cA + kstep, voffA); PG8_STAGE(PG8_SB(1, 1), cB + hsB + kstep, voffB);
    PG8_WAIT_V(6); PG8_BAR;
    for (;;) {
        const bool has_next = S.next(ui + 1, nxt);
        const char* nA = has_next ? (const char*)g.A + (size_t)nxt.pm * tsA : cA; const char* nB = has_next ? (const char*)g.Bt + (size_t)nxt.pn * tsB : cB;
        for (int t = 0; t < nt; t += 2) {
            const bool last = (t == nt - 2);
            const int relax = ((t == 0) && (ui > 0)) ? 1 : 0;
            const char* a1 = cA + (size_t)(t + 1) * kstep;
            const char* a2 = last ? nA : cA + (size_t)(t + 2) * kstep; const char* b2 = last ? nB : cB + (size_t)(t + 2) * kstep;
            const char* a3 = a2 + kstep; const char* b3 = b2 + kstep;
            PG8_LDB(B0, 0, 0); PG8_LDB(B1, 0, 1); PG8_SCHED; PG8_LDA(At, 0, 0); PG8_STAGE(PG8_SA(1, 1), a1 + hsA, voffA);
            PG8_WAIT_VSEL(__builtin_amdgcn_readfirstlane(relax)); PG8_WAIT_L(0); PG8_BAR; PG8_MMA(0, 0, At, B0); PG8_MMA(0, 1, At, B1); PG8_BAR; PG8_SCHED;
            PG8_LDA(At, 0, 1); PG8_STAGE(PG8_SB(0, 0), b2, voffB); PG8_STAGE(PG8_SB(0, 1), b2 + hsB, voffB); PG8_STAGE(PG8_SA(0, 0), a2, voffA);
            PG8_WAIT_VSEL(__builtin_amdgcn_readfirstlane(relax)); PG8_WAIT_L(0); PG8_BAR; PG8_MMA(1, 0, At, B0); PG8_MMA(1, 1, At, B1); PG8_BAR; PG8_SCHED;
            PG8_LDB(B0, 1, 0); PG8_LDB(B1, 1, 1); PG8_SCHED; PG8_LDA(At, 1, 0); PG8_STAGE(PG8_SA(0, 1), a2 + hsA, voffA);
            PG8_WAIT_V(8); PG8_WAIT_L(0); PG8_BAR; PG8_MMA(0, 0, At, B0); PG8_MMA(0, 1, At, B1); PG8_BAR; PG8_SCHED;
            PG8_LDA(At, 1, 1); PG8_STAGE(PG8_SB(1, 0), b3, voffB); PG8_STAGE(PG8_SB(1, 1), b3 + hsB, voffB); PG8_STAGE(PG8_SA(1, 0), a3, voffA);
            PG8_WAIT_V(8); PG8_WAIT_L(0); PG8_BAR; PG8_MMA(1, 0, At, B0); PG8_MMA(1, 1, At, B1); PG8_BAR; PG8_SCHED;
        }
        if (wr == 0) PG8_BAR;
        E(acc, cur, wr, wc, fr, fq);
        if (!has_next) break;
        { float z0; asm volatile("v_mov_b32 %0, 0" : "=v"(z0));
#pragma unroll
        for (int a = 0; a < 2; ++a)
#pragma unroll
            for (int b = 0; b < 2; ++b)
#pragma unroll
                for (int m = 0; m < 4; ++m)
#pragma unroll
                    for (int n = 0; n < 2; ++n) acc[a][b][m][n] = (f32x4){z0, z0, z0, z0}; }
        cur = nxt; cA = nA; cB = nB; ++ui;
        if (wr == 1) PG8_BAR;
    }
    PG8_WAIT_V(0);
    PG8_BAR;
#undef PG8_SA
#undef PG8_SB
#undef PG8_STAGE
#undef PG8_LDA
#undef PG8_LDB
#undef PG8_MMA
#undef PG8_WAIT_V
#undef PG8_WAIT_L
#undef PG8_WAIT_VSEL
#undef PG8_BAR
#undef PG8_SCHED
}

struct EpiZ {
    static constexpr bool PERM = true; static constexpr int NST = 16;
    bf16_t* Z; float* gates; const LAS float* rs;
    DI void operator()(const f32x4 (&acc)[2][2][4][2], const Unit& u, int wr, int wc, int fr, int fq) const {
        asm volatile("" : "+v"(fr), "+v"(fq));
        const int row0 = u.pm * BM + wr * 64 + fr, col0 = u.pn * BM + wc * 32 + 8 * fq;
#pragma unroll
        for (int ai = 0; ai < 2; ++ai)
#pragma unroll
            for (int m = 0; m < 4; ++m) { const int row = row0 + ai * HALF + m * 16; const float sc = rs[row - u.pm * BM];
#pragma unroll
                for (int bj = 0; bj < 2; ++bj) { const int col = col0 + bj * HALF; const f32x4 v0 = acc[ai][bj][m][0] * sc, v1 = acc[ai][bj][m][1] * sc;
                    if (col < ZLD) { u32x4 w; w.x = pk2(v0[0], v0[1]); w.y = pk2(v0[2], v0[3]); w.z = pk2(v1[0], v1[1]); w.w = pk2(v1[2], v1[3]); __builtin_nontemporal_store(w, (u32x4*)(Z + (size_t)row * ZLD + col)); }
                    else if (col < DIN) { float* gp = gates + (size_t)row * 24 + (col - ZLD); *(f32x4*)gp = v0; *(f32x4*)(gp + 4) = v1; } }
                asm volatile("" ::: "memory"); }
    }
};
struct EpiSwiGLU {
    static constexpr bool PERM = true; static constexpr int NST = 8;
    bf16_t* Z; const LAS float* rs;
    DI void operator()(const f32x4 (&acc)[2][2][4][2], const Unit& u, int wr, int wc, int fr, int fq) const {
        asm volatile("" : "+v"(fr), "+v"(fq));
        const int row0 = u.pm * BM + wr * 64 + fr, col0 = ACT_OFF + u.pn * HALF + wc * 32 + 8 * fq;
#pragma unroll
        for (int ai = 0; ai < 2; ++ai)
#pragma unroll
            for (int m = 0; m < 4; ++m) { const int row = row0 + ai * HALF + m * 16; const float sc = rs[row - u.pm * BM]; float o[8];
#pragma unroll
                for (int n = 0; n < 2; ++n)
#pragma unroll
                    for (int i = 0; i < 4; ++i) { const float gg = acc[ai][0][m][n][i] * sc, uu = acc[ai][1][m][n][i] * sc; o[4 * n + i] = gg * sigmoidf_(gg) * uu; }
                u32x4 w; w.x = pk2(o[0], o[1]); w.y = pk2(o[2], o[3]); w.z = pk2(o[4], o[5]); w.w = pk2(o[6], o[7]);
                __builtin_nontemporal_store(w, (u32x4*)(Z + (size_t)row * ZLD + col0));
                asm volatile("" ::: "memory"); }
    }
};
struct EpiSigmoid {
    static constexpr bool PERM = true; static constexpr int NST = 16;
    bf16_t* Z;
    DI void operator()(const f32x4 (&acc)[2][2][4][2], const Unit& u, int wr, int wc, int fr, int fq) const {
        asm volatile("" : "+v"(fr), "+v"(fq));
        const int row0 = u.pm * BM + wr * 64 + fr, col0 = u.pn * BM + wc * 32 + 8 * fq;
#pragma unroll
        for (int ai = 0; ai < 2; ++ai)
#pragma unroll
            for (int m = 0; m < 4; ++m) { const int row = row0 + ai * HALF + m * 16;
#pragma unroll
                for (int bj = 0; bj < 2; ++bj) { const f32x4 v0 = acc[ai][bj][m][0], v1 = acc[ai][bj][m][1]; u32x4 w;
                    w.x = pk2(sigmoidf_(v0[0]), sigmoidf_(v0[1])); w.y = pk2(sigmoidf_(v0[2]), sigmoidf_(v0[3])); w.z = pk2(sigmoidf_(v1[0]), sigmoidf_(v1[1])); w.w = pk2(sigmoidf_(v1[2]), sigmoidf_(v1[3]));
                    *(u32x4*)(Z + (size_t)row * ZLD + col0 + bj * HALF) = w; }
                asm volatile("" ::: "memory"); }
    }
};
template <bool MUL> struct EpiResid {
    static constexpr bool PERM = true; static constexpr int NST = 16;
    static constexpr int GM = MUL ? 2 : 4;
    const bf16_t* resid; bf16_t* xb; const bf16_t* mul; LAS float* ssq; bool wr_en;
    DI void operator()(const f32x4 (&acc)[2][2][4][2], const Unit& u, int wr, int wc, int fr, int fq) const {
        asm volatile("" : "+v"(fr), "+v"(fq));
        const int col0 = u.pn * BM + wc * 32 + 8 * fq;
#pragma unroll
        for (int ai = 0; ai < 2; ++ai)
#pragma unroll
            for (int mg = 0; mg < 4; mg += GM) {
                u32x4 rv[GM][2], mv[GM][2];
#pragma unroll
                for (int mm = 0; mm < GM; ++mm) { const size_t row = (size_t)(u.pm * BM + ai * HALF + wr * 64 + (mg + mm) * 16 + fr);
#pragma unroll
                    for (int bj = 0; bj < 2; ++bj) { const int col = col0 + bj * HALF; rv[mm][bj] = *(const u32x4*)(resid + row * DM + col);
                        if (MUL) mv[mm][bj] = *(const u32x4*)(mul + row * ZLD + col); } }
#pragma unroll
                for (int mm = 0; mm < GM; ++mm) { const int m = mg + mm; const int rl = ai * HALF + wr * 64 + m * 16 + fr; const size_t row = (size_t)(u.pm * BM + rl); float s = 0.f;
#pragma unroll
                    for (int bj = 0; bj < 2; ++bj) { const int col = col0 + bj * HALF; f32x4 a0 = acc[ai][bj][m][0], a1 = acc[ai][bj][m][1];
                        if (MUL) { const u32x4 q = mv[mm][bj];
                            a0[0] *= bflo(q.x); a0[1] *= bfhi(q.x); a0[2] *= bflo(q.y); a0[3] *= bfhi(q.y); a1[0] *= bflo(q.z); a1[1] *= bfhi(q.z); a1[2] *= bflo(q.w); a1[3] *= bfhi(q.w); }
                        const u32x4 r = rv[mm][bj];
                        const f32x4 x0 = {bflo(r.x) + a0[0], bfhi(r.x) + a0[1], bflo(r.y) + a0[2], bfhi(r.y) + a0[3]};
                        const f32x4 x1 = {bflo(r.z) + a1[0], bfhi(r.z) + a1[1], bflo(r.w) + a1[2], bfhi(r.w) + a1[3]};
                        if (wr_en) { u32x4 w; w.x = pk2(x0[0], x0[1]); w.y = pk2(x0[2], x0[3]); w.z = pk2(x1[0], x1[1]); w.w = pk2(x1[2], x1[3]); *(u32x4*)(xb + row * DM + col) = w; }
                        s += ((x0[0] * x0[0] + x0[1] * x0[1]) + (x0[2] * x0[2] + x0[3] * x0[3])) + ((x1[0] * x1[0] + x1[1] * x1[1]) + (x1[2] * x1[2] + x1[3] * x1[3])); }
                    s = xsum4(s);
                    if (fq == 0 && wr_en) ssq[rl * 4 + wc] += s; }
                asm volatile("" ::: "memory"); }
    }
};
}

struct KParams {
    const float* x; const float* p; const float* rel_bias; const float* attn_norm; const float* w_in; const float* qk_conv; const float* gate_bias; const float* sink;
    const float* mlstm_norm; const float* w_out; const float* ffn_norm; const float* w_up; const float* w_down; const float* ple_proj; const float* ple_gate; const float* final_norm;
    float* out; unsigned char* ws;
};

DI void transpose_item(const float* __restrict__ W, int K, int Nsrc, int n0, int nvalid, const float* __restrict__ gk, float cs,
                       bf16_t* __restrict__ WT, int dst_row0, int k0, LAS float* scr, int lane) {
    const int n4 = (lane & 7) * 4, kr = lane >> 3;
    f32x4 v[8];
#pragma unroll
    for (int i = 0; i < 8; ++i) { const int kk = kr + 8 * i; v[i] = (f32x4){0.f, 0.f, 0.f, 0.f};
        if (n4 < nvalid) v[i] = __builtin_nontemporal_load((const f32x4*)(W + (size_t)(k0 + kk) * Nsrc + n0 + n4)); }
#pragma unroll
    for (int i = 0; i < 8; ++i) { const int kk = kr + 8 * i; const float sc = gk ? gk[k0 + kk] * cs : cs;
        scr[kk * 33 + n4 + 0] = v[i][0] * sc; scr[kk * 33 + n4 + 1] = v[i][1] * sc; scr[kk * 33 + n4 + 2] = v[i][2] * sc; scr[kk * 33 + n4 + 3] = v[i][3] * sc; }
    WAVE_LDS_FENCE();
    const int c8 = lane & 7;
#pragma unroll
    for (int j = 0; j < 4; ++j) { const int n = (lane >> 3) + 8 * j; const LAS float* s = scr + (8 * c8) * 33 + n;
        u32x4 o; o.x = pk2(s[0 * 33], s[1 * 33]); o.y = pk2(s[2 * 33], s[3 * 33]); o.z = pk2(s[4 * 33], s[5 * 33]); o.w = pk2(s[6 * 33], s[7 * 33]);
        *(u32x4*)(WT + (size_t)(dst_row0 + n) * K + k0 + 8 * c8) = o; }
    WAVE_LDS_FENCE();
}
constexpr int IT_WIN = 16 * 104, IT_WOUT = 16 * 32, IT_WUP = 16 * 176, IT_WDOWN = 44 * 32, IT_WP = 4 * 32, IT_WG = 16 * 32;
constexpr int IT_LAYER = IT_WIN + IT_WOUT + IT_WUP + IT_WDOWN + IT_WP + IT_WG;

DI void prep_weights(const KParams& P, LAS unsigned char* lds, int gw, int NGW, int wave, int lane) {
    LAS float* scr = (LAS float*)(lds + wave * 16384);
    bf16_t* Wall = (bf16_t*)(P.ws + WS_W);
    for (int it = gw; it < DEPTH * IT_LAYER; it += NGW) {
        const int l = it / IT_LAYER; int r = it % IT_LAYER;
        bf16_t* Wl = Wall + (size_t)l * LAYER_W;
        if (r < IT_WIN) { const int kb = r / 104, jb = r % 104, d0 = 32 * jb; int src = d0, nv = 32; float cs = 1.f;
            if (d0 < 384) { src = d0; cs = QSCALE; } else if (d0 < 640) { src = 1152 + d0 - 384; cs = QSCALE; } else if (d0 < 1024) src = 1664 + d0 - 640;
            else if (d0 < 1408) src = 384 + d0 - 1024; else if (d0 < 1536) src = d0; else if (d0 < 1920) src = 2048 + d0 - 1536;
            else if (d0 < 2304) src = 768 + d0 - 1920; else if (d0 < 2432) src = 1536 + d0 - 2304; else if (d0 < 3200) src = d0;
            else if (d0 == 3200) { src = 3200; nv = 24; } else { src = 0; nv = 0; }
            transpose_item(P.w_in + (size_t)l * DM * DIN, DM, DIN, src, nv, P.attn_norm + l * DM, cs, Wl + OFF_WIN, d0, 64 * kb, scr, lane); continue; }
        r -= IT_WIN;
        if (r < IT_WOUT) { const int kb = r / 32, jb = r % 32; transpose_item(P.w_out + (size_t)l * DM * DM, DM, DM, 32 * jb, 32, nullptr, 1.f, Wl + OFF_WOUT, 32 * jb, 64 * kb, scr, lane); continue; }
        r -= IT_WOUT;
        if (r < IT_WUP) { const int kb = r / 176, jb = r % 176, d0 = 32 * jb, pn = d0 >> 8, c0 = d0 & 255; const int src = c0 < 128 ? 128 * pn + c0 : DFF + 128 * pn + (c0 - 128);
            transpose_item(P.w_up + (size_t)l * DM * NUP, DM, NUP, src, 32, P.ffn_norm + l * DM, 1.f, Wl + OFF_WUP, d0, 64 * kb, scr, lane); continue; }
        r -= IT_WUP;
        if (r < IT_WDOWN) { const int kb = r / 32, jb = r % 32; transpose_item(P.w_down + (size_t)l * DFF * DM, DFF, DM, 32 * jb, 32, nullptr, 1.f, Wl + OFF_WDOWN, 32 * jb, 64 * kb, scr, lane); continue; }
        r -= IT_WDOWN;
        if (r < IT_WP) { const int kb = r / 32, jb = r % 32; transpose_item(P.ple_proj + (size_t)l * PLE * DM, PLE, DM, 32 * jb, 32, nullptr, 1.f, Wl + OFF_WP, 32 * jb, 64 * kb, scr, lane); continue; }
        r -= IT_WP;
        { const int kb = r / 32, jb = r % 32; transpose_item(P.ple_gate + (size_t)l * DM * DM, DM, DM, 32 * jb, 32, nullptr, 1.f, Wl + OFF_WG, 32 * jb, 64 * kb, scr, lane); }
    }
}
DI float wave_sum(float v, int lane) {
#pragma unroll
    for (int o = 1; o < 64; o <<= 1) v += shx(v, o, lane);
    return v;
}
DI float wave_max(float v, int lane) {
#pragma unroll
    for (int o = 1; o < 64; o <<= 1) v = fmaxf(v, shx(v, o, lane));
    return v;
}

constexpr int VROW = 144;
constexpr int VBUF = 32 * VROW;
constexpr int LUTA = 256, LUTAC = 128, LUTB = 320, LUTBC = 160;
constexpr int LUT_BYTES = (18 * LUTA + 4 * LUTB) * 4, PBUF_BYTES = 256 * 136;

template <bool EDGE>
DI void load_kv(const bf16_t* __restrict__ zb, int kcol, int vcol, int dstr, int rd, int u0, int lane, bf16x8 (&kn)[2][2], u32x4 (&vn)[4]) {
    const int r16 = lane & 15, g = lane >> 4;
#pragma unroll
    for (int T = 0; T < 2; ++T) { int pos = dstr * (u0 + 16 * T + r16) + rd; if (EDGE) pos = pos < 0 ? 0 : (pos > SEQ - 1 ? SEQ - 1 : pos);
        const unsigned off = (unsigned)pos * (unsigned)ZLD + (unsigned)(kcol + 8 * g); kn[T][0] = *(const bf16x8*)(zb + off); kn[T][1] = *(const bf16x8*)(zb + off + 32u); }
#pragma unroll
    for (int k = 0; k < 4; ++k) { const int id = lane + 64 * k, row = id >> 3, c16 = id & 7; int pos = dstr * (u0 + row) + rd; if (EDGE) pos = pos < 0 ? 0 : (pos > SEQ - 1 ? SEQ - 1 : pos);
        const unsigned off = (unsigned)pos * (unsigned)ZLD + (unsigned)(vcol + 8 * c16); vn[k] = *(const u32x4*)(zb + off); }
}

struct DescA {
    int rd0, rd1, ub0, ub1, uq0, uq1, tb;
    DI void get(int ci, int g, int& dstr, int& rd, int& u0, int& li) const {
        const int t1 = ci >= 5 ? 1 : 0;
        dstr = 16 - 12 * t1; rd = rd0 + t1 * (rd1 - rd0);
        const int lc = ci - 5 * t1;
        u0 = ub0 + t1 * (ub1 - ub0) + 32 * lc;
        const int uq = uq0 + t1 * (uq1 - uq0);
        li = u0 - uq + 4 * g + LUTAC + tb + t1 * 6 * LUTA; }
};
struct DescB {
    int ub, uq, tb, lc;
    DI void get(int ci, int g, int& dstr, int& rd, int& u0, int& li) const { dstr = 1; rd = 0; u0 = ub + 32 * ci; li = u0 - uq + 4 * g + lc + tb; }
};

template <int NH, int D, bool EDGE, class Desc>
DI void attn_stream(const bf16_t* __restrict__ zb, int kcol, int vcol, int nch, const Desc& ds, const LAS float* lutbase, int lstr,
                    const bf16x8 (&qf)[NH][2], float (&m)[NH], float (&l)[NH], f32x4 (&o)[NH][4], LAS unsigned char* vbase, int lane) {
    const int r16 = lane & 15, g = lane >> 4, q4 = r16 >> 2, p4 = r16 & 3;
    bf16x8 kn[D][2][2]; u32x4 vn[D][4];
#pragma unroll
    for (int j = 0; j < D; ++j) if (j < nch) { int dstr, rd, u0, li; ds.get(j, g, dstr, rd, u0, li); load_kv<EDGE>(zb, kcol, vcol, dstr, rd, u0, lane, kn[j], vn[j]); }
#pragma unroll 1
    for (int c0 = 0; c0 < nch; c0 += D) {
#pragma unroll
        for (int j = 0; j < D; ++j) {
            const int c = c0 + j;
            if (c < nch) {
                int dstr, rd, u0, li; ds.get(c, g, dstr, rd, u0, li);
                LAS unsigned char* vb = vbase + (c & 1) * VBUF;
#pragma unroll
                for (int k = 0; k < 4; ++k) { const int id = lane + 64 * k, row = id >> 3, c16 = id & 7; *(LAS u32x4*)(vb + row * VROW + c16 * 16) = vn[j][k]; }
                f32x4 stt[NH][2];
#pragma unroll
                for (int hh = 0; hh < NH; ++hh)
#pragma unroll
                    for (int T = 0; T < 2; ++T) { f32x4 st = {0.f, 0.f, 0.f, 0.f}; st = mfma16(kn[j][T][0], qf[hh][0], st); st = mfma16(kn[j][T][1], qf[hh][1], st); stt[hh][T] = st; }
                if (c + D < nch) { int d2, r2, u2, l2; ds.get(c + D, g, d2, r2, u2, l2); load_kv<EDGE>(zb, kcol, vcol, d2, r2, u2, lane, kn[j], vn[j]); }
                float rm[2][4];
#pragma unroll
                for (int T = 0; T < 2; ++T)
#pragma unroll
                    for (int i = 0; i < 4; ++i) { const int pos = dstr * (u0 + 16 * T + 4 * g + i) + rd; rm[T][i] = (!EDGE || (unsigned)pos < (unsigned)SEQ) ? 0.f : NEGBIG; }
                bf16x8 vf[4];
#pragma unroll
                for (int c4 = 0; c4 < 4; ++c4) { const s16x4 a0 = trread(vb + (4 * g + q4) * VROW + 32 * c4 + 8 * p4), a1 = trread(vb + (16 + 4 * g + q4) * VROW + 32 * c4 + 8 * p4); vf[c4] = cat8(a0, a1); }
#pragma unroll
                for (int hh = 0; hh < NH; ++hh) {
                    const LAS float* lut = lutbase + hh * lstr + li;
                    float sv[8];
#pragma unroll
                    for (int T = 0; T < 2; ++T) {
#pragma unroll
                        for (int i = 0; i < 4; ++i) sv[4 * T + i] = EDGE ? (stt[hh][T][i] + lut[16 * T + i] + rm[T][i]) : (stt[hh][T][i] + lut[16 * T + i]); }
                    float cm = fmaxf(fmaxf(fmaxf(sv[0], sv[1]), fmaxf(sv[2], sv[3])), fmaxf(fmaxf(sv[4], sv[5]), fmaxf(sv[6], sv[7])));
                    cm = xmax4(cm);
                    const float mn = fmaxf(m[hh], cm), alpha = ex2(m[hh] - mn); m[hh] = mn;
                    float pv[8], ps = 0.f;
#pragma unroll
                    for (int k = 0; k < 8; ++k) { pv[k] = ex2(sv[k] - mn); ps += pv[k]; }
                    l[hh] = l[hh] * alpha + ps;
                    u32x4 pw; pw.x = pk2(pv[0], pv[1]); pw.y = pk2(pv[2], pv[3]); pw.z = pk2(pv[4], pv[5]); pw.w = pk2(pv[6], pv[7]);
                    const bf16x8 pf = __builtin_bit_cast(bf16x8, pw);
#pragma unroll
                    for (int c4 = 0; c4 < 4; ++c4) { o[hh][c4] = o[hh][c4] * alpha; o[hh][c4] = mfma16(vf[c4], pf, o[hh][c4]); }
                }
            }
        }
    }
}

DI void build_lut(const KParams& P, LAS unsigned char* lds, int tid) {
    LAS float* lut = (LAS float*)lds;
    for (int idx = tid; idx < 18 * LUTA + 4 * LUTB; idx += 512) {
        int rel, dil, half, hc;
        if (idx < 18 * LUTA) { const int t = idx / LUTA, cfg = t / 6; rel = idx % LUTA - LUTAC; dil = cfg == 0 ? 16 : (cfg == 1 ? 4 : 1); half = 64; hc = t % 6; }
        else { const int j = idx - 18 * LUTA; rel = j % LUTB - LUTBC; dil = 1; half = 128; hc = 6 + j / LUTB; }
        float v = NEGBIG; const int ar = rel < 0 ? -rel : rel;
        if (ar <= half) { const int n = ar * dil; int bk;
            if (n < 8) bk = n; else { const float nf = (float)n; bk = 8 + (int)(logf(nf / 8.0f) / 4.852030263919617f * 8.0f); bk = bk > 15 ? 15 : bk; }
            if (rel > 0) bk += 16;
            v = P.rel_bias[bk * 10 + hc] * LOG2E; }
        lut[idx] = v;
    }
}

DI void attention_phase(const KParams& P0_, LAS unsigned char* lds, int l, int pm, int wave, int lane, bool wr_en = true) {
    KParams P = P0_; { __attribute__((address_space(1))) unsigned char* w1_ = (__attribute__((address_space(1))) unsigned char*)P.ws; asm volatile("" : "+s"(w1_)); P.ws = (unsigned char*)w1_; }
    bf16_t* Z = (bf16_t*)(P.ws + WS_Z);
    const int r16 = lane & 15, g = lane >> 4;
    const int row0 = pm * 256, b = row0 / SEQ, s0 = row0 % SEQ;
    bf16_t* zb = Z + (size_t)b * SEQ * ZLD;
    const LAS float* lut = (const LAS float*)lds;
    LAS unsigned char* pbuf = lds + LUT_BYTES;
    LAS unsigned char* vbase = lds + LUT_BYTES + PBUF_BYTES + wave * (2 * VBUF);
    const bool edge1 = s0 < 64 || s0 + 256 + 96 > SEQ, edge2 = s0 < 1024 || s0 + 1536 > SEQ, edgeb = s0 < 128 || s0 + 256 + 160 > SEQ;
    for (int h = 0; h < 6; ++h) {
        for (int qg = wave; qg < 16; qg += 8) {
            const int posq = s0 + 16 * qg + r16;
            bf16x8 qf[1][2];
            { const bf16_t* qp = zb + (size_t)posq * ZLD + QA + 64 * h + 8 * g; qf[0][0] = *(const bf16x8*)qp; qf[0][1] = *(const bf16x8*)(qp + 32); }
            float m[1] = {-1e20f}, lsum[1] = {0.f}; f32x4 o[1][4];
#pragma unroll
            for (int c4 = 0; c4 < 4; ++c4) o[0][c4] = zero4();
            { DescB ds; const int U1 = s0 + 16 * qg; ds.ub = U1 - 64; ds.uq = U1 + r16; ds.tb = (12 + h) * LUTA; ds.lc = LUTAC;
              if (edge1) attn_stream<1, 2, true, DescB>(zb, KA + 64 * h, VA + 64 * h, 5, ds, lut, 0, qf, m, lsum, o, vbase, lane);
              else attn_stream<1, 2, false, DescB>(zb, KA + 64 * h, VA + 64 * h, 5, ds, lut, 0, qf, m, lsum, o, vbase, lane); }
            const float lt = xsum4(lsum[0]);
            LAS unsigned char* pq = pbuf + (16 * qg + r16) * 136;
#pragma unroll
            for (int c4 = 0; c4 < 4; ++c4) { const f32x4 v = o[0][c4]; u32x2 w; w.x = pk2(v[0], v[1]); w.y = pk2(v[2], v[3]); *(LAS u32x2*)(pq + (16 * c4 + 4 * g) * 2) = w; }
            if (g == 0) { *(LAS float*)(pq + 128) = m[0]; *(LAS float*)(pq + 132) = lt; }
        }
        __syncthreads();
        for (int rho = wave; rho < 16; rho += 8) {
            const int posq = s0 + rho + 16 * r16;
            bf16x8 qf[1][2];
            { const bf16_t* qp = zb + (size_t)posq * ZLD + QA + 64 * h + 8 * g; qf[0][0] = *(const bf16x8*)qp; qf[0][1] = *(const bf16x8*)(qp + 32); }
            float m[1] = {-1e20f}, lsum[1] = {0.f}; f32x4 o[1][4];
#pragma unroll
            for (int c4 = 0; c4 < 4; ++c4) o[0][c4] = zero4();
            { DescA ds; const int U16 = s0 >> 4, U4 = (s0 >> 2) + (rho >> 2);
              ds.rd0 = rho; ds.rd1 = rho & 3; ds.ub0 = U16 - 64; ds.ub1 = U4 - 64; ds.uq0 = U16 + r16; ds.uq1 = U4 + 4 * r16; ds.tb = h * LUTA;
              if (edge2) attn_stream<1, 2, true, DescA>(zb, KA + 64 * h, VA + 64 * h, 11, ds, lut, 0, qf, m, lsum, o, vbase, lane);
              else attn_stream<1, 2, false, DescA>(zb, KA + 64 * h, VA + 64 * h, 11, ds, lut, 0, qf, m, lsum, o, vbase, lane); }
            const float lt = xsum4(lsum[0]);
            const LAS unsigned char* pq = pbuf + (rho + 16 * r16) * 136;
            const float m1 = *(const LAS float*)(pq + 128), l1 = *(const LAS float*)(pq + 132);
            const float mf = fmaxf(m[0], m1), a0 = ex2(m[0] - mf), a1 = ex2(m1 - mf);
            const float inv = 1.f / (lt * a0 + l1 * a1), f0 = a0 * inv, f1 = a1 * inv;
            bf16_t* yp = zb + (size_t)posq * ZLD + QA + 64 * h + 4 * g;
            if (wr_en)
#pragma unroll
            for (int c4 = 0; c4 < 4; ++c4) { const u32x2 pw = *(const LAS u32x2*)(pq + (16 * c4 + 4 * g) * 2); const f32x4 v = o[0][c4];
                u32x2 w; w.x = pk2(v[0] * f0 + bflo(pw.x) * f1, v[1] * f0 + bfhi(pw.x) * f1); w.y = pk2(v[2] * f0 + bflo(pw.y) * f1, v[3] * f0 + bfhi(pw.y) * f1); *(u32x2*)(yp + 16 * c4) = w; }
        }
        __syncthreads();
    }
    for (int ub = wave; ub < 32; ub += 8) {
        const int kvh = ub >> 4, qg = ub & 15;
        const int posq = s0 + 16 * qg + r16;
        bf16x8 qf[2][2];
#pragma unroll
        for (int hh = 0; hh < 2; ++hh) { const bf16_t* qp = zb + (size_t)posq * ZLD + QB + 64 * (2 * kvh + hh) + 8 * g; qf[hh][0] = *(const bf16x8*)qp; qf[hh][1] = *(const bf16x8*)(qp + 32); }
        float m[2] = {-1e20f, -1e20f}, lsum[2] = {0.f, 0.f}; f32x4 o[2][4];
#pragma unroll
        for (int hh = 0; hh < 2; ++hh)
#pragma unroll
            for (int c4 = 0; c4 < 4; ++c4) o[hh][c4] = zero4();
        const int U0 = s0 + 16 * qg;
        { DescB ds; ds.ub = U0 - 128; ds.uq = U0 + r16; ds.tb = 18 * LUTA + (2 * kvh) * LUTB; ds.lc = LUTBC;
          if (edgeb) attn_stream<2, 2, true, DescB>(zb, KB + 64 * kvh, VB + 64 * kvh, 9, ds, lut, LUTB, qf, m, lsum, o, vbase, lane);
          else attn_stream<2, 2, false, DescB>(zb, KB + 64 * kvh, VB + 64 * kvh, 9, ds, lut, LUTB, qf, m, lsum, o, vbase, lane); }
#pragma unroll
        for (int hh = 0; hh < 2; ++hh) { const int hq = 2 * kvh + hh;
            const float lt = xsum4(lsum[hh]);
            const float sk = P.sink[l * 4 + hq] * LOG2E, mf = fmaxf(m[hh], sk), sc = ex2(m[hh] - mf);
            const float den = lt * sc + ex2(sk - mf), f = sc / den;
            bf16_t* yp = zb + (size_t)posq * ZLD + QB + 64 * hq + 4 * g;
            if (wr_en)
#pragma unroll
            for (int c4 = 0; c4 < 4; ++c4) { const f32x4 v = o[hh][c4] * f; u32x2 w; w.x = pk2(v[0], v[1]); w.y = pk2(v[2], v[3]); *(u32x2*)(yp + 16 * c4) = w; } }
    }
}

DI float logsig(float x) { return fminf(x, 0.f) - log1pf(fexp(-fabsf(x))); }
DI float scan_add_up(float v, int lane) {
#pragma unroll
    for (int o = 1; o < 64; o <<= 1) { const float t = shi(v, lane - o); if (lane >= o) v += t; }
    return v;
}
DI float scan_add_down(float v, int lane) {
#pragma unroll
    for (int o = 1; o < 64; o <<= 1) { const float t = shi(v, lane + o); if (lane + o < 64) v += t; }
    return v;
}
DI float scan_max_up(float v, int lane) {
#pragma unroll
    for (int o = 1; o < 64; o <<= 1) { const float t = shi(v, lane - o); if (lane >= o) v = fmaxf(v, t); }
    return v;
}
DI float scan_max_down(float v, int lane) {
#pragma unroll
    for (int o = 1; o < 64; o <<= 1) { const float t = shi(v, lane + o); if (lane + o < 64) v = fmaxf(v, t); }
    return v;
}

DI void conv8(const bf16_t* __restrict__ zb, int s, int col, const float* __restrict__ cw  , int lane, float (&acc)[8][8]) {
    const int r8 = lane >> 3;
    float w[5][8];
#pragma unroll
    for (int j = 0; j < 5; ++j) { const f32x4 a = *(const f32x4*)(cw + j * 768), b = *(const f32x4*)(cw + j * 768 + 4);
        w[j][0] = a[0]; w[j][1] = a[1]; w[j][2] = a[2]; w[j][3] = a[3]; w[j][4] = b[0]; w[j][5] = b[1]; w[j][6] = b[2]; w[j][7] = b[3]; }
#pragma unroll
    for (int k = 0; k < 8; ++k)
#pragma unroll
        for (int e = 0; e < 8; ++e) acc[k][e] = 0.f;
#pragma unroll
    for (int rr = -2; rr < 10; ++rr) {
        const int pos = s + 8 * r8 + rr;
        u32x4 raw = {0u, 0u, 0u, 0u};
        if ((unsigned)pos < (unsigned)SEQ) raw = *(const u32x4*)(zb + (size_t)pos * ZLD + col);
        float x[8] = {bflo(raw.x), bfhi(raw.x), bflo(raw.y), bfhi(raw.y), bflo(raw.z), bfhi(raw.z), bflo(raw.w), bfhi(raw.w)};
#pragma unroll
        for (int k = 0; k < 8; ++k) { const int j = rr - k + 2;
            if (j >= 0 && j <= 4) {
#pragma unroll
                for (int e = 0; e < 8; ++e) acc[k][e] += w[j][e] * x[e]; } }
    }
#pragma unroll
    for (int k = 0; k < 8; ++k)
#pragma unroll
        for (int e = 0; e < 8; ++e) { const float a = acc[k][e]; acc[k][e] = a * sigmoidf_(a); }
}

DI void mlstm_state_phase(const KParams& P0_, LAS unsigned char* lds, int l, int pm, int wave, int lane) {
    KParams P = P0_; { __attribute__((address_space(1))) unsigned char* w1_ = (__attribute__((address_space(1))) unsigned char*)P.ws; asm volatile("" : "+s"(w1_)); P.ws = (unsigned char*)w1_; }

    bf16_t* Z = (bf16_t*)(P.ws + WS_Z);
    const float* gates = (const float*)(P.ws + WS_GATES);
    bf16_t* qconv = (bf16_t*)(P.ws + WS_QCONV); bf16_t* kconv = (bf16_t*)(P.ws + WS_KCONV);
    bf16_t* CT = (bf16_t*)(P.ws + WS_CT); bf16_t* nbuf = (bf16_t*)(P.ws + WS_NB);
    float* mloc = (float*)(P.ws + WS_ML); float* blast = (float*)(P.ws + WS_BL);
    const float* gb = P.gate_bias + l * 24;
    const int r16 = lane & 15, g = lane >> 4, q4 = r16 >> 2, p4 = r16 & 3, r8 = lane >> 3, pc = lane & 7;
    LAS unsigned char* kbuf = lds + wave * (2 * 64 * VROW);
    LAS unsigned char* vbuf = kbuf + 64 * VROW;
    for (int um = wave; um < 24; um += 8) {
        asm volatile("" : "+v"(lane));
        const int cc = um / 6, h = um % 6;
        const int tc = pm * 256 + 64 * cc, b = tc / SEQ, s = tc % SEQ, ci = s >> 6;
        const bf16_t* zb = Z + (size_t)b * SEQ * ZLD;
        const float* G = gates + (size_t)(tc + lane) * 24;
        const float igf = G[h] + gb[h], fgf = G[6 + h] + gb[6 + h], igb = G[12 + h] + gb[12 + h], fgb = G[18 + h] + gb[18 + h];
        const float bfw = scan_add_up(logsig(fgf), lane), bbw = scan_add_down(logsig(fgb), lane);
        const float blf = shi(bfw, 63), blb = shi(bbw, 0);
        const float wf = blf - bfw + igf, wb = blb - bbw + igb;
        const float mlf = wave_max(wf, lane), mlb = wave_max(wb, lane);
        const float ef = fexp(wf - mlf), eb = fexp(wb - mlb);
        const int slot_f = ((0 * NB + b) * 6 + h) * NCH + ci, slot_b = ((1 * NB + b) * 6 + h) * NCH + ci;
        if (lane == 0) { mloc[slot_f] = mlf; blast[slot_f] = blf; mloc[slot_b] = mlb; blast[slot_b] = blb; }
        float acc[8][8];
        conv8(zb, s, QC + 64 * h + 8 * pc, P.qk_conv + (size_t)l * 5 * 768 + 64 * h + 8 * pc, lane, acc);
#pragma unroll
        for (int k = 0; k < 8; ++k) { u32x4 w; w.x = pk2(acc[k][0], acc[k][1]); w.y = pk2(acc[k][2], acc[k][3]); w.z = pk2(acc[k][4], acc[k][5]); w.w = pk2(acc[k][6], acc[k][7]);
            *(u32x4*)(qconv + (size_t)(tc + 8 * r8 + k) * 384 + 64 * h + 8 * pc) = w; }
        conv8(zb, s, KC + 64 * h + 8 * pc, P.qk_conv + (size_t)l * 5 * 768 + 384 + 64 * h + 8 * pc, lane, acc);
        u32x4 kpk[8];
#pragma unroll
        for (int k = 0; k < 8; ++k) {
#pragma unroll
            for (int e = 0; e < 8; ++e) acc[k][e] *= 0.125f;
            u32x4 w; w.x = pk2(acc[k][0], acc[k][1]); w.y = pk2(acc[k][2], acc[k][3]); w.z = pk2(acc[k][4], acc[k][5]); w.w = pk2(acc[k][6], acc[k][7]);
            kpk[k] = w;
            *(u32x4*)(kconv + (size_t)(tc + 8 * r8 + k) * 384 + 64 * h + 8 * pc) = w; }
#pragma unroll
        for (int k = 0; k < 8; ++k) { const int id = lane + 64 * k, row = id >> 3, c16 = id & 7;
            *(LAS u32x4*)(vbuf + row * VROW + 16 * c16) = *(const u32x4*)(zb + (size_t)(s + row) * ZLD + VC + 64 * h + 8 * c16); }
#pragma unroll
        for (int dir = 0; dir < 2; ++dir) {
            const float ed = dir ? eb : ef;
#pragma unroll
            for (int k = 0; k < 8; ++k) { const float e = shi(ed, 8 * r8 + k); const u32x4 kk = kpk[k];
                u32x4 w; w.x = pk2(bflo(kk.x) * e, bfhi(kk.x) * e); w.y = pk2(bflo(kk.y) * e, bfhi(kk.y) * e); w.z = pk2(bflo(kk.z) * e, bfhi(kk.z) * e); w.w = pk2(bflo(kk.w) * e, bfhi(kk.w) * e);
                *(LAS u32x4*)(kbuf + (8 * r8 + k) * VROW + 16 * pc) = w; }
            WAVE_LDS_FENCE();
            f32x4 c[4][5];
#pragma unroll
            for (int dt = 0; dt < 4; ++dt)
#pragma unroll
                for (int et = 0; et < 5; ++et) c[dt][et] = zero4();
#pragma unroll
            for (int ks = 0; ks < 2; ++ks) {
                bf16x8 af[4], bfr[5];
#pragma unroll
                for (int t4 = 0; t4 < 4; ++t4) {
                    af[t4] = cat8(trread(kbuf + (32 * ks + 8 * g + q4) * VROW + 32 * t4 + 8 * p4), trread(kbuf + (32 * ks + 8 * g + 4 + q4) * VROW + 32 * t4 + 8 * p4));
                    bfr[t4] = cat8(trread(vbuf + (32 * ks + 8 * g + q4) * VROW + 32 * t4 + 8 * p4), trread(vbuf + (32 * ks + 8 * g + 4 + q4) * VROW + 32 * t4 + 8 * p4)); }
                { const short one = r16 == 0 ? (short)0x3F80 : (short)0; bfr[4] = (bf16x8){one, one, one, one, one, one, one, one}; }
#pragma unroll
                for (int dt = 0; dt < 4; ++dt)
#pragma unroll
                    for (int et = 0; et < 5; ++et) c[dt][et] = mfma16(af[dt], bfr[et], c[dt][et]);
            }
            const int slot = dir ? slot_b : slot_f;
            bf16_t* ct = CT + ((size_t)(slot / NCH) * 64 * NCH + (slot % NCH)) * 64;
#pragma unroll
            for (int dt = 0; dt < 4; ++dt) {
#pragma unroll
                for (int et = 0; et < 4; ++et) { const f32x4 v = c[dt][et]; u32x2 w; w.x = pk2(v[0], v[1]); w.y = pk2(v[2], v[3]); *(u32x2*)(ct + (size_t)(16 * et + r16) * (NCH * 64) + 16 * dt + 4 * g) = w; }
                if (r16 == 0) { const f32x4 v = c[dt][4]; u32x2 w; w.x = pk2(v[0], v[1]); w.y = pk2(v[2], v[3]); *(u32x2*)(nbuf + (size_t)slot * 64 + 16 * dt + 4 * g) = w; } }
            WAVE_LDS_FENCE();
        }
    }
}

DI void mlstm_scan_phase(const KParams& P0_, LAS unsigned char* lds, int bid, int G, int tid, bool wr_en = true) {
    KParams P = P0_; { __attribute__((address_space(1))) unsigned char* w1_ = (__attribute__((address_space(1))) unsigned char*)P.ws; asm volatile("" : "+s"(w1_)); P.ws = (unsigned char*)w1_; }
    bf16_t* CT = (bf16_t*)(P.ws + WS_CT); bf16_t* nbuf = (bf16_t*)(P.ws + WS_NB);
    const float* mloc = (const float*)(P.ws + WS_ML); const float* blast = (const float*)(P.ws + WS_BL); float* mprev = (float*)(P.ws + WS_MP);
    LAS float* sbl = (LAS float*)lds; LAS float* sml = sbl + 512; LAS float* sa = sml + 512; LAS float* scc = sa + 512;
    const int wave = tid >> 6, lane = tid & 63;
    const int sb_ = bid >> 5, sj_ = bid & 31;
#define SCAN_SEQ(dh) ((((dh) / 6) * NB + sb_) * 6 + (dh) % 6)
    { const int k = tid >> 7, st = tid & 127; const int dh = k < 3 ? (sj_ >> 3) + 4 * k : (sj_ < 12 ? sj_ : 0); const int sq = SCAN_SEQ(dh); const int c = sq >= NSEQ / 2 ? (NCH - 1 - st) : st;
      sbl[tid] = blast[sq * NCH + c]; sml[tid] = mloc[sq * NCH + c]; }
    __syncthreads();
    if (tid < 4) { const int k = tid; const int dh = k < 3 ? (sj_ >> 3) + 4 * k : (sj_ < 12 ? sj_ : 0); const int sq = SCAN_SEQ(dh); const bool dirb = sq >= NSEQ / 2;
        const bool wm = wr_en && k < 3 && (sj_ & 7) == 0;
        float m = 0.f;
        for (int st = 0; st < NCH; ++st) { const float bl = sbl[k * 128 + st], ml = sml[k * 128 + st]; const float mn = fmaxf(bl + m, ml);
            sa[k * 128 + st] = fexp(bl + m - mn); scc[k * 128 + st] = fexp(ml - mn);
            if (wm) mprev[sq * NCH + (dirb ? (NCH - 1 - st) : st)] = m;
            m = mn; } }
    __syncthreads();
    bf16_t* ptr[4]; bool act[4]; bool dirb[4];
#pragma unroll
    for (int k = 0; k < 3; ++k) { const int sq = SCAN_SEQ((sj_ >> 3) + 4 * k); const int row = sq * 64 + 8 * (sj_ & 7) + wave; ptr[k] = CT + (size_t)row * (NCH * 64) + lane; act[k] = true; dirb[k] = sq >= NSEQ / 2; }
    { const int sq = SCAN_SEQ(sj_ < 12 ? sj_ : 0); ptr[3] = nbuf + (size_t)sq * NCH * 64 + lane; act[3] = sj_ < 12 && wave == 0; dirb[3] = sq >= NSEQ / 2; }
    float C[4] = {0.f, 0.f, 0.f, 0.f};
    for (int st0 = 0; st0 < NCH; st0 += 16) {
        float cl[4][16];
#pragma unroll
        for (int k = 0; k < 4; ++k)
#pragma unroll
            for (int j = 0; j < 16; ++j) { const int c = dirb[k] ? (NCH - 1 - (st0 + j)) : (st0 + j); cl[k][j] = act[k] ? bf2f(ptr[k][c * 64]) : 0.f; }
#pragma unroll
        for (int k = 0; k < 4; ++k)
#pragma unroll
            for (int j = 0; j < 16; ++j) { const int c = dirb[k] ? (NCH - 1 - (st0 + j)) : (st0 + j);
                if (act[k] && wr_en) ptr[k][c * 64] = (bf16_t)(pk2(C[k], 0.f) & 0xffffu);
                C[k] = sa[k * 128 + st0 + j] * C[k] + scc[k * 128 + st0 + j] * cl[k][j]; }
    }
    __syncthreads();
#undef SCAN_SEQ
}

DI void mlstm_out_phase(const KParams& P0_, LAS unsigned char* lds, int l, int pm, int wave, int lane) {
    KParams P = P0_; { __attribute__((address_space(1))) unsigned char* w1_ = (__attribute__((address_space(1))) unsigned char*)P.ws; asm volatile("" : "+s"(w1_)); P.ws = (unsigned char*)w1_; }

    bf16_t* Z = (bf16_t*)(P.ws + WS_Z);
    const float* gates = (const float*)(P.ws + WS_GATES);
    const bf16_t* qconv = (const bf16_t*)(P.ws + WS_QCONV); const bf16_t* kconv = (const bf16_t*)(P.ws + WS_KCONV);
    const bf16_t* CT = (const bf16_t*)(P.ws + WS_CT); const bf16_t* nbuf = (const bf16_t*)(P.ws + WS_NB);
    const float* mprev = (const float*)(P.ws + WS_MP);
    const float* gb = P.gate_bias + l * 24;
    const int r16 = lane & 15, g = lane >> 4, q4 = r16 >> 2, p4 = r16 & 3;
    LAS unsigned char* vbuf = lds + wave * (64 * VROW + 2048 + 256);
    LAS float* tab = (LAS float*)(vbuf + 64 * VROW);
    LAS unsigned char* ntab = vbuf + 64 * VROW + 2048;
    for (int um = wave; um < 24; um += 8) {
        asm volatile("" : "+v"(lane));
        const int cc = um / 6, h = um % 6;
        const int tc = pm * 256 + 64 * cc, b = tc / SEQ, s = tc % SEQ, ci = s >> 6;
        bf16_t* zb = Z + (size_t)b * SEQ * ZLD;
        const int slot_f = ((0 * NB + b) * 6 + h) * NCH + ci, slot_b = ((1 * NB + b) * 6 + h) * NCH + ci;
        u32x4 vreg[8];
#pragma unroll
        for (int k = 0; k < 8; ++k) { const int id = lane + 64 * k, row = id >> 3, c16 = id & 7; vreg[k] = *(const u32x4*)(zb + (size_t)(s + row) * ZLD + VC + 64 * h + 8 * c16); }
        bf16x8 kfr[4][2];
#pragma unroll
        for (int st = 0; st < 4; ++st) { const bf16_t* kp = kconv + (size_t)(tc + 16 * st + r16) * 384 + 64 * h + 8 * g; kfr[st][0] = *(const bf16x8*)kp; kfr[st][1] = *(const bf16x8*)(kp + 32); }
        bf16x8 cfr[2][4][2];
#pragma unroll
        for (int dir = 0; dir < 2; ++dir) { const int slot = dir ? slot_b : slot_f; const bf16_t* ct = CT + ((size_t)(slot / NCH) * 64 * NCH + (slot % NCH)) * 64;
#pragma unroll
            for (int kp = 0; kp < 2; ++kp)
#pragma unroll
                for (int et = 0; et < 4; ++et) cfr[dir][et][kp] = *(const bf16x8*)(ct + (size_t)(16 * et + r16) * (NCH * 64) + 32 * kp + 8 * g); }
        {
            const float* G = gates + (size_t)(tc + lane) * 24;
            const float igf = G[h] + gb[h], fgf = G[6 + h] + gb[6 + h], igb = G[12 + h] + gb[12 + h], fgb = G[18 + h] + gb[18 + h];
            const float bfw = scan_add_up(logsig(fgf), lane), bbw = scan_add_down(logsig(fgb), lane);
            const float gf = igf - bfw, gbk = igb - bbw;
            const float pmf = scan_max_up(gf, lane), pmb = scan_max_down(gbk, lane);
            const float mpf = mprev[slot_f], mpb = mprev[slot_b];
            const float Mf = fmaxf(pmf, mpf), Mb = fmaxf(pmb, mpb);
            tab[0 * 64 + lane] = gf; tab[1 * 64 + lane] = gbk; tab[2 * 64 + lane] = Mf; tab[3 * 64 + lane] = Mb;
            tab[4 * 64 + lane] = fexp(mpf - Mf); tab[5 * 64 + lane] = fexp(mpb - Mb); tab[6 * 64 + lane] = fexp(-(bfw + Mf)); tab[7 * 64 + lane] = fexp(-(bbw + Mb));
        }
#pragma unroll
        for (int k = 0; k < 8; ++k) { const int id = lane + 64 * k, row = id >> 3, c16 = id & 7; *(LAS u32x4*)(vbuf + row * VROW + 16 * c16) = vreg[k]; }
        if (lane < 16) { const int dirn = lane >> 3, c8 = lane & 7; *(LAS u32x4*)(ntab + dirn * 128 + c8 * 16) = *(const u32x4*)(nbuf + (size_t)(dirn ? slot_b : slot_f) * 64 + 8 * c8); }
        WAVE_LDS_FENCE();
        for (int tt = 0; tt < 4; ++tt) {
            const int tau = 16 * tt + r16;
            bf16x8 qfr[2];
            { const bf16_t* qp = qconv + (size_t)(tc + tau) * 384 + 64 * h + 8 * g; qfr[0] = *(const bf16x8*)qp; qfr[1] = *(const bf16x8*)(qp + 32); }
            u32x2 ocv[4];
#pragma unroll
            for (int et = 0; et < 4; ++et) ocv[et] = *(const u32x2*)(zb + (size_t)(s + tau) * ZLD + OC + 64 * h + 16 * et + 4 * g);
            f32x4 S[4];
#pragma unroll
            for (int st = 0; st < 4; ++st) { S[st] = (f32x4){0.f, 0.f, 0.f, 0.f}; S[st] = mfma16(kfr[st][0], qfr[0], S[st]); S[st] = mfma16(kfr[st][1], qfr[1], S[st]); }
            f32x4 hs[4];
#pragma unroll
            for (int et = 0; et < 4; ++et) hs[et] = zero4();
#pragma unroll
            for (int dir = 0; dir < 2; ++dir) {
                const float Mt = tab[(2 + dir) * 64 + tau], at = tab[(4 + dir) * 64 + tau], flt = tab[(6 + dir) * 64 + tau];
                bf16x8 pfr[2];
#pragma unroll
                for (int kp = 0; kp < 2; ++kp) { float pv[8];
#pragma unroll
                    for (int hf = 0; hf < 2; ++hf) { const int st = 2 * kp + hf; const f32x4 gs = *(const LAS f32x4*)(tab + dir * 64 + 16 * st + 4 * g);
#pragma unroll
                        for (int i = 0; i < 4; ++i) { const int sg = 16 * st + 4 * g + i; const bool ok = dir ? (sg >= tau) : (sg <= tau);
                            const float e = fexp(gs[i] - Mt) * S[st][i]; pv[4 * hf + i] = ok ? e : 0.f; } }
                    u32x4 pw; pw.x = pk2(pv[0], pv[1]); pw.y = pk2(pv[2], pv[3]); pw.z = pk2(pv[4], pv[5]); pw.w = pk2(pv[6], pv[7]); pfr[kp] = __builtin_bit_cast(bf16x8, pw); }
                f32x4 nd[5];
#pragma unroll
                for (int et = 0; et < 5; ++et) nd[et] = zero4();
#pragma unroll
                for (int kp = 0; kp < 2; ++kp) {
                    const u32x4 qw = __builtin_bit_cast(u32x4, qfr[kp]); u32x4 qs;
                    qs.x = pk2(bflo(qw.x) * at, bfhi(qw.x) * at); qs.y = pk2(bflo(qw.y) * at, bfhi(qw.y) * at); qs.z = pk2(bflo(qw.z) * at, bfhi(qw.z) * at); qs.w = pk2(bflo(qw.w) * at, bfhi(qw.w) * at);
                    const bf16x8 qsc = __builtin_bit_cast(bf16x8, qs);
#pragma unroll
                    for (int et = 0; et < 4; ++et) { const bf16x8 vf = cat8(trread(vbuf + (32 * kp + 4 * g + q4) * VROW + 32 * et + 8 * p4), trread(vbuf + (32 * kp + 16 + 4 * g + q4) * VROW + 32 * et + 8 * p4));
                        nd[et] = mfma16(vf, pfr[kp], nd[et]); nd[et] = mfma16(cfr[dir][et][kp], qsc, nd[et]); }
                    { const short one = r16 == 0 ? (short)0x3F80 : (short)0; const bf16x8 of = {one, one, one, one, one, one, one, one}; nd[4] = mfma16(of, pfr[kp], nd[4]); }
                    { bf16x8 nf = {0, 0, 0, 0, 0, 0, 0, 0}; if (r16 == 0) nf = *(const LAS bf16x8*)(ntab + dir * 128 + 64 * kp + 16 * g); nd[4] = mfma16(nf, qsc, nd[4]); }
                }
                const float den = shi(nd[4][0], r16);
                const float inv = 1.f / fmaxf(fabsf(den), flt);
#pragma unroll
                for (int et = 0; et < 4; ++et) hs[et] += nd[et] * inv;
            }
            float ss = 0.f;
#pragma unroll
            for (int et = 0; et < 4; ++et) ss += (hs[et][0] * hs[et][0] + hs[et][1] * hs[et][1]) + (hs[et][2] * hs[et][2] + hs[et][3] * hs[et][3]);
            ss = xsum4(ss);
            const float rn = 1.f / sqrtf(ss * (1.f / 64.f) + EPS);
            bf16_t* zr = zb + (size_t)(s + tau) * ZLD;
#pragma unroll
            for (int et = 0; et < 4; ++et) { const int e0 = 64 * h + 16 * et + 4 * g;
                const u32x2 ov = ocv[et]; const f32x4 ng = *(const f32x4*)(P.mlstm_norm + l * 384 + e0);
                const float y0 = hs[et][0] * rn * ng[0] * sigmoidf_(bflo(ov.x)), y1 = hs[et][1] * rn * ng[1] * sigmoidf_(bfhi(ov.x));
                const float y2 = hs[et][2] * rn * ng[2] * sigmoidf_(bflo(ov.y)), y3 = hs[et][3] * rn * ng[3] * sigmoidf_(bfhi(ov.y));
                u32x2 w; w.x = pk2(y0, y1); w.y = pk2(y2, y3); *(u32x2*)(zr + QC + e0) = w; }
        }
        WAVE_LDS_FENCE();
    }
}

#ifndef PROBE_MODE
#define PROBE_MODE 0
#endif
#ifndef SKIP_ATTN
#define SKIP_ATTN 0
#endif
#ifndef SKIP_MLSTM
#define SKIP_MLSTM 0
#endif

__global__ void __launch_bounds__(512, 2) fwd_kernel(KParams P) {
    extern __shared__ __attribute__((aligned(16))) unsigned char lds_raw[];
    LAS unsigned char* lds = (LAS unsigned char*)lds_raw;
    cg::grid_group grid = cg::this_grid();
#if PROBE_MODE == 4
#define GSYNC() do { grid.sync(); grid.sync(); } while (0)
#else
#define GSYNC() grid.sync()
#endif
    unsigned* const bar_w = (unsigned*)P.ws;
    const unsigned xcd_ = (unsigned)__builtin_amdgcn_s_getreg((3 << 11) | 20) & 0xFu;
    unsigned bar_round = 0; bool bar_local = false;
#define ABAR() do { asm volatile("s_waitcnt vmcnt(0) lgkmcnt(0)" ::: "memory"); __syncthreads(); bar_round += 1u; \
        if (wave_s == 0 && lane_id_asm() == 0) { \
            if (!bar_local) { __builtin_amdgcn_fence(__ATOMIC_RELEASE, "agent"); asm volatile("s_waitcnt vmcnt(0)" ::: "memory"); } \
            __hip_atomic_fetch_add(bar_w + 48 + (pm0 >> 5), 1u, __ATOMIC_RELAXED, __HIP_MEMORY_SCOPE_AGENT); \
            unsigned sp_ = 0; while (__hip_atomic_load(bar_w + 48 + (pm0 >> 5), __ATOMIC_RELAXED, __HIP_MEMORY_SCOPE_AGENT) < 32u * bar_round && ++sp_ < (1u << 22)) __builtin_amdgcn_s_sleep(2); \
            __builtin_amdgcn_fence(__ATOMIC_ACQUIRE, "agent"); } \
        __syncthreads(); } while (0)
    const int G = gridDim.x, bx = blockIdx.x;
    if (G != 256) return;
    const int pm0 = (bx & 7) * 32 + (bx >> 3);
const int wave_s = __builtin_amdgcn_readfirstlane((int)threadIdx.x >> 6);
#define FRESH_IDS int tid = wave_s * 64 + lane_id_asm(); asm volatile("" : "+v"(tid)); const int lane = tid & 63, wave = __builtin_amdgcn_readfirstlane(tid >> 6); int pm = pm0; asm volatile("" : "+s"(pm)); (void)lane; (void)wave; (void)pm;
#define WSP() ({ __attribute__((address_space(1))) unsigned char* w_ = (__attribute__((address_space(1))) unsigned char*)P.ws; asm volatile("" : "+s"(w_)); (unsigned char*)w_; })
#define Wall ((bf16_t*)(WSP() + WS_W))
#define PB ((bf16_t*)(WSP() + WS_PB))
#define gates ((float*)(WSP() + WS_GATES))
#define rs ((float*)(WSP() + WS_RS))
#define XBA ((bf16_t*)(WSP() + WS_XBA))
#define XBB ((bf16_t*)(WSP() + WS_XBB))
#define Z ((bf16_t*)(WSP() + WS_Z))
    LAS float* ssq = (LAS float*)(lds + SSQ_OFF);
    LAS float* rsl = (LAS float*)(lds + RSL_OFF);
#define ZERO_SSQ() do { FRESH_IDS; if (tid < 256) { *(LAS f32x4*)(ssq + tid * 4) = zero4(); } } while (0)
#define WRITE_RS() do { FRESH_IDS; if (tid < 256) { const float s_ = (ssq[tid * 4] + ssq[tid * 4 + 1]) + (ssq[tid * 4 + 2] + ssq[tid * 4 + 3]); const float r_ = 1.f / sqrtf(s_ * (1.f / DM) + EPS); rs[pm * 256 + tid] = r_; rsl[tid] = r_; } } while (0)

#if PROBE_MODE == 3
    { FRESH_IDS;
      prep_weights(P, lds, bx * 8 + wave, G * 8, wave, lane);
      for (int rr = wave; rr < 256; rr += 8) { const size_t row = (size_t)pm * 256 + rr;
        const f32x4* xr = (const f32x4*)(P.x + row * DM) + lane; f32x4 v[4]; float s = 0.f;
#pragma unroll
        for (int j = 0; j < 4; ++j) { v[j] = __builtin_nontemporal_load(xr + 64 * j); s += (v[j][0] * v[j][0] + v[j][1] * v[j][1]) + (v[j][2] * v[j][2] + v[j][3] * v[j][3]); }
        s = wave_sum(s, lane);
        u32x2* o = (u32x2*)(XBA + row * DM) + lane;
#pragma unroll
        for (int j = 0; j < 4; ++j) { u32x2 w; w.x = pk2(v[j][0], v[j][1]); w.y = pk2(v[j][2], v[j][3]); o[64 * j] = w; }
        if (lane == 0) rs[row] = 1.f / sqrtf(s * (1.f / DM) + EPS); } }
    __syncthreads();
#endif
    { FRESH_IDS;
      prep_weights(P, lds, bx * 8 + wave, G * 8, wave, lane);
      for (int rr = wave; rr < 256; rr += 8) { const size_t row = (size_t)pm * 256 + rr;
        const f32x4* xr = (const f32x4*)(P.x + row * DM) + lane; f32x4 v[4]; float s = 0.f;
#pragma unroll
        for (int j = 0; j < 4; ++j) { v[j] = __builtin_nontemporal_load(xr + 64 * j); s += (v[j][0] * v[j][0] + v[j][1] * v[j][1]) + (v[j][2] * v[j][2] + v[j][3] * v[j][3]); }
        s = wave_sum(s, lane);
        u32x2* o = (u32x2*)(XBA + row * DM) + lane;
#pragma unroll
        for (int j = 0; j < 4; ++j) { u32x2 w; w.x = pk2(v[j][0], v[j][1]); w.y = pk2(v[j][2], v[j][3]); o[64 * j] = w; }
        if (lane == 0) { const float r_ = 1.f / sqrtf(s * (1.f / DM) + EPS); rs[row] = r_; rsl[rr] = r_; } } }
    if (wave_s == 0 && lane_id_asm() == 0) __hip_atomic_store(bar_w + 256 + pm0, xcd_, __ATOMIC_RELAXED, __HIP_MEMORY_SCOPE_AGENT);
    GSYNC();
    { unsigned same = 1u;
      for (int i = 0; i < 32; ++i) same &= (__hip_atomic_load(bar_w + 256 + (pm0 & ~31) + i, __ATOMIC_RELAXED, __HIP_MEMORY_SCOPE_AGENT) == xcd_) ? 1u : 0u;
      bar_local = __builtin_amdgcn_readfirstlane((int)same) != 0; }

    for (int l = 0; l < DEPTH; ++l) {
        bf16_t* Wl = Wall + (size_t)l * LAYER_W;
        { pg8::Gemm g{XBA, Wl + OFF_WIN, DM, DM, wave_s}; pg8::RowOrder S{pm0, NIN_PAD / 256}; pg8::EpiZ E{Z, gates, rsl};
          pg8::gemm_phase<pg8::EpiZ, pg8::RowOrder>(lds, g, S, E);
#if PROBE_MODE == 2
          pg8::gemm_phase<pg8::EpiZ, pg8::RowOrder>(lds, g, S, E);
#endif
          }
        ABAR();
#if PROBE_MODE == 1 || PROBE_MODE == 6
        { FRESH_IDS; build_lut(P, lds, tid); __syncthreads(); attention_phase(P, lds, l, pm, wave, lane, P.out == nullptr); __syncthreads(); }
#endif
#if PROBE_MODE == 1 || PROBE_MODE == 7
        { FRESH_IDS; mlstm_state_phase(P, lds, l, pm, wave, lane); __syncthreads(); }
#endif
        if (!SKIP_ATTN) { FRESH_IDS;
            build_lut(P, lds, tid);
            __syncthreads();
            attention_phase(P, lds, l, pm, wave, lane);
        }
        __syncthreads();
        if (!SKIP_MLSTM) { FRESH_IDS; mlstm_state_phase(P, lds, l, pm, wave, lane); }
        ABAR();
#if PROBE_MODE == 1 || PROBE_MODE == 8
        { FRESH_IDS; mlstm_scan_phase(P, lds, pm, G, tid, P.out == nullptr); }
#endif
        if (!SKIP_MLSTM) { FRESH_IDS; mlstm_scan_phase(P, lds, pm, G, tid); }
        ABAR();
#if PROBE_MODE == 1 || PROBE_MODE == 9
        { FRESH_IDS; mlstm_out_phase(P, lds, l, pm, wave, lane); __syncthreads(); }
#endif
        if (!SKIP_MLSTM) { FRESH_IDS; mlstm_out_phase(P, lds, l, pm, wave, lane); }
        ZERO_SSQ();
        LOCAL_SEAM();
#if PROBE_MODE == 5
        { pg8::Gemm g{Z, Wl + OFF_WOUT, ZLD, DM, wave_s}; pg8::RowOrder S{pm0, 4}; pg8::EpiResid<false> E{XBA, XBA, nullptr, ssq, (P.out == nullptr)};
          pg8::gemm_phase<pg8::EpiResid<false>, pg8::RowOrder>(lds, g, S, E); }
        __syncthreads();
#endif
        { pg8::Gemm g{Z, Wl + OFF_WOUT, ZLD, DM, wave_s}; pg8::RowOrder S{pm0, 4}; pg8::EpiResid<false> E{XBA, XBA, nullptr, ssq, true};
          pg8::gemm_phase<pg8::EpiResid<false>, pg8::RowOrder>(lds, g, S, E); }
        __syncthreads();
        WRITE_RS();
        LOCAL_SEAM();
        { pg8::Gemm g{XBA, Wl + OFF_WUP, DM, DM, wave_s}; pg8::RowOrder S{pm0, NUP / 256}; pg8::EpiSwiGLU E{Z, rsl};
          pg8::gemm_phase<pg8::EpiSwiGLU, pg8::RowOrder>(lds, g, S, E);
#if PROBE_MODE == 2
          pg8::gemm_phase<pg8::EpiSwiGLU, pg8::RowOrder>(lds, g, S, E);
#endif
          }
        ZERO_SSQ();
        LOCAL_SEAM();
#if PROBE_MODE == 5
        { pg8::Gemm g{Z + ACT_OFF, Wl + OFF_WDOWN, ZLD, DFF, wave_s}; pg8::RowOrder S{pm0, 4}; pg8::EpiResid<false> E{XBA, XBB, nullptr, ssq, (P.out == nullptr)};
          pg8::gemm_phase<pg8::EpiResid<false>, pg8::RowOrder>(lds, g, S, E); }
        __syncthreads();
#endif
        { pg8::Gemm g{Z + ACT_OFF, Wl + OFF_WDOWN, ZLD, DFF, wave_s}; pg8::RowOrder S{pm0, 4}; pg8::EpiResid<false> E{XBA, XBB, nullptr, ssq, true};
          pg8::gemm_phase<pg8::EpiResid<false>, pg8::RowOrder>(lds, g, S, E); }
        { FRESH_IDS;
          for (int r0 = wave; r0 < 256; r0 += 64) {
            f32x4 v[8];
#pragma unroll
            for (int j = 0; j < 8; ++j) { const size_t row = (size_t)pm * 256 + r0 + 8 * j; v[j] = __builtin_nontemporal_load((const f32x4*)(P.p + ((size_t)l * MTOK + row) * PLE) + lane); }
#pragma unroll
            for (int j = 0; j < 8; ++j) { const size_t row = (size_t)pm * 256 + r0 + 8 * j; u32x2 w; w.x = pk2(v[j][0], v[j][1]); w.y = pk2(v[j][2], v[j][3]); *((u32x2*)(PB + row * PLE) + lane) = w; } } }
        LOCAL_SEAM();
        { pg8::Gemm g{XBB, Wl + OFF_WG, DM, DM, wave_s}; pg8::RowOrder S{pm0, 4}; pg8::EpiSigmoid E{Z};
          pg8::gemm_phase<pg8::EpiSigmoid, pg8::RowOrder>(lds, g, S, E);
#if PROBE_MODE == 2
          pg8::gemm_phase<pg8::EpiSigmoid, pg8::RowOrder>(lds, g, S, E);
#endif
          }
        ZERO_SSQ();
        LOCAL_SEAM();
#if PROBE_MODE == 5
        { pg8::Gemm g{PB, Wl + OFF_WP, PLE, PLE, wave_s}; pg8::RowOrder S{pm0, 4}; pg8::EpiResid<true> E{XBB, XBA, Z, ssq, (P.out == nullptr)};
          pg8::gemm_phase<pg8::EpiResid<true>, pg8::RowOrder>(lds, g, S, E); }
        __syncthreads();
#endif
        { pg8::Gemm g{PB, Wl + OFF_WP, PLE, PLE, wave_s}; pg8::RowOrder S{pm0, 4}; pg8::EpiResid<true> E{XBB, XBA, Z, ssq, true};
          pg8::gemm_phase<pg8::EpiResid<true>, pg8::RowOrder>(lds, g, S, E); }
        __syncthreads();
        WRITE_RS();
        LOCAL_SEAM();
    }
    { FRESH_IDS;
      for (int r0 = wave; r0 < 256; r0 += 32) {
        u32x2 v[4][4]; float sc[4];
#pragma unroll
        for (int q = 0; q < 4; ++q) { const size_t row = (size_t)pm * 256 + r0 + 8 * q; sc[q] = rs[row]; const u32x2* xr = (const u32x2*)(XBA + row * DM) + lane;
#pragma unroll
            for (int j = 0; j < 4; ++j) v[q][j] = xr[64 * j]; }
        const f32x4* gr = (const f32x4*)P.final_norm + lane;
#pragma unroll
        for (int q = 0; q < 4; ++q) { const size_t row = (size_t)pm * 256 + r0 + 8 * q; f32x4* orow = (f32x4*)(P.out + row * DM) + lane;
#pragma unroll
            for (int j = 0; j < 4; ++j) { const f32x4 gg = gr[64 * j]; const u32x2 w = v[q][j];
                __builtin_nontemporal_store((f32x4){bflo(w.x) * sc[q] * gg[0], bfhi(w.x) * sc[q] * gg[1], bflo(w.y) * sc[q] * gg[2], bfhi(w.y) * sc[q] * gg[3]}, orow + 64 * j); } } } }
}

extern "C" void kernel_launch(void* const* d_in, const int* in_sizes, int n_in, void* d_out, int out_size, void* d_ws, size_t ws_size, hipStream_t stream) {
    static int ready = 0;
    if (ready == 0) {
        if (n_in != 16 || out_size != MTOK * DM || ws_size < WS_END) { fprintf(stderr, "kernel_launch: unexpected sizes (n_in %d, out %d, ws %zu)\n", n_in, out_size, ws_size); ready = -1; return; }
        if (hipFuncSetAttribute((const void*)fwd_kernel, hipFuncAttributeMaxDynamicSharedMemorySize, LDS_BYTES) != hipSuccess) { fprintf(stderr, "kernel_launch: hipFuncSetAttribute failed\n"); ready = -1; return; }
        int dev = 0, cus = 0, per_cu = 0;
        (void)hipGetDevice(&dev); (void)hipDeviceGetAttribute(&cus, hipDeviceAttributeMultiprocessorCount, dev);
        (void)hipOccupancyMaxActiveBlocksPerMultiprocessor(&per_cu, (const void*)fwd_kernel, 512, LDS_BYTES);
        if (cus != 256 || per_cu < 1) fprintf(stderr, "kernel_launch: note: %d CUs, %d blocks/CU (kernel expects 256 x 1)\n", cus, per_cu);
        (void)hipGetLastError();
        ready = 1;
    }
    if (ready < 0) return;
    KParams P{};
    P.x = (const float*)d_in[0]; P.p = (const float*)d_in[1]; P.rel_bias = (const float*)d_in[2]; P.attn_norm = (const float*)d_in[3]; P.w_in = (const float*)d_in[4];
    P.qk_conv = (const float*)d_in[5]; P.gate_bias = (const float*)d_in[6]; P.sink = (const float*)d_in[7]; P.mlstm_norm = (const float*)d_in[8]; P.w_out = (const float*)d_in[9];
    P.ffn_norm = (const float*)d_in[10]; P.w_up = (const float*)d_in[11]; P.w_down = (const float*)d_in[12]; P.ple_proj = (const float*)d_in[13]; P.ple_gate = (const float*)d_in[14];
    P.final_norm = (const float*)d_in[15]; P.out = (float*)d_out; P.ws = (unsigned char*)d_ws;
    (void)hipMemsetAsync(d_ws, 0, 256, stream);
    void* args[] = {&P};
    hipError_t e = hipLaunchCooperativeKernel((const void*)fwd_kernel, dim3(256), dim3(512), args, LDS_BYTES, stream);
    if (e != hipSuccess) fprintf(stderr, "kernel_launch: cooperative launch failed: %s\n", hipGetErrorString(e));
}
```

```cpp
#include <hip/hip_runtime.h>
#include <hip/hip_cooperative_groups.h>
#include <cstdio>
#include <cstdint>
namespace cg = cooperative_groups;

#define LAS __attribute__((address_space(3)))
#define DI __device__ __forceinline__
typedef unsigned short bf16_t;
typedef short bf16x8 __attribute__((ext_vector_type(8)));
typedef short s16x4 __attribute__((ext_vector_type(4)));
typedef float f32x4 __attribute__((ext_vector_type(4)));
typedef float f32x2 __attribute__((ext_vector_type(2)));
typedef unsigned u32x4 __attribute__((ext_vector_type(4)));
typedef unsigned u32x2 __attribute__((ext_vector_type(2)));
typedef __bf16 bf16v2 __attribute__((ext_vector_type(2)));

constexpr int NB = 8, SEQ = 8192, DM = 1024, DEPTH = 4, MTOK = NB * SEQ;
constexpr int ZLD = 3200, NIN_PAD = 3328, DFF = 2816, NUP = 2 * DFF, PLE = 256, DIN = 3224;
constexpr int QA = 0, QB = 384, QC = 640, KA = 1024, KB = 1408, KC = 1536, VA = 1920, VB = 2304, VC = 2432, OC = 2816;
constexpr int ACT_OFF = 384;
constexpr float LOG2E = 1.4426950408889634f;
constexpr float QSCALE = 0.125f * LOG2E;
constexpr float EPS = 1e-6f;
constexpr float NEGBIG = -1e30f;
constexpr int NSEQ = 2 * NB * 6, NCH = SEQ / 64;

constexpr size_t OFF_WIN = 0, OFF_WOUT = OFF_WIN + (size_t)NIN_PAD * DM, OFF_WUP = OFF_WOUT + (size_t)DM * DM, OFF_WDOWN = OFF_WUP + (size_t)NUP * DM,
                 OFF_WP = OFF_WDOWN + (size_t)DM * DFF, OFF_WG = OFF_WP + (size_t)DM * PLE, LAYER_W = OFF_WG + (size_t)DM * DM;
constexpr size_t MiB = 1u << 20;
constexpr size_t WS_W = 1 * MiB, WS_PB = 112 * MiB, WS_GATES = 144 * MiB, WS_RS = 150 * MiB, WS_NB = 151 * MiB, WS_ML = 153 * MiB, WS_BL = WS_ML + 256 * 1024,
                 WS_MP = WS_ML + 512 * 1024, WS_QCONV = 154 * MiB, WS_KCONV = 202 * MiB, WS_XBA = 250 * MiB, WS_XBB = 378 * MiB, WS_Z = 506 * MiB, WS_CT = 906 * MiB,
                 WS_END = 1002 * MiB;
static_assert(WS_W + 4 * LAYER_W * 2 <= WS_PB, "weights");
static_assert(WS_Z + (size_t)MTOK * ZLD * 2 <= WS_CT, "z");
static_assert(WS_CT + (size_t)NSEQ * NCH * 4096 * 2 <= WS_END, "ct");

constexpr int LDS_BYTES = 155648;
constexpr int RING_BYTES = 131072, SSQ_OFF = 131072, RSL_OFF = 151552;

DI unsigned pk2(float lo, float hi) { f32x2 v = {lo, hi}; bf16v2 b = __builtin_convertvector(v, bf16v2); return __builtin_bit_cast(unsigned, b); }
DI float bf2f(unsigned short u) { return __uint_as_float(((unsigned)u) << 16); }
DI float bflo(unsigned u) { return __uint_as_float(u << 16); }
DI float bfhi(unsigned u) { return __uint_as_float(u & 0xffff0000u); }
DI float ex2(float x) { return __builtin_amdgcn_exp2f(x); }
DI float fexp(float x) { return __builtin_amdgcn_exp2f(x * LOG2E); }
DI float frcp(float x) { return __builtin_amdgcn_rcpf(x); }
DI float sigmoidf_(float x) { return frcp(1.f + fexp(-x)); }
DI f32x4 mfma16(bf16x8 a, bf16x8 b, f32x4 c) { return __builtin_amdgcn_mfma_f32_16x16x32_bf16(a, b, c, 0, 0, 0); }
DI f32x4 zero4() { float z; asm volatile("v_mov_b32 %0, 0" : "=v"(z)); return (f32x4){z, z, z, z}; }
DI s16x4 trread(LAS unsigned char* p) { return __builtin_amdgcn_ds_read_tr16_b64_v4i16((LAS s16x4*)p); }
DI bf16x8 cat8(s16x4 a, s16x4 b) { return __builtin_shufflevector(a, b, 0, 1, 2, 3, 4, 5, 6, 7); }
DI float shx(float v, int mask, int lane) { return __builtin_bit_cast(float, __builtin_amdgcn_ds_bpermute((lane ^ mask) << 2, __builtin_bit_cast(int, v))); }
DI float shi(float v, int idx) { return __builtin_bit_cast(float, __builtin_amdgcn_ds_bpermute(idx << 2, __builtin_bit_cast(int, v))); }
DI float xmax4(float v) {
    const unsigned x = __builtin_bit_cast(unsigned, v);
    const auto r = __builtin_amdgcn_permlane16_swap(x, x, false, false); unsigned r0 = r[0], r1 = r[1]; asm volatile("" : "+v"(r0), "+v"(r1));
    const float a = __builtin_bit_cast(float, r0), b = __builtin_bit_cast(float, r1); const float c = a > b ? a : b;
    const unsigned y = __builtin_bit_cast(unsigned, c);
    const auto q = __builtin_amdgcn_permlane32_swap(y, y, false, false); unsigned q0 = q[0], q1 = q[1]; asm volatile("" : "+v"(q0), "+v"(q1));
    const float d = __builtin_bit_cast(float, q0), e = __builtin_bit_cast(float, q1); return d > e ? d : e;
}
DI float xsum4(float v) {
    const unsigned x = __builtin_bit_cast(unsigned, v);
    const auto r = __builtin_amdgcn_permlane16_swap(x, x, false, false); unsigned r0 = r[0], r1 = r[1]; asm volatile("" : "+v"(r0), "+v"(r1));
    const float c = __builtin_bit_cast(float, r0) + __builtin_bit_cast(float, r1);
    const unsigned y = __builtin_bit_cast(unsigned, c);
    const auto q = __builtin_amdgcn_permlane32_swap(y, y, false, false); unsigned q0 = q[0], q1 = q[1]; asm volatile("" : "+v"(q0), "+v"(q1));
    return __builtin_bit_cast(float, q0) + __builtin_bit_cast(float, q1);
}
DI int lane_id_asm() { int l_; asm volatile("v_mbcnt_lo_u32_b32 %0, -1, 0\n\tv_mbcnt_hi_u32_b32 %0, -1, %0" : "=v"(l_)); return l_; }
#define WAVE_LDS_FENCE() asm volatile("s_waitcnt lgkmcnt(0)" ::: "memory")
#define LOCAL_SEAM() do { asm volatile("s_waitcnt vmcnt(0) lgkmcnt(0)" ::: "memory"); __syncthreads(); __builtin_amdgcn_fence(__ATOMIC_ACQUIRE, "workgroup"); } while (0)

namespace pg8 {
constexpr int BM = 256, BK = 64, HALF = 128, HTB = HALF * BK * 2, STAGE_BYTES = 8 * HTB;
DI int lds_byte(int r, int c) { const int st = (r >> 4) * 2 + (c >> 5), rr = r & 15, cc = c & 31, ob = rr * 64 + cc * 2; return st * 1024 + (ob ^ (((ob >> 9) & 1) << 5)); }
DI void stage_rc(int b, int& R, int& C) { const int st = b / 1024, sb = b % 1024, swz = sb ^ (((sb >> 9) & 1) << 5); R = (st >> 1) * 16 + swz / 64; C = (st & 1) * 32 + (swz % 64) / 2; }
DI int perm32(int rho) { const int n = rho >> 4, i = rho & 15; return 8 * (i >> 2) + 4 * n + (i & 3); }
struct Unit { int pm, pn; };
struct Gemm { const bf16_t* A; const bf16_t* Bt; int lda, K, wave; };
struct RowOrder {
    int pm, nN;
    DI bool next(int i, Unit& u) const { if (i >= nN) return false; u.pm = pm; u.pn = i; return true; }
};

template <class Epi, class Sched>
DI void gemm_phase(LAS unsigned char* lds, const Gemm g, const Sched& S, const Epi& E) {
    int tid = g.wave * 64 + lane_id_asm(); asm volatile("" : "+v"(tid));
    const int wid = __builtin_amdgcn_readfirstlane(tid >> 6), lane = tid & 63, wr = wid >> 2, wc = wid & 3, fr = lane & 15, fq = lane >> 4;
    const int K = g.K, nt = K / BK, lda = g.lda;
    unsigned voffA[2], voffB[2];
#pragma unroll
    for (int i = 0; i < 2; ++i) { int R, C; stage_rc(tid * 16 + i * 8192, R, C); const int Rb = Epi::PERM ? ((R & ~31) + perm32(R & 31)) : R;
        voffA[i] = (unsigned)(R * lda + C) * 2u; voffB[i] = (unsigned)(Rb * K + C) * 2u; }
    const size_t kstep = (size_t)(BK * 2);
    const size_t hsA = (size_t)HALF * lda * 2, hsB = (size_t)HALF * K * 2;
    const size_t tsA = 2 * hsA, tsB = 2 * hsB;
    const unsigned ldsw = (unsigned)wid * 1024u;
    const int aoff = lds_byte(wr * 64 + fr, fq * 8), boff = lds_byte(wc * 32 + fr, fq * 8);
#define PG8_SA(b, h) (((b) * 2 + (h)) * HTB)
#define PG8_SB(b, h) ((4 + (b) * 2 + (h)) * HTB)
#define PG8_STAGE(bufoff, gbase, voff) do { _Pragma("unroll") for (int _i = 0; _i < 2; ++_i) \
        __builtin_amdgcn_global_load_lds((const unsigned*)((const char*)(gbase) + (voff)[_i]), (LAS unsigned*)(lds + (bufoff) + ldsw + _i * 8192), 16, 0, 0); } while (0)
#define PG8_LDA(dst, b, h) do { _Pragma("unroll") for (int m = 0; m < 4; ++m) _Pragma("unroll") for (int k = 0; k < 2; ++k) dst[m][k] = *(const LAS bf16x8*)(lds + PG8_SA(b, h) + aoff + m * 2048 + k * 1024); } while (0)
#define PG8_LDB(dst, b, h) do { _Pragma("unroll") for (int n = 0; n < 2; ++n) _Pragma("unroll") for (int k = 0; k < 2; ++k) dst[n][k] = *(const LAS bf16x8*)(lds + PG8_SB(b, h) + boff + n * 2048 + k * 1024); } while (0)
#define PG8_MMA(ai, bj, At, Bt) do { __builtin_amdgcn_s_setprio(1); _Pragma("unroll") for (int m = 0; m < 4; ++m) _Pragma("unroll") for (int n = 0; n < 2; ++n) _Pragma("unroll") for (int k = 0; k < 2; ++k) \
        acc[ai][bj][m][n] = __builtin_amdgcn_mfma_f32_16x16x32_bf16(Bt[n][k], At[m][k], acc[ai][bj][m][n], 0, 0, 0); __builtin_amdgcn_s_setprio(0); } while (0)
#define PG8_WAIT_V(n) asm volatile("s_waitcnt vmcnt(" #n ")" ::: "memory")
#define PG8_WAIT_L(n) asm volatile("s_waitcnt lgkmcnt(" #n ")" ::: "memory")
#define PG8_WAIT_VSEL(sel) do { if constexpr (Epi::NST == 16) asm volatile("s_cmp_eq_u32 %0, 0\n\ts_cbranch_scc1 .Lws%=\n\ts_waitcnt vmcnt(24)\n\ts_branch .Lwe%=\n.Lws%=:\n\ts_waitcnt vmcnt(8)\n.Lwe%=:" :: "s"(sel) : "scc", "memory"); \
    else asm volatile("s_cmp_eq_u32 %0, 0\n\ts_cbranch_scc1 .Lws%=\n\ts_waitcnt vmcnt(16)\n\ts_branch .Lwe%=\n.Lws%=:\n\ts_waitcnt vmcnt(8)\n.Lwe%=:" :: "s"(sel) : "scc", "memory"); } while (0)
#define PG8_BAR __builtin_amdgcn_s_barrier()
#define PG8_SCHED __builtin_amdgcn_sched_barrier(0)
    Unit cur, nxt; int ui = 0;
    if (!S.next(0, cur)) return;
    f32x4 acc[2][2][4][2];
    { float z0; asm volatile("v_mov_b32 %0, 0" : "=v"(z0));
#pragma unroll
    for (int a = 0; a < 2; ++a)
#pragma unroll
        for (int b = 0; b < 2; ++b)
#pragma unroll
            for (int m = 0; m < 4; ++m)
#pragma unroll
                for (int n = 0; n < 2; ++n) acc[a][b][m][n] = (f32x4){z0, z0, z0, z0}; }
    bf16x8 At[4][2], B0[2][2], B1[2][2];
    const char* cA = (const char*)g.A + (size_t)cur.pm * tsA; const char* cB = (const char*)g.Bt + (size_t)cur.pn * tsB;
    PG8_STAGE(PG8_SB(0, 0), cB, voffB); PG8_STAGE(PG8_SB(0, 1), cB + hsB, voffB); PG8_STAGE(PG8_SA(0, 0), cA, voffA); PG8_STAGE(PG8_SA(0, 1), cA + hsA, voffA);
    if (wr == 1) PG8_BAR;
    PG8_WAIT_V(2); PG8_BAR;
    PG8_STAGE(PG8_SB(1, 0), cB + kstep, voffB); PG8_STAGE(PG8_SA(1, 0), cA + kstep, voffA); PG8_STAGE(PG8_SB(1, 1), cB + hsB + kstep, voffB);
    PG8_WAIT_V(6); PG8_BAR;
    for (;;) {
        const bool has_next = S.next(ui + 1, nxt);
        const char* nA = has_next ? (const char*)g.A + (size_t)nxt.pm * tsA : cA; const char* nB = has_next ? (const char*)g.Bt + (size_t)nxt.pn * tsB : cB;
        for (int t = 0; t < nt; t += 2) {
            const bool last = (t == nt - 2);
            const int relax = ((t == 0) && (ui > 0)) ? 1 : 0;
            const char* a1 = cA + (size_t)(t + 1) * kstep;
            const char* a2 = last ? nA : cA + (size_t)(t + 2) * kstep; const char* b2 = last ? nB : cB + (size_t)(t + 2) * kstep;
            const char* a3 = a2 + kstep; const char* b3 = b2 + kstep;
            PG8_LDB(B0, 0, 0); PG8_LDB(B1, 0, 1); PG8_SCHED; PG8_LDA(At, 0, 0); PG8_STAGE(PG8_SA(1, 1), a1 + hsA, voffA);
            PG8_WAIT_VSEL(__builtin_amdgcn_readfirstlane(relax)); PG8_WAIT_L(0); PG8_BAR; PG8_MMA(0, 0, At, B0); PG8_MMA(0, 1, At, B1); PG8_BAR; PG8_SCHED;
            PG8_LDA(At, 0, 1); PG8_STAGE(PG8_SB(0, 0), b2, voffB); PG8_STAGE(PG8_SB(0, 1), b2 + hsB, voffB); PG8_STAGE(PG8_SA(0, 0), a2, voffA);
            PG8_WAIT_VSEL(__builtin_amdgcn_readfirstlane(relax)); PG8_WAIT_L(0); PG8_BAR; PG8_MMA(1, 0, At, B0); PG8_MMA(1, 1, At, B1); PG8_BAR; PG8_SCHED;
            PG8_LDB(B0, 1, 0); PG8_LDB(B1, 1, 1); PG8_SCHED; PG8_LDA(At, 1, 0); PG8_STAGE(PG8_SA(0, 1), a2 + hsA, voffA);
            PG8_WAIT_V(8); PG8_WAIT_L(0); PG8_BAR; PG8_MMA(0, 0, At, B0); PG8_MMA(0, 1, At, B1); PG8_BAR; PG8_SCHED;
            PG8_LDA(At, 1, 1); PG8_STAGE(PG8_SB(1, 0), b3, voffB); PG8_STAGE(PG8_SB(1, 1), b3 + hsB, voffB); PG8_STAGE(PG8_SA(1, 0), a3, voffA);
            PG8_WAIT_V(8); PG8_WAIT_L(0); PG8_BAR; PG8_MMA(1, 0, At, B0); PG8_MMA(1, 1, At, B1); PG8_BAR; PG8_SCHED;
        }
        if (wr == 0) PG8_BAR;
        E(acc, cur, wr, wc, fr, fq);
        if (!has_next) break;
        { float z0; asm volatile("v_mov_b32 %0, 0" : "=v"(z0));
#pragma unroll
        for (int a = 0; a < 2; ++a)
#pragma unroll
            for (int b = 0; b < 2; ++b)
#pragma unroll
                for (int m = 0; m < 4; ++m)
#pragma unroll
                    for (int n = 0; n < 2; ++n) acc[a][b][m][n] = (f32x4){z0, z0, z0, z0}; }
        cur = nxt; cA = nA; cB = nB; ++ui;
        if (wr == 1) PG8_BAR;
    }
    PG8_WAIT_V(0);
    PG8_BAR;
#undef PG8_SA
#undef PG8_SB
#undef PG8_STAGE
#undef PG8_LDA
#undef PG8_LDB
#undef PG8_MMA
#undef PG8_WAIT_V
#undef PG8_WAIT_L
#undef PG8_WAIT_VSEL
#undef PG8_BAR
#undef PG8_SCHED
}

struct EpiZ {
    static constexpr bool PERM = true; static constexpr int NST = 16;
    bf16_t* Z; float* gates; const LAS float* rs;
    DI void operator()(const f32x4 (&acc)[2][2][4][2], const Unit& u, int wr, int wc, int fr, int fq) const {
        asm volatile("" : "+v"(fr), "+v"(fq));
        const int row0 = u.pm * BM + wr * 64 + fr, col0 = u.pn * BM + wc * 32 + 8 * fq;
#pragma unroll
        for (int ai = 0; ai < 2; ++ai)
#pragma unroll
            for (int m = 0; m < 4; ++m) { const int row = row0 + ai * HALF + m * 16; const float sc = rs[row - u.pm * BM];
#pragma unroll
                for (int bj = 0; bj < 2; ++bj) { const int col = col0 + bj * HALF; const f32x4 v0 = acc[ai][bj][m][0] * sc, v1 = acc[ai][bj][m][1] * sc;
                    if (col < ZLD) { u32x4 w; w.x = pk2(v0[0], v0[1]); w.y = pk2(v0[2], v0[3]); w.z = pk2(v1[0], v1[1]); w.w = pk2(v1[2], v1[3]); __builtin_nontemporal_store(w, (u32x4*)(Z + (size_t)row * ZLD + col)); }
                    else if (col < DIN) { float* gp = gates + (size_t)row * 24 + (col - ZLD); *(f32x4*)gp = v0; *(f32x4*)(gp + 4) = v1; } }
                asm volatile("" ::: "memory"); }
    }
};
struct EpiSwiGLU {
    static constexpr bool PERM = true; static constexpr int NST = 8;
    bf16_t* Z; const LAS float* rs;
    DI void operator()(const f32x4 (&acc)[2][2][4][2], const Unit& u, int wr, int wc, int fr, int fq) const {
        asm volatile("" : "+v"(fr), "+v"(fq));
        const int row0 = u.pm * BM + wr * 64 + fr, col0 = ACT_OFF + u.pn * HALF + wc * 32 + 8 * fq;
#pragma unroll
        for (int ai = 0; ai < 2; ++ai)
#pragma unroll
            for (int m = 0; m < 4; ++m) { const int row = row0 + ai * HALF + m * 16; const float sc = rs[row - u.pm * BM]; float o[8];
#pragma unroll
                for (int n = 0; n < 2; ++n)
#pragma unroll
                    for (int i = 0; i < 4; ++i) { const float gg = acc[ai][0][m][n][i] * sc, uu = acc[ai][1][m][n][i] * sc; o[4 * n + i] = gg * sigmoidf_(gg) * uu; }
                u32x4 w; w.x = pk2(o[0], o[1]); w.y = pk2(o[2], o[3]); w.z = pk2(o[4], o[5]); w.w = pk2(o[6], o[7]);
                __builtin_nontemporal_store(w, (u32x4*)(Z + (size_t)row * ZLD + col0));
                asm volatile("" ::: "memory"); }
    }
};
struct EpiSigmoid {
    static constexpr bool PERM = true; static constexpr int NST = 16;
    bf16_t* Z;
    DI void operator()(const f32x4 (&acc)[2][2][4][2], const Unit& u, int wr, int wc, int fr, int fq) const {
        asm volatile("" : "+v"(fr), "+v"(fq));
        const int row0 = u.pm * BM + wr * 64 + fr, col0 = u.pn * BM + wc * 32 + 8 * fq;
#pragma unroll
        for (int ai = 0; ai < 2; ++ai)
#pragma unroll
            for (int m = 0; m < 4; ++m) { const int row = row0 + ai * HALF + m * 16;
#pragma unroll
                for (int bj = 0; bj < 2; ++bj) { const f32x4 v0 = acc[ai][bj][m][0], v1 = acc[ai][bj][m][1]; u32x4 w;
                    w.x = pk2(sigmoidf_(v0[0]), sigmoidf_(v0[1])); w.y = pk2(sigmoidf_(v0[2]), sigmoidf_(v0[3])); w.z = pk2(sigmoidf_(v1[0]), sigmoidf_(v1[1])); w.w = pk2(sigmoidf_(v1[2]), sigmoidf_(v1[3]));
                    *(u32x4*)(Z + (size_t)row * ZLD + col0 + bj * HALF) = w; }
                asm volatile("" ::: "memory"); }
    }
};
template <bool MUL> struct EpiResid {
    static constexpr bool PERM = true; static constexpr int NST = 16;
    static constexpr int GM = MUL ? 2 : 4;
    const bf16_t* resid; bf16_t* xb; const bf16_t* mul; LAS float* ssq; bool wr_en;
    DI void operator()(const f32x4 (&acc)[2][2][4][2], const Unit& u, int wr, int wc, int fr, int fq) const {
        asm volatile("" : "+v"(fr), "+v"(fq));
        const int col0 = u.pn * BM + wc * 32 + 8 * fq;
#pragma unroll
        for (int ai = 0; ai < 2; ++ai)
#pragma unroll
            for (int mg = 0; mg < 4; mg += GM) {
                u32x4 rv[GM][2], mv[GM][2];
#pragma unroll
                for (int mm = 0; mm < GM; ++mm) { const size_t row = (size_t)(u.pm * BM + ai * HALF + wr * 64 + (mg + mm) * 16 + fr);
#pragma unroll
                    for (int bj = 0; bj < 2; ++bj) { const int col = col0 + bj * HALF; rv[mm][bj] = *(const u32x4*)(resid + row * DM + col);
                        if (MUL) mv[mm][bj] = *(const u32x4*)(mul + row * ZLD + col); } }
#pragma unroll
                for (int mm = 0; mm < GM; ++mm) { const int m = mg + mm; const int rl = ai * HALF + wr * 64 + m * 16 + fr; const size_t row = (size_t)(u.pm * BM + rl); float s = 0.f;
#pragma unroll
                    for (int bj = 0; bj < 2; ++bj) { const int col = col0 + bj * HALF; f32x4 a0 = acc[ai][bj][m][0], a1 = acc[ai][bj][m][1];
                        if (MUL) { const u32x4 q = mv[mm][bj];
                            a0[0] *= bflo(q.x); a0[1] *= bfhi(q.x); a0[2] *= bflo(q.y); a0[3] *= bfhi(q.y); a1[0] *= bflo(q.z); a1[1] *= bfhi(q.z); a1[2] *= bflo(q.w); a1[3] *= bfhi(q.w); }
                        const u32x4 r = rv[mm][bj];
                        const f32x4 x0 = {bflo(r.x) + a0[0], bfhi(r.x) + a0[1], bflo(r.y) + a0[2], bfhi(r.y) + a0[3]};
                        const f32x4 x1 = {bflo(r.z) + a1[0], bfhi(r.z) + a1[1], bflo(r.w) + a1[2], bfhi(r.w) + a1[3]};
                        if (wr_en) { u32x4 w; w.x = pk2(x0[0], x0[1]); w.y = pk2(x0[2], x0[3]); w.z = pk2(x1[0], x1[1]); w.w = pk2(x1[2], x1[3]); *(u32x4*)(xb + row * DM + col) = w; }
                        s += ((x0[0] * x0[0] + x0[1] * x0[1]) + (x0[2] * x0[2] + x0[3] * x0[3])) + ((x1[0] * x1[0] + x1[1] * x1[1]) + (x1[2] * x1[2] + x1[3] * x1[3])); }
                    s = xsum4(s);
                    if (fq == 0 && wr_en) ssq[rl * 4 + wc] += s; }
                asm volatile("" ::: "memory"); }
    }
};
}

struct KParams {
    const float* x; const float* p; const float* rel_bias; const float* attn_norm; const float* w_in; const float* qk_conv; const float* gate_bias; const float* sink;
    const float* mlstm_norm; const float* w_out; const float* ffn_norm; const float* w_up; const float* w_down; const float* ple_proj; const float* ple_gate; const float* final_norm;
    float* out; unsigned char* ws;
};

DI void transpose_item(const float* __restrict__ W, int K, int Nsrc, int n0, int nvalid, const float* __restrict__ gk, float cs,
                       bf16_t* __restrict__ WT, int dst_row0, int k0, LAS float* scr, int lane) {
    const int n4 = (lane & 7) * 4, kr = lane >> 3;
    f32x4 v[8];
#pragma unroll
    for (int i = 0; i < 8; ++i) { const int kk = kr + 8 * i; v[i] = (f32x4){0.f, 0.f, 0.f, 0.f};
        if (n4 < nvalid) v[i] = __builtin_nontemporal_load((const f32x4*)(W + (size_t)(k0 + kk) * Nsrc + n0 + n4)); }
#pragma unroll
    for (int i = 0; i < 8; ++i) { const int kk = kr + 8 * i; const float sc = gk ? gk[k0 + kk] * cs : cs;
        scr[kk * 33 + n4 + 0] = v[i][0] * sc; scr[kk * 33 + n4 + 1] = v[i][1] * sc; scr[kk * 33 + n4 + 2] = v[i][2] * sc; scr[kk * 33 + n4 + 3] = v[i][3] * sc; }
    WAVE_LDS_FENCE();
    const int c8 = lane & 7;
#pragma unroll
    for (int j = 0; j < 4; ++j) { const int n = (lane >> 3) + 8 * j; const LAS float* s = scr + (8 * c8) * 33 + n;
        u32x4 o; o.x = pk2(s[0 * 33], s[1 * 33]); o.y = pk2(s[2 * 33], s[3 * 33]); o.z = pk2(s[4 * 33], s[5 * 33]); o.w = pk2(s[6 * 33], s[7 * 33]);
        *(u32x4*)(WT + (size_t)(dst_row0 + n) * K + k0 + 8 * c8) = o; }
    WAVE_LDS_FENCE();
}
constexpr int IT_WIN = 16 * 104, IT_WOUT = 16 * 32, IT_WUP = 16 * 176, IT_WDOWN = 44 * 32, IT_WP = 4 * 32, IT_WG = 16 * 32;
constexpr int IT_LAYER = IT_WIN + IT_WOUT + IT_WUP + IT_WDOWN + IT_WP + IT_WG;

DI void prep_weights(const KParams& P, LAS unsigned char* lds, int gw, int NGW, int wave, int lane) {
    LAS float* scr = (LAS float*)(lds + wave * 16384);
    bf16_t* Wall = (bf16_t*)(P.ws + WS_W);
    for (int it = gw; it < DEPTH * IT_LAYER; it += NGW) {
        const int l = it / IT_LAYER; int r = it % IT_LAYER;
        bf16_t* Wl = Wall + (size_t)l * LAYER_W;
        if (r < IT_WIN) { const int kb = r / 104, jb = r % 104, d0 = 32 * jb; int src = d0, nv = 32; float cs = 1.f;
            if (d0 < 384) { src = d0; cs = QSCALE; } else if (d0 < 640) { src = 1152 + d0 - 384; cs = QSCALE; } else if (d0 < 1024) src = 1664 + d0 - 640;
            else if (d0 < 1408) src = 384 + d0 - 1024; else if (d0 < 1536) src = d0; else if (d0 < 1920) src = 2048 + d0 - 1536;
            else if (d0 < 2304) src = 768 + d0 - 1920; else if (d0 < 2432) src = 1536 + d0 - 2304; else if (d0 < 3200) src = d0;
            else if (d0 == 3200) { src = 3200; nv = 24; } else { src = 0; nv = 0; }
            transpose_item(P.w_in + (size_t)l * DM * DIN, DM, DIN, src, nv, P.attn_norm + l * DM, cs, Wl + OFF_WIN, d0, 64 * kb, scr, lane); continue; }
        r -= IT_WIN;
        if (r < IT_WOUT) { const int kb = r / 32, jb = r % 32; transpose_item(P.w_out + (size_t)l * DM * DM, DM, DM, 32 * jb, 32, nullptr, 1.f, Wl + OFF_WOUT, 32 * jb, 64 * kb, scr, lane); continue; }
        r -= IT_WOUT;
        if (r < IT_WUP) { const int kb = r / 176, jb = r % 176, d0 = 32 * jb, pn = d0 >> 8, c0 = d0 & 255; const int src = c0 < 128 ? 128 * pn + c0 : DFF + 128 * pn + (c0 - 128);
            transpose_item(P.w_up + (size_t)l * DM * NUP, DM, NUP, src, 32, P.ffn_norm + l * DM, 1.f, Wl + OFF_WUP, d0, 64 * kb, scr, lane); continue; }
        r -= IT_WUP;
        if (r < IT_WDOWN) { const int kb = r / 32, jb = r % 32; transpose_item(P.w_down + (size_t)l * DFF * DM, DFF, DM, 32 * jb, 32, nullptr, 1.f, Wl + OFF_WDOWN, 32 * jb, 64 * kb, scr, lane); continue; }
        r -= IT_WDOWN;
        if (r < IT_WP) { const int kb = r / 32, jb = r % 32; transpose_item(P.ple_proj + (size_t)l * PLE * DM, PLE, DM, 32 * jb, 32, nullptr, 1.f, Wl + OFF_WP, 32 * jb, 64 * kb, scr, lane); continue; }
        r -= IT_WP;
        { const int kb = r / 32, jb = r % 32; transpose_item(P.ple_gate + (size_t)l * DM * DM, DM, DM, 32 * jb, 32, nullptr, 1.f, Wl + OFF_WG, 32 * jb, 64 * kb, scr, lane); }
    }
}
DI float wave_sum(float v, int lane) {
#pragma unroll
    for (int o = 1; o < 64; o <<= 1) v += shx(v, o, lane);
    return v;
}
DI float wave_max(float v, int lane) {
#pragma unroll
    for (int o = 1; o < 64; o <<= 1) v = fmaxf(v, shx(v, o, lane));
    return v;
}

constexpr int VROW = 144;
constexpr int VBUF = 32 * VROW;
constexpr int LUTA = 256, LUTAC = 128, LUTB = 320, LUTBC = 160;
constexpr int LUT_BYTES = (18 * LUTA + 4 * LUTB) * 4, PBUF_BYTES = 256 * 136;

template <bool EDGE>
DI void load_kv(const bf16_t* __restrict__ zb, int kcol, int vcol, int dstr, int rd, int u0, int lane, bf16x8 (&kn)[2][2], u32x4 (&vn)[4]) {
    const int r16 = lane & 15, g = lane >> 4;
#pragma unroll
    for (int T = 0; T < 2; ++T) { int pos = dstr * (u0 + 16 * T + r16) + rd; if (EDGE) pos = pos < 0 ? 0 : (pos > SEQ - 1 ? SEQ - 1 : pos);
        const unsigned off = (unsigned)pos * (unsigned)ZLD + (unsigned)(kcol + 8 * g); kn[T][0] = *(const bf16x8*)(zb + off); kn[T][1] = *(const bf16x8*)(zb + off + 32u); }
#pragma unroll
    for (int k = 0; k < 4; ++k) { const int id = lane + 64 * k, row = id >> 3, c16 = id & 7; int pos = dstr * (u0 + row) + rd; if (EDGE) pos = pos < 0 ? 0 : (pos > SEQ - 1 ? SEQ - 1 : pos);
        const unsigned off = (unsigned)pos * (unsigned)ZLD + (unsigned)(vcol + 8 * c16); vn[k] = *(const u32x4*)(zb + off); }
}

struct DescA {
    int rd0, rd1, ub0, ub1, uq0, uq1, tb;
    DI void get(int ci, int g, int& dstr, int& rd, int& u0, int& li) const {
        const int t1 = ci >= 5 ? 1 : 0;
        dstr = 16 - 12 * t1; rd = rd0 + t1 * (rd1 - rd0);
        const int lc = ci - 5 * t1;
        u0 = ub0 + t1 * (ub1 - ub0) + 32 * lc;
        const int uq = uq0 + t1 * (uq1 - uq0);
        li = u0 - uq + 4 * g + LUTAC + tb + t1 * 6 * LUTA; }
};
struct DescB {
    int ub, uq, tb, lc;
    DI void get(int ci, int g, int& dstr, int& rd, int& u0, int& li) const { dstr = 1; rd = 0; u0 = ub + 32 * ci; li = u0 - uq + 4 * g + lc + tb; }
};

template <int NH, int D, bool EDGE, class Desc>
DI void attn_stream(const bf16_t* __restrict__ zb, int kcol, int vcol, int nch, const Desc& ds, const LAS float* lutbase, int lstr,
                    const bf16x8 (&qf)[NH][2], float (&m)[NH], float (&l)[NH], f32x4 (&o)[NH][4], LAS unsigned char* vbase, int lane) {
    const int r16 = lane & 15, g = lane >> 4, q4 = r16 >> 2, p4 = r16 & 3;
    bf16x8 kn[D][2][2]; u32x4 vn[D][4];
#pragma unroll
    for (int j = 0; j < D; ++j) if (j < nch) { int dstr, rd, u0, li; ds.get(j, g, dstr, rd, u0, li); load_kv<EDGE>(zb, kcol, vcol, dstr, rd, u0, lane, kn[j], vn[j]); }
#pragma unroll 1
    for (int c0 = 0; c0 < nch; c0 += D) {
#pragma unroll
        for (int j = 0; j < D; ++j) {
            const int c = c0 + j;
            if (c < nch) {
                int dstr, rd, u0, li; ds.get(c, g, dstr, rd, u0, li);
                LAS unsigned char* vb = vbase + (c & 1) * VBUF;
#pragma unroll
                for (int k = 0; k < 4; ++k) { const int id = lane + 64 * k, row = id >> 3, c16 = id & 7; *(LAS u32x4*)(vb + row * VROW + c16 * 16) = vn[j][k]; }
                f32x4 stt[NH][2];
#pragma unroll
                for (int hh = 0; hh < NH; ++hh)
#pragma unroll
                    for (int T = 0; T < 2; ++T) { f32x4 st = {0.f, 0.f, 0.f, 0.f}; st = mfma16(kn[j][T][0], qf[hh][0], st); st = mfma16(kn[j][T][1], qf[hh][1], st); stt[hh][T] = st; }
                if (c + D < nch) { int d2, r2, u2, l2; ds.get(c + D, g, d2, r2, u2, l2); load_kv<EDGE>(zb, kcol, vcol, d2, r2, u2, lane, kn[j], vn[j]); }
                float rm[2][4];
#pragma unroll
                for (int T = 0; T < 2; ++T)
#pragma unroll
                    for (int i = 0; i < 4; ++i) { const int pos = dstr * (u0 + 16 * T + 4 * g + i) + rd; rm[T][i] = (!EDGE || (unsigned)pos < (unsigned)SEQ) ? 0.f : NEGBIG; }
                bf16x8 vf[4];
#pragma unroll
                for (int c4 = 0; c4 < 4; ++c4) { const s16x4 a0 = trread(vb + (4 * g + q4) * VROW + 32 * c4 + 8 * p4), a1 = trread(vb + (16 + 4 * g + q4) * VROW + 32 * c4 + 8 * p4); vf[c4] = cat8(a0, a1); }
#pragma unroll
                for (int hh = 0; hh < NH; ++hh) {
                    const LAS float* lut = lutbase + hh * lstr + li;
                    float sv[8];
#pragma unroll
                    for (int T = 0; T < 2; ++T) {
#pragma unroll
                        for (int i = 0; i < 4; ++i) sv[4 * T + i] = EDGE ? (stt[hh][T][i] + lut[16 * T + i] + rm[T][i]) : (stt[hh][T][i] + lut[16 * T + i]); }
                    float cm = fmaxf(fmaxf(fmaxf(sv[0], sv[1]), fmaxf(sv[2], sv[3])), fmaxf(fmaxf(sv[4], sv[5]), fmaxf(sv[6], sv[7])));
                    cm = xmax4(cm);
                    const float mn = fmaxf(m[hh], cm), alpha = ex2(m[hh] - mn); m[hh] = mn;
                    float pv[8], ps = 0.f;
#pragma unroll
                    for (int k = 0; k < 8; ++k) { pv[k] = ex2(sv[k] - mn); ps += pv[k]; }
                    l[hh] = l[hh] * alpha + ps;
                    u32x4 pw; pw.x = pk2(pv[0], pv[1]); pw.y = pk2(pv[2], pv[3]); pw.z = pk2(pv[4], pv[5]); pw.w = pk2(pv[6], pv[7]);
                    const bf16x8 pf = __builtin_bit_cast(bf16x8, pw);
#pragma unroll
                    for (int c4 = 0; c4 < 4; ++c4) { o[hh][c4] = o[hh][c4] * alpha; o[hh][c4] = mfma16(vf[c4], pf, o[hh][c4]); }
                }
            }
        }
    }
}

DI void build_lut(const KParams& P, LAS unsigned char* lds, int tid) {
    LAS float* lut = (LAS float*)lds;
    for (int idx = tid; idx < 18 * LUTA + 4 * LUTB; idx += 512) {
        int rel, dil, half, hc;
        if (idx < 18 * LUTA) { const int t = idx / LUTA, cfg = t / 6; rel = idx % LUTA - LUTAC; dil = cfg == 0 ? 16 : (cfg == 1 ? 4 : 1); half = 64; hc = t % 6; }
        else { const int j = idx - 18 * LUTA; rel = j % LUTB - LUTBC; dil = 1; half = 128; hc = 6 + j / LUTB; }
        float v = NEGBIG; const int ar = rel < 0 ? -rel : rel;
        if (ar <= half) { const int n = ar * dil; int bk;
            if (n < 8) bk = n; else { const float nf = (float)n; bk = 8 + (int)(logf(nf / 8.0f) / 4.852030263919617f * 8.0f); bk = bk > 15 ? 15 : bk; }
            if (rel > 0) bk += 16;
            v = P.rel_bias[bk * 10 + hc] * LOG2E; }
        lut[idx] = v;
    }
}

DI void attention_phase(const KParams& P0_, LAS unsigned char* lds, int l, int pm, int wave, int lane, bool wr_en = true) {
    KParams P = P0_; { __attribute__((address_space(1))) unsigned char* w1_ = (__attribute__((address_space(1))) unsigned char*)P.ws; asm volatile("" : "+s"(w1_)); P.ws = (unsigned char*)w1_; }
    bf16_t* Z = (bf16_t*)(P.ws + WS_Z);
    const int r16 = lane & 15, g = lane >> 4;
    const int row0 = pm * 256, b = row0 / SEQ, s0 = row0 % SEQ;
    bf16_t* zb = Z + (size_t)b * SEQ * ZLD;
    const LAS float* lut = (const LAS float*)lds;
    LAS unsigned char* pbuf = lds + LUT_BYTES;
    LAS unsigned char* vbase = lds + LUT_BYTES + PBUF_BYTES + wave * (2 * VBUF);
    const bool edge1 = s0 < 64 || s0 + 256 + 96 > SEQ, edge2 = s0 < 1024 || s0 + 1536 > SEQ, edgeb = s0 < 128 || s0 + 256 + 160 > SEQ;
    for (int h = 0; h < 6; ++h) {
        for (int qg = wave; qg < 16; qg += 8) {
            const int posq = s0 + 16 * qg + r16;
            bf16x8 qf[1][2];
            { const bf16_t* qp = zb + (size_t)posq * ZLD + QA + 64 * h + 8 * g; qf[0][0] = *(const bf16x8*)qp; qf[0][1] = *(const bf16x8*)(qp + 32); }
            float m[1] = {-1e20f}, lsum[1] = {0.f}; f32x4 o[1][4];
#pragma unroll
            for (int c4 = 0; c4 < 4; ++c4) o[0][c4] = zero4();
            { DescB ds; const int U1 = s0 + 16 * qg; ds.ub = U1 - 64; ds.uq = U1 + r16; ds.tb = (12 + h) * LUTA; ds.lc = LUTAC;
              if (edge1) attn_stream<1, 2, true, DescB>(zb, KA + 64 * h, VA + 64 * h, 5, ds, lut, 0, qf, m, lsum, o, vbase, lane);
              else attn_stream<1, 2, false, DescB>(zb, KA + 64 * h, VA + 64 * h, 5, ds, lut, 0, qf, m, lsum, o, vbase, lane); }
            const float lt = xsum4(lsum[0]);
            LAS unsigned char* pq = pbuf + (16 * qg + r16) * 136;
#pragma unroll
            for (int c4 = 0; c4 < 4; ++c4) { const f32x4 v = o[0][c4]; u32x2 w; w.x = pk2(v[0], v[1]); w.y = pk2(v[2], v[3]); *(LAS u32x2*)(pq + (16 * c4 + 4 * g) * 2) = w; }
            if (g == 0) { *(LAS float*)(pq + 128) = m[0]; *(LAS float*)(pq + 132) = lt; }
        }
        __syncthreads();
        for (int rho = wave; rho < 16; rho += 8) {
            const int posq = s0 + rho + 16 * r16;
            bf16x8 qf[1][2];
            { const bf16_t* qp = zb + (size_t)posq * ZLD + QA + 64 * h + 8 * g; qf[0][0] = *(const bf16x8*)qp; qf[0][1] = *(const bf16x8*)(qp + 32); }
            float m[1] = {-1e20f}, lsum[1] = {0.f}; f32x4 o[1][4];
#pragma unroll
            for (int c4 = 0; c4 < 4; ++c4) o[0][c4] = zero4();
            { DescA ds; const int U16 = s0 >> 4, U4 = (s0 >> 2) + (rho >> 2);
              ds.rd0 = rho; ds.rd1 = rho & 3; ds.ub0 = U16 - 64; ds.ub1 = U4 - 64; ds.uq0 = U16 + r16; ds.uq1 = U4 + 4 * r16; ds.tb = h * LUTA;
              if (edge2) attn_stream<1, 2, true, DescA>(zb, KA + 64 * h, VA + 64 * h, 11, ds, lut, 0, qf, m, lsum, o, vbase, lane);
              else attn_stream<1, 2, false, DescA>(zb, KA + 64 * h, VA + 64 * h, 11, ds, lut, 0, qf, m, lsum, o, vbase, lane); }
            const float lt = xsum4(lsum[0]);
            const LAS unsigned char* pq = pbuf + (rho + 16 * r16) * 136;
            const float m1 = *(const LAS float*)(pq + 128), l1 = *(const LAS float*)(pq + 132);
            const float mf = fmaxf(m[0], m1), a0 = ex2(m[0] - mf), a1 = ex2(m1 - mf);
            const float inv = 1.f / (lt * a0 + l1 * a1), f0 = a0 * inv, f1 = a1 * inv;
            bf16_t* yp = zb + (size_t)posq * ZLD + QA + 64 * h + 4 * g;
            if (wr_en)
#pragma unroll
            for (int c4 = 0; c4 < 4; ++c4) { const u32x2 pw = *(const LAS u32x2*)(pq + (16 * c4 + 4 * g) * 2); const f32x4 v = o[0][c4];
                u32x2 w; w.x = pk2(v[0] * f0 + bflo(pw.x) * f1, v[1] * f0 + bfhi(pw.x) * f1); w.y = pk2(v[2] * f0 + bflo(pw.y) * f1, v[3] * f0 + bfhi(pw.y) * f1); *(u32x2*)(yp + 16 * c4) = w; }
        }
        __syncthreads();
    }
    for (int ub = wave; ub < 32; ub += 8) {
        const int kvh = ub >> 4, qg = ub & 15;
        const int posq = s0 + 16 * qg + r16;
        bf16x8 qf[2][2];
#pragma unroll
        for (int hh = 0; hh < 2; ++hh) { const bf16_t* qp = zb + (size_t)posq * ZLD + QB + 64 * (2 * kvh + hh) + 8 * g; qf[hh][0] = *(const bf16x8*)qp; qf[hh][1] = *(const bf16x8*)(qp + 32); }
        float m[2] = {-1e20f, -1e20f}, lsum[2] = {0.f, 0.f}; f32x4 o[2][4];
#pragma unroll
        for (int hh = 0; hh < 2; ++hh)
#pragma unroll
            for (int c4 = 0; c4 < 4; ++c4) o[hh][c4] = zero4();
        const int U0 = s0 + 16 * qg;
        { DescB ds; ds.ub = U0 - 128; ds.uq = U0 + r16; ds.tb = 18 * LUTA + (2 * kvh) * LUTB; ds.lc = LUTBC;
          if (edgeb) attn_stream<2, 2, true, DescB>(zb, KB + 64 * kvh, VB + 64 * kvh, 9, ds, lut, LUTB, qf, m, lsum, o, vbase, lane);
          else attn_stream<2, 2, false, DescB>(zb, KB + 64 * kvh, VB + 64 * kvh, 9, ds, lut, LUTB, qf, m, lsum, o, vbase, lane); }
#pragma unroll
        for (int hh = 0; hh < 2; ++hh) { const int hq = 2 * kvh + hh;
            const float lt = xsum4(lsum[hh]);
            const float sk = P.sink[l * 4 + hq] * LOG2E, mf = fmaxf(m[hh], sk), sc = ex2(m[hh] - mf);
            const float den = lt * sc + ex2(sk - mf), f = sc / den;
            bf16_t* yp = zb + (size_t)posq * ZLD + QB + 64 * hq + 4 * g;
            if (wr_en)
#pragma unroll
            for (int c4 = 0; c4 < 4; ++c4) { const f32x4 v = o[hh][c4] * f; u32x2 w; w.x = pk2(v[0], v[1]); w.y = pk2(v[2], v[3]); *(u32x2*)(yp + 16 * c4) = w; } }
    }
}

DI float logsig(float x) { return fminf(x, 0.f) - log1pf(fexp(-fabsf(x))); }
DI float scan_add_up(float v, int lane) {
#pragma unroll
    for (int o = 1; o < 64; o <<= 1) { const float t = shi(v, lane - o); if (lane >= o) v += t; }
    return v;
}
DI float scan_add_down(float v, int lane) {
#pragma unroll
    for (int o = 1; o < 64; o <<= 1) { const float t = shi(v, lane + o); if (lane + o < 64) v += t; }
    return v;
}
DI float scan_max_up(float v, int lane) {
#pragma unroll
    for (int o = 1; o < 64; o <<= 1) { const float t = shi(v, lane - o); if (lane >= o) v = fmaxf(v, t); }
    return v;
}
DI float scan_max_down(float v, int lane) {
#pragma unroll
    for (int o = 1; o < 64; o <<= 1) { const float t = shi(v, lane + o); if (lane + o < 64) v = fmaxf(v, t); }
    return v;
}

DI void conv8(const bf16_t* __restrict__ zb, int s, int col, const float* __restrict__ cw  , int lane, float (&acc)[8][8]) {
    const int r8 = lane >> 3;
    float w[5][8];
#pragma unroll
    for (int j = 0; j < 5; ++j) { const f32x4 a = *(const f32x4*)(cw + j * 768), b = *(const f32x4*)(cw + j * 768 + 4);
        w[j][0] = a[0]; w[j][1] = a[1]; w[j][2] = a[2]; w[j][3] = a[3]; w[j][4] = b[0]; w[j][5] = b[1]; w[j][6] = b[2]; w[j][7] = b[3]; }
#pragma unroll
    for (int k = 0; k < 8; ++k)
#pragma unroll
        for (int e = 0; e < 8; ++e) acc[k][e] = 0.f;
#pragma unroll
    for (int rr = -2; rr < 10; ++rr) {
        const int pos = s + 8 * r8 + rr;
        u32x4 raw = {0u, 0u, 0u, 0u};
        if ((unsigned)pos < (unsigned)SEQ) raw = *(const u32x4*)(zb + (size_t)pos * ZLD + col);
        float x[8] = {bflo(raw.x), bfhi(raw.x), bflo(raw.y), bfhi(raw.y), bflo(raw.z), bfhi(raw.z), bflo(raw.w), bfhi(raw.w)};
#pragma unroll
        for (int k = 0; k < 8; ++k) { const int j = rr - k + 2;
            if (j >= 0 && j <= 4) {
#pragma unroll
                for (int e = 0; e < 8; ++e) acc[k][e] += w[j][e] * x[e]; } }
    }
#pragma unroll
    for (int k = 0; k < 8; ++k)
#pragma unroll
        for (int e = 0; e < 8; ++e) { const float a = acc[k][e]; acc[k][e] = a * sigmoidf_(a); }
}

DI void mlstm_state_phase(const KParams& P0_, LAS unsigned char* lds, int l, int pm, int wave, int lane) {
    KParams P = P0_; { __attribute__((address_space(1))) unsigned char* w1_ = (__attribute__((address_space(1))) unsigned char*)P.ws; asm volatile("" : "+s"(w1_)); P.ws = (unsigned char*)w1_; }

    bf16_t* Z = (bf16_t*)(P.ws + WS_Z);
    const float* gates = (const float*)(P.ws + WS_GATES);
    bf16_t* qconv = (bf16_t*)(P.ws + WS_QCONV); bf16_t* kconv = (bf16_t*)(P.ws + WS_KCONV);
    bf16_t* CT = (bf16_t*)(P.ws + WS_CT); bf16_t* nbuf = (bf16_t*)(P.ws + WS_NB);
    float* mloc = (float*)(P.ws + WS_ML); float* blast = (float*)(P.ws + WS_BL);
    const float* gb = P.gate_bias + l * 24;
    const int r16 = lane & 15, g = lane >> 4, q4 = r16 >> 2, p4 = r16 & 3, r8 = lane >> 3, pc = lane & 7;
    LAS unsigned char* kbuf = lds + wave * (2 * 64 * VROW);
    LAS unsigned char* vbuf = kbuf + 64 * VROW;
    for (int um = wave; um < 24; um += 8) {
        asm volatile("" : "+v"(lane));
        const int cc = um / 6, h = um % 6;
        const int tc = pm * 256 + 64 * cc, b = tc / SEQ, s = tc % SEQ, ci = s >> 6;
        const bf16_t* zb = Z + (size_t)b * SEQ * ZLD;
        const float* G = gates + (size_t)(tc + lane) * 24;
        const float igf = G[h] + gb[h], fgf = G[6 + h] + gb[6 + h], igb = G[12 + h] + gb[12 + h], fgb = G[18 + h] + gb[18 + h];
        const float bfw = scan_add_up(logsig(fgf), lane), bbw = scan_add_down(logsig(fgb), lane);
        const float blf = shi(bfw, 63), blb = shi(bbw, 0);
        const float wf = blf - bfw + igf, wb = blb - bbw + igb;
        const float mlf = wave_max(wf, lane), mlb = wave_max(wb, lane);
        const float ef = fexp(wf - mlf), eb = fexp(wb - mlb);
        const int slot_f = ((0 * NB + b) * 6 + h) * NCH + ci, slot_b = ((1 * NB + b) * 6 + h) * NCH + ci;
        if (lane == 0) { mloc[slot_f] = mlf; blast[slot_f] = blf; mloc[slot_b] = mlb; blast[slot_b] = blb; }
        float acc[8][8];
        conv8(zb, s, QC + 64 * h + 8 * pc, P.qk_conv + (size_t)l * 5 * 768 + 64 * h + 8 * pc, lane, acc);
#pragma unroll
        for (int k = 0; k < 8; ++k) { u32x4 w; w.x = pk2(acc[k][0], acc[k][1]); w.y = pk2(acc[k][2], acc[k][3]); w.z = pk2(acc[k][4], acc[k][5]); w.w = pk2(acc[k][6], acc[k][7]);
            *(u32x4*)(qconv + (size_t)(tc + 8 * r8 + k) * 384 + 64 * h + 8 * pc) = w; }
        conv8(zb, s, KC + 64 * h + 8 * pc, P.qk_conv + (size_t)l * 5 * 768 + 384 + 64 * h + 8 * pc, lane, acc);
        u32x4 kpk[8];
#pragma unroll
        for (int k = 0; k < 8; ++k) {
#pragma unroll
            for (int e = 0; e < 8; ++e) acc[k][e] *= 0.125f;
            u32x4 w; w.x = pk2(acc[k][0], acc[k][1]); w.y = pk2(acc[k][2], acc[k][3]); w.z = pk2(acc[k][4], acc[k][5]); w.w = pk2(acc[k][6], acc[k][7]);
            kpk[k] = w;
            *(u32x4*)(kconv + (size_t)(tc + 8 * r8 + k) * 384 + 64 * h + 8 * pc) = w; }
#pragma unroll
        for (int k = 0; k < 8; ++k) { const int id = lane + 64 * k, row = id >> 3, c16 = id & 7;
            *(LAS u32x4*)(vbuf + row * VROW + 16 * c16) = *(const u32x4*)(zb + (size_t)(s + row) * ZLD + VC + 64 * h + 8 * c16); }
#pragma unroll
        for (int dir = 0; dir < 2; ++dir) {
            const float ed = dir ? eb : ef;
#pragma unroll
            for (int k = 0; k < 8; ++k) { const float e = shi(ed, 8 * r8 + k); const u32x4 kk = kpk[k];
                u32x4 w; w.x = pk2(bflo(kk.x) * e, bfhi(kk.x) * e); w.y = pk2(bflo(kk.y) * e, bfhi(kk.y) * e); w.z = pk2(bflo(kk.z) * e, bfhi(kk.z) * e); w.w = pk2(bflo(kk.w) * e, bfhi(kk.w) * e);
                *(LAS u32x4*)(kbuf + (8 * r8 + k) * VROW + 16 * pc) = w; }
            WAVE_LDS_FENCE();
            f32x4 c[4][5];
#pragma unroll
            for (int dt = 0; dt < 4; ++dt)
#pragma unroll
                for (int et = 0; et < 5; ++et) c[dt][et] = zero4();
#pragma unroll
            for (int ks = 0; ks < 2; ++ks) {
                bf16x8 af[4], bfr[5];
#pragma unroll
                for (int t4 = 0; t4 < 4; ++t4) {
                    af[t4] = cat8(trread(kbuf + (32 * ks + 8 * g + q4) * VROW + 32 * t4 + 8 * p4), trread(kbuf + (32 * ks + 8 * g + 4 + q4) * VROW + 32 * t4 + 8 * p4));
                    bfr[t4] = cat8(trread(vbuf + (32 * ks + 8 * g + q4) * VROW + 32 * t4 + 8 * p4), trread(vbuf + (32 * ks + 8 * g + 4 + q4) * VROW + 32 * t4 + 8 * p4)); }
                { const short one = r16 == 0 ? (short)0x3F80 : (short)0; bfr[4] = (bf16x8){one, one, one, one, one, one, one, one}; }
#pragma unroll
                for (int dt = 0; dt < 4; ++dt)
#pragma unroll
                    for (int et = 0; et < 5; ++et) c[dt][et] = mfma16(af[dt], bfr[et], c[dt][et]);
            }
            const int slot = dir ? slot_b : slot_f;
            bf16_t* ct = CT + ((size_t)(slot / NCH) * 64 * NCH + (slot % NCH)) * 64;
#pragma unroll
            for (int dt = 0; dt < 4; ++dt) {
#pragma unroll
                for (int et = 0; et < 4; ++et) { const f32x4 v = c[dt][et]; u32x2 w; w.x = pk2(v[0], v[1]); w.y = pk2(v[2], v[3]); *(u32x2*)(ct + (size_t)(16 * et + r16) * (NCH * 64) + 16 * dt + 4 * g) = w; }
                if (r16 == 0) { const f32x4 v = c[dt][4]; u32x2 w; w.x = pk2(v[0], v[1]); w.y = pk2(v[2], v[3]); *(u32x2*)(nbuf + (size_t)slot * 64 + 16 * dt + 4 * g) = w; } }
            WAVE_LDS_FENCE();
        }
    }
}

DI void mlstm_scan_phase(const KParams& P0_, LAS unsigned char* lds, int bid, int G, int tid, bool wr_en = true) {
    KParams P = P0_; { __attribute__((address_space(1))) unsigned char* w1_ = (__attribute__((address_space(1))) unsigned char*)P.ws; asm volatile("" : "+s"(w1_)); P.ws = (unsigned char*)w1_; }
    bf16_t* CT = (bf16_t*)(P.ws + WS_CT); bf16_t* nbuf = (bf16_t*)(P.ws + WS_NB);
    const float* mloc = (const float*)(P.ws + WS_ML); const float* blast = (const float*)(P.ws + WS_BL); float* mprev = (float*)(P.ws + WS_MP);
    LAS float* sbl = (LAS float*)lds; LAS float* sml = sbl + 512; LAS float* sa = sml + 512; LAS float* scc = sa + 512;
    const int wave = tid >> 6, lane = tid & 63;
    const int sb_ = bid >> 5, sj_ = bid & 31;
#define SCAN_SEQ(dh) ((((dh) / 6) * NB + sb_) * 6 + (dh) % 6)
    { const int k = tid >> 7, st = tid & 127; const int dh = k < 3 ? (sj_ >> 3) + 4 * k : (sj_ < 12 ? sj_ : 0); const int sq = SCAN_SEQ(dh); const int c = sq >= NSEQ / 2 ? (NCH - 1 - st) : st;
      sbl[tid] = blast[sq * NCH + c]; sml[tid] = mloc[sq * NCH + c]; }
    __syncthreads();
    if (tid < 4) { const int k = tid; const int dh = k < 3 ? (sj_ >> 3) + 4 * k : (sj_ < 12 ? sj_ : 0); const int sq = SCAN_SEQ(dh); const bool dirb = sq >= NSEQ / 2;
        const bool wm = wr_en && k < 3 && (sj_ & 7) == 0;
        float m = 0.f;
        for (int st = 0; st < NCH; ++st) { const float bl = sbl[k * 128 + st], ml = sml[k * 128 + st]; const float mn = fmaxf(bl + m, ml);
            sa[k * 128 + st] = fexp(bl + m - mn); scc[k * 128 + st] = fexp(ml - mn);
            if (wm) mprev[sq * NCH + (dirb ? (NCH - 1 - st) : st)] = m;
            m = mn; } }
    __syncthreads();
    bf16_t* ptr[4]; bool act[4]; bool dirb[4];
#pragma unroll
    for (int k = 0; k < 3; ++k) { const int sq = SCAN_SEQ((sj_ >> 3) + 4 * k); const int row = sq * 64 + 8 * (sj_ & 7) + wave; ptr[k] = CT + (size_t)row * (NCH * 64) + lane; act[k] = true; dirb[k] = sq >= NSEQ / 2; }
    { const int sq = SCAN_SEQ(sj_ < 12 ? sj_ : 0); ptr[3] = nbuf + (size_t)sq * NCH * 64 + lane; act[3] = sj_ < 12 && wave == 0; dirb[3] = sq >= NSEQ / 2; }
    float C[4] = {0.f, 0.f, 0.f, 0.f};
    for (int st0 = 0; st0 < NCH; st0 += 16) {
        float cl[4][16];
#pragma unroll
        for (int k = 0; k < 4; ++k)
#pragma unroll
            for (int j = 0; j < 16; ++j) { const int c = dirb[k] ? (NCH - 1 - (st0 + j)) : (st0 + j); cl[k][j] = act[k] ? bf2f(ptr[k][c * 64]) : 0.f; }
#pragma unroll
        for (int k = 0; k < 4; ++k)
#pragma unroll
            for (int j = 0; j < 16; ++j) { const int c = dirb[k] ? (NCH - 1 - (st0 + j)) : (st0 + j);
                if (act[k] && wr_en) ptr[k][c * 64] = (bf16_t)(pk2(C[k], 0.f) & 0xffffu);
                C[k] = sa[k * 128 + st0 + j] * C[k] + scc[k * 128 + st0 + j] * cl[k][j]; }
    }
    __syncthreads();
#undef SCAN_SEQ
}

DI void mlstm_out_phase(const KParams& P0_, LAS unsigned char* lds, int l, int pm, int wave, int lane) {
    KParams P = P0_; { __attribute__((address_space(1))) unsigned char* w1_ = (__attribute__((address_space(1))) unsigned char*)P.ws; asm volatile("" : "+s"(w1_)); P.ws = (unsigned char*)w1_; }

    bf16_t* Z = (bf16_t*)(P.ws + WS_Z);
    const float* gates = (const float*)(P.ws + WS_GATES);
    const bf16_t* qconv = (const bf16_t*)(P.ws + WS_QCONV); const bf16_t* kconv = (const bf16_t*)(P.ws + WS_KCONV);
    const bf16_t* CT = (const bf16_t*)(P.ws + WS_CT); const bf16_t* nbuf = (const bf16_t*)(P.ws + WS_NB);
    const float* mprev = (const float*)(P.ws + WS_MP);
    const float* gb = P.gate_bias + l * 24;
    const int r16 = lane & 15, g = lane >> 4, q4 = r16 >> 2, p4 = r16 & 3;
    LAS unsigned char* vbuf = lds + wave * (64 * VROW + 2048 + 256);
    LAS float* tab = (LAS float*)(vbuf + 64 * VROW);
    LAS unsigned char* ntab = vbuf + 64 * VROW + 2048;
    for (int um = wave; um < 24; um += 8) {
        asm volatile("" : "+v"(lane));
        const int cc = um / 6, h = um % 6;
        const int tc = pm * 256 + 64 * cc, b = tc / SEQ, s = tc % SEQ, ci = s >> 6;
        bf16_t* zb = Z + (size_t)b * SEQ * ZLD;
        const int slot_f = ((0 * NB + b) * 6 + h) * NCH + ci, slot_b = ((1 * NB + b) * 6 + h) * NCH + ci;
        u32x4 vreg[8];
#pragma unroll
        for (int k = 0; k < 8; ++k) { const int id = lane + 64 * k, row = id >> 3, c16 = id & 7; vreg[k] = *(const u32x4*)(zb + (size_t)(s + row) * ZLD + VC + 64 * h + 8 * c16); }
        bf16x8 kfr[4][2];
#pragma unroll
        for (int st = 0; st < 4; ++st) { const bf16_t* kp = kconv + (size_t)(tc + 16 * st + r16) * 384 + 64 * h + 8 * g; kfr[st][0] = *(const bf16x8*)kp; kfr[st][1] = *(const bf16x8*)(kp + 32); }
        bf16x8 cfr[2][4][2];
#pragma unroll
        for (int dir = 0; dir < 2; ++dir) { const int slot = dir ? slot_b : slot_f; const bf16_t* ct = CT + ((size_t)(slot / NCH) * 64 * NCH + (slot % NCH)) * 64;
#pragma unroll
            for (int kp = 0; kp < 2; ++kp)
#pragma unroll
                for (int et = 0; et < 4; ++et) cfr[dir][et][kp] = *(const bf16x8*)(ct + (size_t)(16 * et + r16) * (NCH * 64) + 32 * kp + 8 * g); }
        {
            const float* G = gates + (size_t)(tc + lane) * 24;
            const float igf = G[h] + gb[h], fgf = G[6 + h] + gb[6 + h], igb = G[12 + h] + gb[12 + h], fgb = G[18 + h] + gb[18 + h];
            const float bfw = scan_add_up(logsig(fgf), lane), bbw = scan_add_down(logsig(fgb), lane);
            const float gf = igf - bfw, gbk = igb - bbw;
            const float pmf = scan_max_up(gf, lane), pmb = scan_max_down(gbk, lane);
            const float mpf = mprev[slot_f], mpb = mprev[slot_b];
            const float Mf = fmaxf(pmf, mpf), Mb = fmaxf(pmb, mpb);
            tab[0 * 64 + lane] = gf; tab[1 * 64 + lane] = gbk; tab[2 * 64 + lane] = Mf; tab[3 * 64 + lane] = Mb;
            tab[4 * 64 + lane] = fexp(mpf - Mf); tab[5 * 64 + lane] = fexp(mpb - Mb); tab[6 * 64 + lane] = fexp(-(bfw + Mf)); tab[7 * 64 + lane] = fexp(-(bbw + Mb));
        }
#pragma unroll
        for (int k = 0; k < 8; ++k) { const int id = lane + 64 * k, row = id >> 3, c16 = id & 7; *(LAS u32x4*)(vbuf + row * VROW + 16 * c16) = vreg[k]; }
        if (lane < 16) { const int dirn = lane >> 3, c8 = lane & 7; *(LAS u32x4*)(ntab + dirn * 128 + c8 * 16) = *(const u32x4*)(nbuf + (size_t)(dirn ? slot_b : slot_f) * 64 + 8 * c8); }
        WAVE_LDS_FENCE();
        for (int tt = 0; tt < 4; ++tt) {
            const int tau = 16 * tt + r16;
            bf16x8 qfr[2];
            { const bf16_t* qp = qconv + (size_t)(tc + tau) * 384 + 64 * h + 8 * g; qfr[0] = *(const bf16x8*)qp; qfr[1] = *(const bf16x8*)(qp + 32); }
            u32x2 ocv[4];
#pragma unroll
            for (int et = 0; et < 4; ++et) ocv[et] = *(const u32x2*)(zb + (size_t)(s + tau) * ZLD + OC + 64 * h + 16 * et + 4 * g);
            f32x4 S[4];
#pragma unroll
            for (int st = 0; st < 4; ++st) { S[st] = (f32x4){0.f, 0.f, 0.f, 0.f}; S[st] = mfma16(kfr[st][0], qfr[0], S[st]); S[st] = mfma16(kfr[st][1], qfr[1], S[st]); }
            f32x4 hs[4];
#pragma unroll
            for (int et = 0; et < 4; ++et) hs[et] = zero4();
#pragma unroll
            for (int dir = 0; dir < 2; ++dir) {
                const float Mt = tab[(2 + dir) * 64 + tau], at = tab[(4 + dir) * 64 + tau], flt = tab[(6 + dir) * 64 + tau];
                bf16x8 pfr[2];
#pragma unroll
                for (int kp = 0; kp < 2; ++kp) { float pv[8];
#pragma unroll
                    for (int hf = 0; hf < 2; ++hf) { const int st = 2 * kp + hf; const f32x4 gs = *(const LAS f32x4*)(tab + dir * 64 + 16 * st + 4 * g);
#pragma unroll
                        for (int i = 0; i < 4; ++i) { const int sg = 16 * st + 4 * g + i; const bool ok = dir ? (sg >= tau) : (sg <= tau);
                            const float e = fexp(gs[i] - Mt) * S[st][i]; pv[4 * hf + i] = ok ? e : 0.f; } }
                    u32x4 pw; pw.x = pk2(pv[0], pv[1]); pw.y = pk2(pv[2], pv[3]); pw.z = pk2(pv[4], pv[5]); pw.w = pk2(pv[6], pv[7]); pfr[kp] = __builtin_bit_cast(bf16x8, pw); }
                f32x4 nd[5];
#pragma unroll
                for (int et = 0; et < 5; ++et) nd[et] = zero4();
#pragma unroll
                for (int kp = 0; kp < 2; ++kp) {
                    const u32x4 qw = __builtin_bit_cast(u32x4, qfr[kp]); u32x4 qs;
                    qs.x = pk2(bflo(qw.x) * at, bfhi(qw.x) * at); qs.y = pk2(bflo(qw.y) * at, bfhi(qw.y) * at); qs.z = pk2(bflo(qw.z) * at, bfhi(qw.z) * at); qs.w = pk2(bflo(qw.w) * at, bfhi(qw.w) * at);
                    const bf16x8 qsc = __builtin_bit_cast(bf16x8, qs);
#pragma unroll
                    for (int et = 0; et < 4; ++et) { const bf16x8 vf = cat8(trread(vbuf + (32 * kp + 4 * g + q4) * VROW + 32 * et + 8 * p4), trread(vbuf + (32 * kp + 16 + 4 * g + q4) * VROW + 32 * et + 8 * p4));
                        nd[et] = mfma16(vf, pfr[kp], nd[et]); nd[et] = mfma16(cfr[dir][et][kp], qsc, nd[et]); }
                    { const short one = r16 == 0 ? (short)0x3F80 : (short)0; const bf16x8 of = {one, one, one, one, one, one, one, one}; nd[4] = mfma16(of, pfr[kp], nd[4]); }
                    { bf16x8 nf = {0, 0, 0, 0, 0, 0, 0, 0}; if (r16 == 0) nf = *(const LAS bf16x8*)(ntab + dir * 128 + 64 * kp + 16 * g); nd[4] = mfma16(nf, qsc, nd[4]); }
                }
                const float den = shi(nd[4][0], r16);
                const float inv = 1.f / fmaxf(fabsf(den), flt);
#pragma unroll
                for (int et = 0; et < 4; ++et) hs[et] += nd[et] * inv;
            }
            float ss = 0.f;
#pragma unroll
            for (int et = 0; et < 4; ++et) ss += (hs[et][0] * hs[et][0] + hs[et][1] * hs[et][1]) + (hs[et][2] * hs[et][2] + hs[et][3] * hs[et][3]);
            ss = xsum4(ss);
            const float rn = 1.f / sqrtf(ss * (1.f / 64.f) + EPS);
            bf16_t* zr = zb + (size_t)(s + tau) * ZLD;
#pragma unroll
            for (int et = 0; et < 4; ++et) { const int e0 = 64 * h + 16 * et + 4 * g;
                const u32x2 ov = ocv[et]; const f32x4 ng = *(const f32x4*)(P.mlstm_norm + l * 384 + e0);
                const float y0 = hs[et][0] * rn * ng[0] * sigmoidf_(bflo(ov.x)), y1 = hs[et][1] * rn * ng[1] * sigmoidf_(bfhi(ov.x));
                const float y2 = hs[et][2] * rn * ng[2] * sigmoidf_(bflo(ov.y)), y3 = hs[et][3] * rn * ng[3] * sigmoidf_(bfhi(ov.y));
                u32x2 w; w.x = pk2(y0, y1); w.y = pk2(y2, y3); *(u32x2*)(zr + QC + e0) = w; }
        }
        WAVE_LDS_FENCE();
    }
}

#ifndef PROBE_MODE
#define PROBE_MODE 0
#endif
#ifndef SKIP_ATTN
#define SKIP_ATTN 0
#endif
#ifndef SKIP_MLSTM
#define SKIP_MLSTM 0
#endif

__global__ void __launch_bounds__(512, 2) fwd_kernel(KParams P) {
    extern __shared__ __attribute__((aligned(16))) unsigned char lds_raw[];
    LAS unsigned char* lds = (LAS unsigned char*)lds_raw;
    cg::grid_group grid = cg::this_grid();
#if PROBE_MODE == 4
#define GSYNC() do { grid.sync(); grid.sync(); } while (0)
#else
#define GSYNC() grid.sync()
#endif
    unsigned* const bar_w = (unsigned*)P.ws;
    const unsigned xcd_ = (unsigned)__builtin_amdgcn_s_getreg((3 << 11) | 20) & 0xFu;
    unsigned bar_round = 0; bool bar_local = false;
#define ABAR() do { asm volatile("s_waitcnt vmcnt(0) lgkmcnt(0)" ::: "memory"); __syncthreads(); bar_round += 1u; \
        if (wave_s == 0 && lane_id_asm() == 0) { \
            if (!bar_local) { __builtin_amdgcn_fence(__ATOMIC_RELEASE, "agent"); asm volatile("s_waitcnt vmcnt(0)" ::: "memory"); } \
            __hip_atomic_fetch_add(bar_w + 48 + (pm0 >> 5), 1u, __ATOMIC_RELAXED, __HIP_MEMORY_SCOPE_AGENT); \
            unsigned sp_ = 0; while (__hip_atomic_load(bar_w + 48 + (pm0 >> 5), __ATOMIC_RELAXED, __HIP_MEMORY_SCOPE_AGENT) < 32u * bar_round && ++sp_ < (1u << 22)) __builtin_amdgcn_s_sleep(2); \
            __builtin_amdgcn_fence(__ATOMIC_ACQUIRE, "agent"); } \
        __syncthreads(); } while (0)
#define ABAR_ARRIVE() do { asm volatile("s_waitcnt vmcnt(0) lgkmcnt(0)" ::: "memory"); __syncthreads(); bar_round += 1u; \
        if (wave_s == 0 && lane_id_asm() == 0) { \
            if (!bar_local) { __builtin_amdgcn_fence(__ATOMIC_RELEASE, "agent"); asm volatile("s_waitcnt vmcnt(0)" ::: "memory"); } \
            __hip_atomic_fetch_add(bar_w + 48 + (pm0 >> 5), 1u, __ATOMIC_RELAXED, __HIP_MEMORY_SCOPE_AGENT); } } while (0)
#define ABAR_WAIT() do { \
        if (wave_s == 0 && lane_id_asm() == 0) { \
            unsigned sp_ = 0; while (__hip_atomic_load(bar_w + 48 + (pm0 >> 5), __ATOMIC_RELAXED, __HIP_MEMORY_SCOPE_AGENT) < 32u * bar_round && ++sp_ < (1u << 22)) __builtin_amdgcn_s_sleep(2); \
            __builtin_amdgcn_fence(__ATOMIC_ACQUIRE, "agent"); } \
        __syncthreads(); } while (0)
    const int G = gridDim.x, bx = blockIdx.x;
    if (G != 256) return;
    const int pm0 = (bx & 7) * 32 + (bx >> 3);
const int wave_s = __builtin_amdgcn_readfirstlane((int)threadIdx.x >> 6);
#define FRESH_IDS int tid = wave_s * 64 + lane_id_asm(); asm volatile("" : "+v"(tid)); const int lane = tid & 63, wave = __builtin_amdgcn_readfirstlane(tid >> 6); int pm = pm0; asm volatile("" : "+s"(pm)); (void)lane; (void)wave; (void)pm;
#define WSP() ({ __attribute__((address_space(1))) unsigned char* w_ = (__attribute__((address_space(1))) unsigned char*)P.ws; asm volatile("" : "+s"(w_)); (unsigned char*)w_; })
#define Wall ((bf16_t*)(WSP() + WS_W))
#define PB ((bf16_t*)(WSP() + WS_PB))
#define gates ((float*)(WSP() + WS_GATES))
#define rs ((float*)(WSP() + WS_RS))
#define XBA ((bf16_t*)(WSP() + WS_XBA))
#define XBB ((bf16_t*)(WSP() + WS_XBB))
#define Z ((bf16_t*)(WSP() + WS_Z))
    LAS float* ssq = (LAS float*)(lds + SSQ_OFF);
    LAS float* rsl = (LAS float*)(lds + RSL_OFF);
#define ZERO_SSQ() do { FRESH_IDS; if (tid < 256) { *(LAS f32x4*)(ssq + tid * 4) = zero4(); } } while (0)
#define WRITE_RS() do { FRESH_IDS; if (tid < 256) { const float s_ = (ssq[tid * 4] + ssq[tid * 4 + 1]) + (ssq[tid * 4 + 2] + ssq[tid * 4 + 3]); const float r_ = 1.f / sqrtf(s_ * (1.f / DM) + EPS); rs[pm * 256 + tid] = r_; rsl[tid] = r_; } } while (0)

#if PROBE_MODE == 3
    { FRESH_IDS;
      prep_weights(P, lds, bx * 8 + wave, G * 8, wave, lane);
      for (int rr = wave; rr < 256; rr += 8) { const size_t row = (size_t)pm * 256 + rr;
        const f32x4* xr = (const f32x4*)(P.x + row * DM) + lane; f32x4 v[4]; float s = 0.f;
#pragma unroll
        for (int j = 0; j < 4; ++j) { v[j] = __builtin_nontemporal_load(xr + 64 * j); s += (v[j][0] * v[j][0] + v[j][1] * v[j][1]) + (v[j][2] * v[j][2] + v[j][3] * v[j][3]); }
        s = wave_sum(s, lane);
        u32x2* o = (u32x2*)(XBA + row * DM) + lane;
#pragma unroll
        for (int j = 0; j < 4; ++j) { u32x2 w; w.x = pk2(v[j][0], v[j][1]); w.y = pk2(v[j][2], v[j][3]); o[64 * j] = w; }
        if (lane == 0) rs[row] = 1.f / sqrtf(s * (1.f / DM) + EPS); } }
    __syncthreads();
#endif
    { FRESH_IDS;
      prep_weights(P, lds, bx * 8 + wave, G * 8, wave, lane);
      for (int rr = wave; rr < 256; rr += 8) { const size_t row = (size_t)pm * 256 + rr;
        const f32x4* xr = (const f32x4*)(P.x + row * DM) + lane; f32x4 v[4]; float s = 0.f;
#pragma unroll
        for (int j = 0; j < 4; ++j) { v[j] = __builtin_nontemporal_load(xr + 64 * j); s += (v[j][0] * v[j][0] + v[j][1] * v[j][1]) + (v[j][2] * v[j][2] + v[j][3] * v[j][3]); }
        s = wave_sum(s, lane);
        u32x2* o = (u32x2*)(XBA + row * DM) + lane;
#pragma unroll
        for (int j = 0; j < 4; ++j) { u32x2 w; w.x = pk2(v[j][0], v[j][1]); w.y = pk2(v[j][2], v[j][3]); o[64 * j] = w; }
        if (lane == 0) { const float r_ = 1.f / sqrtf(s * (1.f / DM) + EPS); rs[row] = r_; rsl[rr] = r_; } } }
    if (wave_s == 0 && lane_id_asm() == 0) __hip_atomic_store(bar_w + 256 + pm0, xcd_, __ATOMIC_RELAXED, __HIP_MEMORY_SCOPE_AGENT);
    GSYNC();
    { unsigned same = 1u;
      for (int i = 0; i < 32; ++i) same &= (__hip_atomic_load(bar_w + 256 + (pm0 & ~31) + i, __ATOMIC_RELAXED, __HIP_MEMORY_SCOPE_AGENT) == xcd_) ? 1u : 0u;
      bar_local = __builtin_amdgcn_readfirstlane((int)same) != 0; }

    for (int l = 0; l < DEPTH; ++l) {
        bf16_t* Wl = Wall + (size_t)l * LAYER_W;
        { pg8::Gemm g{XBA, Wl + OFF_WIN, DM, DM, wave_s}; pg8::RowOrder S{pm0, NIN_PAD / 256}; pg8::EpiZ E{Z, gates, rsl};
          pg8::gemm_phase<pg8::EpiZ, pg8::RowOrder>(lds, g, S, E);
#if PROBE_MODE == 2
          pg8::gemm_phase<pg8::EpiZ, pg8::RowOrder>(lds, g, S, E);
#endif
          }
        ABAR();
#if PROBE_MODE == 1 || PROBE_MODE == 6
        { FRESH_IDS; build_lut(P, lds, tid); __syncthreads(); attention_phase(P, lds, l, pm, wave, lane, P.out == nullptr); __syncthreads(); }
#endif
#if PROBE_MODE == 1 || PROBE_MODE == 7
        { FRESH_IDS; mlstm_state_phase(P, lds, l, pm, wave, lane); __syncthreads(); }
#endif
        if (!SKIP_MLSTM) { FRESH_IDS; mlstm_state_phase(P, lds, l, pm, wave, lane); }
        ABAR_ARRIVE();
        if (!SKIP_ATTN) { FRESH_IDS;
            build_lut(P, lds, tid);
            __syncthreads();
            attention_phase(P, lds, l, pm, wave, lane);
        }
        ABAR_WAIT();
#if PROBE_MODE == 1 || PROBE_MODE == 8
        { FRESH_IDS; mlstm_scan_phase(P, lds, pm, G, tid, P.out == nullptr); }
#endif
        if (!SKIP_MLSTM) { FRESH_IDS; mlstm_scan_phase(P, lds, pm, G, tid); }
        ABAR();
#if PROBE_MODE == 1 || PROBE_MODE == 9
        { FRESH_IDS; mlstm_out_phase(P, lds, l, pm, wave, lane); __syncthreads(); }
#endif
        if (!SKIP_MLSTM) { FRESH_IDS; mlstm_out_phase(P, lds, l, pm, wave, lane); }
        ZERO_SSQ();
        LOCAL_SEAM();
#if PROBE_MODE == 5
        { pg8::Gemm g{Z, Wl + OFF_WOUT, ZLD, DM, wave_s}; pg8::RowOrder S{pm0, 4}; pg8::EpiResid<false> E{XBA, XBA, nullptr, ssq, (P.out == nullptr)};
          pg8::gemm_phase<pg8::EpiResid<false>, pg8::RowOrder>(lds, g, S, E); }
        __syncthreads();
#endif
        { pg8::Gemm g{Z, Wl + OFF_WOUT, ZLD, DM, wave_s}; pg8::RowOrder S{pm0, 4}; pg8::EpiResid<false> E{XBA, XBA, nullptr, ssq, true};
          pg8::gemm_phase<pg8::EpiResid<false>, pg8::RowOrder>(lds, g, S, E); }
        __syncthreads();
        WRITE_RS();
        LOCAL_SEAM();
        { pg8::Gemm g{XBA, Wl + OFF_WUP, DM, DM, wave_s}; pg8::RowOrder S{pm0, NUP / 256}; pg8::EpiSwiGLU E{Z, rsl};
          pg8::gemm_phase<pg8::EpiSwiGLU, pg8::RowOrder>(lds, g, S, E);
#if PROBE_MODE == 2
          pg8::gemm_phase<pg8::EpiSwiGLU, pg8::RowOrder>(lds, g, S, E);
#endif
          }
        ZERO_SSQ();
        LOCAL_SEAM();
#if PROBE_MODE == 5
        { pg8::Gemm g{Z + ACT_OFF, Wl + OFF_WDOWN, ZLD, DFF, wave_s}; pg8::RowOrder S{pm0, 4}; pg8::EpiResid<false> E{XBA, XBB, nullptr, ssq, (P.out == nullptr)};
          pg8::gemm_phase<pg8::EpiResid<false>, pg8::RowOrder>(lds, g, S, E); }
        __syncthreads();
#endif
        { pg8::Gemm g{Z + ACT_OFF, Wl + OFF_WDOWN, ZLD, DFF, wave_s}; pg8::RowOrder S{pm0, 4}; pg8::EpiResid<false> E{XBA, XBB, nullptr, ssq, true};
          pg8::gemm_phase<pg8::EpiResid<false>, pg8::RowOrder>(lds, g, S, E); }
        { FRESH_IDS;
          for (int r0 = wave; r0 < 256; r0 += 64) {
            f32x4 v[8];
#pragma unroll
            for (int j = 0; j < 8; ++j) { const size_t row = (size_t)pm * 256 + r0 + 8 * j; v[j] = __builtin_nontemporal_load((const f32x4*)(P.p + ((size_t)l * MTOK + row) * PLE) + lane); }
#pragma unroll
            for (int j = 0; j < 8; ++j) { const size_t row = (size_t)pm * 256 + r0 + 8 * j; u32x2 w; w.x = pk2(v[j][0], v[j][1]); w.y = pk2(v[j][2], v[j][3]); *((u32x2*)(PB + row * PLE) + lane) = w; } } }
        LOCAL_SEAM();
        { pg8::Gemm g{XBB, Wl + OFF_WG, DM, DM, wave_s}; pg8::RowOrder S{pm0, 4}; pg8::EpiSigmoid E{Z};
          pg8::gemm_phase<pg8::EpiSigmoid, pg8::RowOrder>(lds, g, S, E);
#if PROBE_MODE == 2
          pg8::gemm_phase<pg8::EpiSigmoid, pg8::RowOrder>(lds, g, S, E);
#endif
          }
        ZERO_SSQ();
        LOCAL_SEAM();
#if PROBE_MODE == 5
        { pg8::Gemm g{PB, Wl + OFF_WP, PLE, PLE, wave_s}; pg8::RowOrder S{pm0, 4}; pg8::EpiResid<true> E{XBB, XBA, Z, ssq, (P.out == nullptr)};
          pg8::gemm_phase<pg8::EpiResid<true>, pg8::RowOrder>(lds, g, S, E); }
        __syncthreads();
#endif
        { pg8::Gemm g{PB, Wl + OFF_WP, PLE, PLE, wave_s}; pg8::RowOrder S{pm0, 4}; pg8::EpiResid<true> E{XBB, XBA, Z, ssq, true};
          pg8::gemm_phase<pg8::EpiResid<true>, pg8::RowOrder>(lds, g, S, E); }
        __syncthreads();
        WRITE_RS();
        LOCAL_SEAM();
    }
    { FRESH_IDS;
      for (int r0 = wave; r0 < 256; r0 += 32) {
        u32x2 v[4][4]; float sc[4];
#pragma unroll
        for (int q = 0; q < 4; ++q) { const size_t row = (size_t)pm * 256 + r0 + 8 * q; sc[q] = rs[row]; const u32x2* xr = (const u32x2*)(XBA + row * DM) + lane;
#pragma unroll
            for (int j = 0; j < 4; ++j) v[q][j] = xr[64 * j]; }
        const f32x4* gr = (const f32x4*)P.final_norm + lane;
#pragma unroll
        for (int q = 0; q < 4; ++q) { const size_t row = (size_t)pm * 256 + r0 + 8 * q; f32x4* orow = (f32x4*)(P.out + row * DM) + lane;
#pragma unroll
            for (int j = 0; j < 4; ++j) { const f32x4 gg = gr[64 * j]; const u32x2 w = v[q][j];
                __builtin_nontemporal_store((f32x4){bflo(w.x) * sc[q] * gg[0], bfhi(w.x) * sc[q] * gg[1], bflo(w.y) * sc[q] * gg[2], bfhi(w.y) * sc[q] * gg[3]}, orow + 64 * j); } } } }
}

extern "C" void kernel_launch(void* const* d_in, const int* in_sizes, int n_in, void* d_out, int out_size, void* d_ws, size_t ws_size, hipStream_t stream) {
    static int ready = 0;
    if (ready == 0) {
        if (n_in != 16 || out_size != MTOK * DM || ws_size < WS_END) { fprintf(stderr, "kernel_launch: unexpected sizes (n_in %d, out %d, ws %zu)\n", n_in, out_size, ws_size); ready = -1; return; }
        if (hipFuncSetAttribute((const void*)fwd_kernel, hipFuncAttributeMaxDynamicSharedMemorySize, LDS_BYTES) != hipSuccess) { fprintf(stderr, "kernel_launch: hipFuncSetAttribute failed\n"); ready = -1; return; }
        int dev = 0, cus = 0, per_cu = 0;
        (void)hipGetDevice(&dev); (void)hipDeviceGetAttribute(&cus, hipDeviceAttributeMultiprocessorCount, dev);
        (void)hipOccupancyMaxActiveBlocksPerMultiprocessor(&per_cu, (const void*)fwd_kernel, 512, LDS_BYTES);
        if (cus != 256 || per_cu < 1) fprintf(stderr, "kernel_launch: note: %d CUs, %d blocks/CU (kernel expects 256 x 1)\n", cus, per_cu);
        (void)hipGetLastError();
        ready = 1;
    }
    if (ready < 0) return;
    KParams P{};
    P.x = (const float*)d_in[0]; P.p = (const float*)d_in[1]; P.rel_bias = (const float*)d_in[2]; P.attn_norm = (const float*)d_in[3]; P.w_in = (const float*)d_in[4];
    P.qk_conv = (const float*)d_in[5]; P.gate_bias = (const float*)d_in[6]; P.sink = (const float*)d_in[7]; P.mlstm_norm = (const float*)d_in[8]; P.w_out = (const float*)d_in[9];
    P.ffn_norm = (const float*)d_in[10]; P.w_up = (const float*)d_in[11]; P.w_down = (const float*)d_in[12]; P.ple_proj = (const float*)d_in[13]; P.ple_gate = (const float*)d_in[14];
    P.final_norm = (const float*)d_in[15]; P.out = (float*)d_out; P.ws = (unsigned char*)d_ws;
    (void)hipMemsetAsync(d_ws, 0, 256, stream);
    void* args[] = {&P};
    hipError_t e = hipLaunchCooperativeKernel((const void*)fwd_kernel, dim3(256), dim3(512), args, LDS_BYTES, stream);
    if (e != hipSuccess) fprintf(stderr, "kernel_launch: cooperative launch failed: %s\n", hipGetErrorString(e));
}
```
